# Optimizing an MI355X kernel written in HIP

```python
import jax
import jax.numpy as jnp
from jax import lax
import numpy as np

D_MODEL = 1024
BATCH = 16
SEQ = 2048
DEPTH = 2

HEAD_DIM = 64
ROPE_THETA = 10000.0
RMS_EPS = 1e-6
N_BRANCH = 3

A_HEADS = 6
A_WIDTH = A_HEADS * HEAD_DIM
A_BLOCK = 256
A_TOPK = 3
A_QCHUNK = 32

B_HEADS = 6
B_WIDTH = B_HEADS * HEAD_DIM
B_KV_DIM = HEAD_DIM
B_TOPK = 256
B_IDX_HEADS = 4
B_IDX_DIM = HEAD_DIM
B_QCHUNK = 128

C_GROUPS = ((128, 1), (512, 4), (2048, 16))
C_SLOTS = 4
C_HEADS = C_SLOTS * len(C_GROUPS)
C_WIDTH = C_SLOTS * HEAD_DIM
C_BLOCK = 128

IN_SPLITS = (A_WIDTH, A_WIDTH, A_WIDTH, A_WIDTH,
             B_WIDTH, B_KV_DIM, B_KV_DIM, B_WIDTH, B_IDX_HEADS * B_IDX_DIM, B_IDX_DIM, B_IDX_HEADS,
             C_HEADS * HEAD_DIM, C_HEADS * HEAD_DIM, C_HEADS * HEAD_DIM, C_WIDTH,
             N_BRANCH * D_MODEL)
IN_WIDTH = sum(IN_SPLITS)
IN_OFFSETS = tuple(int(o) for o in np.cumsum(IN_SPLITS)[:-1])

kernel_name = 'hybrid_moba_dsa_dilated_gated'


def rmsnorm(x, g):
    xf = x.astype(jnp.float32)
    y = xf * lax.rsqrt(jnp.mean(xf * xf, axis=-1, keepdims=True) + RMS_EPS)
    return (y * g.astype(jnp.float32)).astype(x.dtype)


def rope_tables(seq_len):
    inv_freq = 1.0 / (ROPE_THETA ** (jnp.arange(0, HEAD_DIM, 2, dtype=jnp.float32) / HEAD_DIM))
    ang = jnp.arange(seq_len, dtype=jnp.float32)[:, None] * inv_freq[None, :]
    return jnp.cos(ang), jnp.sin(ang)


def apply_rope(x, cos, sin):
    half = HEAD_DIM // 2
    c = cos[None, :, None, :].astype(x.dtype)
    s = sin[None, :, None, :].astype(x.dtype)
    x1, x2 = x[..., :half], x[..., half:]
    return jnp.concatenate([x1 * c - x2 * s, x1 * s + x2 * c], axis=-1)


def moba_attention(q, k, v):
    bsz, seq, nh, hd = q.shape
    scale = hd ** -0.5
    n_blk = -(-seq // A_BLOCK)
    pad = n_blk * A_BLOCK - seq
    qh = q.transpose(0, 2, 1, 3)
    kb = jnp.pad(k.transpose(0, 2, 1, 3), ((0, 0), (0, 0), (0, pad), (0, 0))).reshape(bsz, nh, n_blk, A_BLOCK, hd)
    vb = jnp.pad(v.transpose(0, 2, 1, 3), ((0, 0), (0, 0), (0, pad), (0, 0))).reshape(bsz, nh, n_blk, A_BLOCK, hd)
    k_mean = jnp.mean(kb.astype(jnp.float32), axis=3)
    topk = max(1, min(A_TOPK, n_blk - 1))
    b_ix = jnp.arange(bsz)[:, None, None, None]
    h_ix = jnp.arange(nh)[None, :, None, None]
    blk_ids = jnp.arange(n_blk)
    n_sel = topk * A_BLOCK

    def chunk(ci):
        t0 = ci * A_QCHUNK
        own = t0 // A_BLOCK
        t_pos = t0 + jnp.arange(A_QCHUNK)
        qc = lax.dynamic_slice_in_dim(qh, t0, A_QCHUNK, axis=2)
        k_own = lax.dynamic_index_in_dim(kb, own, axis=2, keepdims=False)
        v_own = lax.dynamic_index_in_dim(vb, own, axis=2, keepdims=False)
        kpos_own = own * A_BLOCK + jnp.arange(A_BLOCK)
        s_own = jnp.einsum('bhqd,bhkd->bhqk', qc, k_own, preferred_element_type=jnp.float32) * scale
        s_own = jnp.where(kpos_own[None, :] <= t_pos[:, None], s_own, -jnp.inf)
        gate = jnp.einsum('bhqd,bhnd->bhqn', qc.astype(jnp.float32), k_mean)
        gate = jnp.where(blk_ids < own, gate, -jnp.inf)
        g_val, g_idx = lax.top_k(gate, topk)
        sel_ok = jnp.isfinite(g_val)
        k_sel = kb[b_ix, h_ix, g_idx]
        v_sel = vb[b_ix, h_ix, g_idx]
        s_sel = jnp.einsum('bhqd,bhqnkd->bhqnk', qc, k_sel, preferred_element_type=jnp.float32) * scale
        s_sel = jnp.where(sel_ok[..., None], s_sel, -jnp.inf)
        scores = jnp.concatenate([s_sel.reshape(bsz, nh, A_QCHUNK, n_sel), s_own], axis=-1)
        p = jax.nn.softmax(scores, axis=-1).astype(v.dtype)
        p_sel = p[..., :n_sel].reshape(bsz, nh, A_QCHUNK, topk, A_BLOCK)
        out = jnp.einsum('bhqnk,bhqnkd->bhqd', p_sel, v_sel)
        return out + jnp.einsum('bhqk,bhkd->bhqd', p[..., n_sel:], v_own)

    outs = lax.map(chunk, jnp.arange(seq // A_QCHUNK))
    return outs.transpose(1, 0, 3, 2, 4).reshape(bsz, seq, nh, hd)


def dsa_attention(q, k, v, iq, ik, iw):
    bsz, seq, nh, hd = q.shape
    scale = hd ** -0.5
    n_keep = min(B_TOPK, seq // 4)
    b_ix = jnp.arange(bsz)[:, None, None]
    key_pos = jnp.arange(seq)
    iw = iw.astype(jnp.float32) * (B_IDX_HEADS * B_IDX_DIM) ** -0.5

    def chunk(ci):
        t0 = ci * B_QCHUNK
        t_pos = t0 + jnp.arange(B_QCHUNK)
        iq_c = lax.dynamic_slice_in_dim(iq, t0, B_QCHUNK, axis=1)
        iw_c = lax.dynamic_slice_in_dim(iw, t0, B_QCHUNK, axis=1)
        logit = jnp.einsum('bqhd,bsd->bqhs', iq_c, ik, preferred_element_type=jnp.float32)
        idx_score = jnp.einsum('bqhs,bqh->bqs', jax.nn.relu(logit), iw_c)
        idx_score = jnp.where(key_pos[None, :] <= t_pos[:, None], idx_score, -jnp.inf)
        _, sel = lax.top_k(idx_score, n_keep)
        sel_ok = sel <= t_pos[None, :, None]
        k_g = k[b_ix, sel]
        v_g = v[b_ix, sel]
        qc = lax.dynamic_slice_in_dim(q, t0, B_QCHUNK, axis=1)
        s = jnp.einsum('bqhd,bqkd->bqhk', qc, k_g, preferred_element_type=jnp.float32) * scale
        s = jnp.where(sel_ok[:, :, None, :], s, -jnp.inf)
        p = jax.nn.softmax(s, axis=-1).astype(v.dtype)
        return jnp.einsum('bqhk,bqkd->bqhd', p, v_g)

    outs = lax.map(chunk, jnp.arange(seq // B_QCHUNK))
    return outs.transpose(1, 0, 2, 3, 4).reshape(bsz, seq, nh, hd)


def dilated_group(q, k, v, steps, dil):
    bsz, seq, nh, hd = q.shape
    n_sub = seq // dil
    n_blk = -(-n_sub // C_BLOCK)
    pad = n_blk * C_BLOCK - n_sub

    def to_sub(t):
        t = t.reshape(bsz, n_sub, dil, nh, hd).transpose(0, 2, 3, 1, 4)
        return jnp.pad(t, ((0, 0), (0, 0), (0, 0), (0, pad), (0, 0)))

    def band(t):
        tb = jnp.pad(to_sub(t), ((0, 0), (0, 0), (0, 0), (C_BLOCK, 0), (0, 0)))
        tb = tb.reshape(bsz, dil, nh, n_blk + 1, C_BLOCK, hd)
        return jnp.concatenate([tb[:, :, :, :-1], tb[:, :, :, 1:]], axis=4)

    qs = to_sub(q).reshape(bsz, dil, nh, n_blk, C_BLOCK, hd)
    kw = band(k)
    vw = band(v)
    s = jnp.einsum('brhnqd,brhnkd->brhnqk', qs, kw, preferred_element_type=jnp.float32) * hd ** -0.5
    blk = jnp.arange(n_blk)[:, None, None]
    qi = jnp.arange(C_BLOCK)[None, :, None]
    ki = jnp.arange(2 * C_BLOCK)[None, None, :]
    dist = C_BLOCK + qi - ki
    ok = (dist >= 0) & (dist <= steps) & (blk * C_BLOCK + ki >= C_BLOCK)
    s = jnp.where(ok, s, -jnp.inf)
    lse = jax.nn.logsumexp(s, axis=-1)
    p = jnp.exp(s - lse[..., None]).astype(v.dtype)
    o = jnp.einsum('brhnqk,brhnkd->brhnqd', p, vw)
    o = o.reshape(bsz, dil, nh, n_blk * C_BLOCK, hd)[:, :, :, :n_sub]
    o = o.transpose(0, 3, 1, 2, 4).reshape(bsz, seq, nh, hd)
    lse = lse.reshape(bsz, dil, nh, n_blk * C_BLOCK)[..., :n_sub]
    lse = lse.transpose(0, 3, 1, 2).reshape(bsz, seq, nh)
    return o, lse


def dilated_mixture(q, k, v):
    outs = []
    lses = []
    for g, (window, dil) in enumerate(C_GROUPS):
        sl = slice(g * C_SLOTS, (g + 1) * C_SLOTS)
        o, l = dilated_group(q[:, :, sl], k[:, :, sl], v[:, :, sl], window // dil, dil)
        outs.append(o)
        lses.append(l)
    w = jax.nn.softmax(jnp.stack(lses, axis=0), axis=0)
    return jnp.sum(w[..., None] * jnp.stack(outs, axis=0), axis=0).astype(q.dtype)


def hybrid_layer(x, norm_g, w_in, w_br_a, w_br_b, w_br_c, w_out, cos, sin):
    bsz, seq, _ = x.shape
    h = rmsnorm(x, norm_g)
    proj = h @ w_in
    (a_q, a_k, a_v, a_g, b_q, b_k, b_v, b_g, i_q, i_k, i_w,
     c_q, c_k, c_v, c_g, m_g) = jnp.split(proj, IN_OFFSETS, axis=-1)

    def heads(t, n):
        return t.reshape(bsz, seq, n, -1)

    def rope1(t):
        return apply_rope(t[:, :, None, :], cos, sin)[:, :, 0, :]

    ya = moba_attention(apply_rope(heads(a_q, A_HEADS), cos, sin),
                        apply_rope(heads(a_k, A_HEADS), cos, sin),
                        heads(a_v, A_HEADS))
    ya = ya.reshape(bsz, seq, A_WIDTH) * jax.nn.silu(a_g)
    yb = dsa_attention(apply_rope(heads(b_q, B_HEADS), cos, sin), rope1(b_k), b_v,
                       apply_rope(heads(i_q, B_IDX_HEADS), cos, sin), rope1(i_k), i_w)
    yb = yb.reshape(bsz, seq, B_WIDTH) * jax.nn.silu(b_g)
    yc = dilated_mixture(apply_rope(heads(c_q, C_HEADS), cos, sin),
                         apply_rope(heads(c_k, C_HEADS), cos, sin),
                         heads(c_v, C_HEADS))
    yc = yc.reshape(bsz, seq, C_WIDTH) * jax.nn.silu(c_g)
    gates = jax.nn.sigmoid(m_g).reshape(bsz, seq, N_BRANCH, D_MODEL)
    merged = (gates[:, :, 0] * (ya @ w_br_a)
              + gates[:, :, 1] * (yb @ w_br_b)
              + gates[:, :, 2] * (yc @ w_br_c))
    return x + merged @ w_out


def setup_inputs(seed: int = 0) -> dict:
    key = jax.random.key(seed)
    ks = jax.random.split(key, 8)
    x = jax.random.normal(ks[0], (BATCH, SEQ, D_MODEL), jnp.float32)
    norm_g = 1.0 + 0.02 * jax.random.normal(ks[1], (DEPTH, D_MODEL), jnp.float32)
    w_in = jax.random.normal(ks[2], (DEPTH, D_MODEL, IN_WIDTH), jnp.float32) * D_MODEL ** -0.5
    w_br_a = jax.random.normal(ks[3], (DEPTH, A_WIDTH, D_MODEL), jnp.float32) * A_WIDTH ** -0.5
    w_br_b = jax.random.normal(ks[4], (DEPTH, B_WIDTH, D_MODEL), jnp.float32) * B_WIDTH ** -0.5
    w_br_c = jax.random.normal(ks[5], (DEPTH, C_WIDTH, D_MODEL), jnp.float32) * C_WIDTH ** -0.5
    w_out = jax.random.normal(ks[6], (DEPTH, D_MODEL, D_MODEL), jnp.float32) * D_MODEL ** -0.5
    final_norm_g = 1.0 + 0.02 * jax.random.normal(ks[7], (D_MODEL,), jnp.float32)
    return {'x': x, 'norm_g': norm_g, 'w_in': w_in, 'w_br_a': w_br_a, 'w_br_b': w_br_b,
            'w_br_c': w_br_c, 'w_out': w_out, 'final_norm_g': final_norm_g}


def reference(x, norm_g, w_in, w_br_a, w_br_b, w_br_c, w_out, final_norm_g):
    cos, sin = rope_tables(x.shape[1])
    for layer in range(DEPTH):
        x = hybrid_layer(x, norm_g[layer], w_in[layer], w_br_a[layer], w_br_b[layer],
                         w_br_c[layer], w_out[layer], cos, sin)
    return rmsnorm(x, final_norm_g)
```

```cpp
#include <hip/hip_runtime.h>
#include <cstdio>
#include <cstdint>

#ifndef MK_N_LAUNCHES
#define MK_N_LAUNCHES 1
#endif

#ifndef EN_MASK
#define EN_MASK 0xFF
#endif
#define EN(k) (((EN_MASK) >> (k)) & 1)
#ifndef REP_KIND
#define REP_KIND -1
#endif
#ifndef REP_N
#define REP_N 2
#endif
#define NREP(k) (((k) == (REP_KIND)) ? (REP_N) : 1)
#define GAS __attribute__((address_space(1)))
#define LAS __attribute__((address_space(3)))
typedef unsigned short bf16_t;
typedef short bf16x8 __attribute__((ext_vector_type(8)));
typedef short s16x4 __attribute__((ext_vector_type(4)));
typedef float f32x4 __attribute__((ext_vector_type(4)));
typedef float f32x2 __attribute__((ext_vector_type(2)));
typedef float f32x16 __attribute__((ext_vector_type(16)));
typedef unsigned u32x4 __attribute__((ext_vector_type(4)));
typedef unsigned u32x2 __attribute__((ext_vector_type(2)));
typedef GAS unsigned gu32;
typedef unsigned long long u64;

constexpr int BATCH = 16, SEQ = 2048, DM = 1024, DEPTH = 2;
constexpr int NCH = 2, BPC = BATCH / NCH, MC = BPC * SEQ;
constexpr int INW = 8388;
constexpr int NW = 8448;
constexpr int C_AQ = 0, C_IQ = 384, C_IK = 640, C_BK = 704, C_AK = 768, C_BQ = 1152, C_CQ = 1536, C_CK = 2304, C_ROPE_END = 3072;
constexpr int C_AV = 3072, C_BV = 3456, C_CV = 3520, C_PLAIN_END = 4288;
constexpr int C_GA = 4288, C_SILU_END = 5312;
constexpr int C_MG = 5312, C_SIG_END = 8384;
constexpr int NP = 5312;
constexpr int NW_MAIN = 8192;
constexpr int C_F8 = 768;
constexpr int PBLK = NP / 32;
__host__ __device__ constexpr size_t p_col(int col) { return (size_t)(col >> 5) * 512 + (size_t)(col & 31); }
__host__ __device__ constexpr size_t p_off(int row, int col) { return (size_t)(row >> 4) * PBLK * 512 + (size_t)(row & 15) * 32 + p_col(col); }
__host__ __device__ constexpr size_t g_off(int row, int bc, int pitchB) { return ((size_t)(row >> 4) * (size_t)(pitchB / 64) + (size_t)(bc >> 6)) * 1024 + (size_t)((row & 15) * 64 + (bc & 63)); }
constexpr int YP = 1280;
constexpr float F8_SA = 16.f, F8_SB = 256.f, F8_SM = 16.f, F8_SY = 4.f;
constexpr float RMS_EPS = 1e-6f;
constexpr float QSCALE = 0.125f * 1.4426950408889634f;

constexpr size_t MiB = 1u << 20;
constexpr size_t WS_CTL = 0, CTL_ZERO_BYTES = 128 * 1024;
constexpr size_t WS_ROPE = 1 * MiB;
constexpr size_t WS_IW = 2 * MiB;
constexpr size_t WS_WIN = 4 * MiB;
constexpr size_t WS_WBR = 38 * MiB;
constexpr size_t WS_WOUT = 42 * MiB;
constexpr size_t WS_BITS = 46 * MiB;
constexpr size_t WS_H = 50 * MiB;
constexpr size_t WS_Y = 82 * MiB;
constexpr size_t WS_MERGED = 114 * MiB;
constexpr size_t WS_P = 146 * MiB;
constexpr size_t WS_MG8 = 312 * MiB;
constexpr size_t WS_H1 = 410 * MiB;
constexpr size_t WS_PO = 442 * MiB;
constexpr size_t WS_PML = 474 * MiB;
constexpr size_t WS_H8 = 476 * MiB;
constexpr size_t WS_IKC = 102 * MiB;
constexpr size_t WS_END = 508 * MiB;
static_assert(WS_P + (size_t)MC * NP * 2 <= WS_MG8 && WS_MG8 + (size_t)MC * 3072 <= WS_H1, "ws map");
static_assert(WS_Y + (size_t)MC * YP <= WS_IKC && WS_IKC + (size_t)2 * MC * 64 <= WS_MERGED, "ws map (compact indexer keys)");
static_assert(WS_WIN + (size_t)2 * NW * 1024 * 2 <= WS_WBR, "ws map");

constexpr int CW_TMO = 0;
constexpr int CW_BAR = 4096;
constexpr int CW_Q = 16384;

constexpr int RING_BYTES = 131072;
constexpr int SCORE_PITCH = 2052;
constexpr int LDSCTL_OFF = 135168, MISC_OFF = LDSCTL_OFF + 320;
constexpr int LDS_BYTES = 147456;
static_assert(16 * SCORE_PITCH * 4 <= LDSCTL_OFF, "lds map");

constexpr int NWAVES = 8;
constexpr int NPHASES = 2 + DEPTH * NCH * 5;

#define LDS_WAIT() asm volatile("s_waitcnt lgkmcnt(0)" ::: "memory")
#define VM_WAIT() asm volatile("s_waitcnt vmcnt(0)" ::: "memory")
#define RLX_AGENT __ATOMIC_RELAXED, __HIP_MEMORY_SCOPE_AGENT

__device__ __forceinline__ unsigned f2bf(float f) { unsigned u = __builtin_bit_cast(unsigned, f); return (u + 0x7fffu + ((u >> 16) & 1u)) >> 16; }
__device__ __forceinline__ unsigned pk2(float lo, float hi) { return f2bf(lo) | (f2bf(hi) << 16); }
__device__ __forceinline__ unsigned pk4_fp8(float a, float b, float c, float d) { int w = 0; w = __builtin_amdgcn_cvt_pk_fp8_f32(a, b, w, false); w = __builtin_amdgcn_cvt_pk_fp8_f32(c, d, w, true); return (unsigned)w; }
__device__ __forceinline__ float bf2f(short s) { return __builtin_bit_cast(float, ((unsigned)(unsigned short)s) << 16); }
typedef __bf16 bf16x2_t __attribute__((ext_vector_type(2)));
__device__ __forceinline__ unsigned cvtpk(float lo, float hi) { f32x2 v = {lo, hi}; bf16x2_t b = __builtin_convertvector(v, bf16x2_t); return __builtin_bit_cast(unsigned, b); }

__device__ __forceinline__ int opaque_wave(int wave) { asm volatile("" : "+s"(wave)); return wave; }
__device__ __forceinline__ int opaque_lane() { int l; asm volatile("v_mbcnt_lo_u32_b32 %0, -1, 0\n\tv_mbcnt_hi_u32_b32 %0, -1, %0" : "=v"(l)); return l; }
__device__ __forceinline__ int opaque_tid(int wave) { int l; asm volatile("v_mbcnt_lo_u32_b32 %0, -1, 0\n\tv_mbcnt_hi_u32_b32 %0, -1, %0" : "=v"(l)); return (wave << 6) | l; }
namespace pg8 {
constexpr int BM = 256, BK = 64, HALF = 128, HTB = HALF * BK * 2, STAGE_BYTES = 8 * HTB, NXCD = 8, WGM = 8;
__host__ __device__ __forceinline__ int lds_byte(int r, int c) { const int st = (r >> 4) * 2 + (c >> 5), rr = r & 15, cc = c & 31, ob = rr * 64 + cc * 2; return st * 1024 + (ob ^ (((ob >> 9) & 1) << 5)); }
__host__ __device__ __forceinline__ void stage_rc(int b, int& R, int& C) { const int st = b / 1024, sb = b % 1024, swz = sb ^ (((sb >> 9) & 1) << 5); R = (st >> 1) * 16 + swz / 64; C = (st & 1) * 32 + (swz % 64) / 2; }
__host__ __device__ __forceinline__ int perm32(int rho) { const int n = rho >> 4, i = rho & 15; return 8 * (i >> 2) + 4 * n + (i & 3); }

struct Unit { int pm, pn, kofs, nt, tag; };
constexpr int LD = 1024;
struct Gemm { const bf16_t* A; const bf16_t* Bt; };

struct StaticOrder {
    int nM, nN, nwg, G, c, nt;
    __device__ __forceinline__ void init(int M, int N, int K, int G_, int c_) { nM = M / BM; nN = N / BM; nwg = nM * nN; G = G_; c = c_; nt = K / BK; }
    __device__ __forceinline__ bool tile(int j, Unit& u) const {
        const long L = (long)j * G + c; if (L >= nwg) return false;
        int wgid = (int)L; { const int q = nwg / NXCD, r = nwg % NXCD, xcd = wgid % NXCD, off = wgid / NXCD; wgid = (xcd < r ? xcd * (q + 1) : r * (q + 1) + (xcd - r) * q) + off; }
        const int nig = WGM * nN, gid = wgid / nig, fm = gid * WGM, gsz = (nM - fm) < WGM ? (nM - fm) : WGM;
        u.pm = fm + ((wgid % nig) % gsz); u.pn = (wgid % nig) / gsz; return true;
    }
    __device__ __forceinline__ bool next(int i, Unit& u) const { if (!tile(i, u)) return false; u.kofs = 0; u.nt = nt; u.tag = 0; return true; }
};
struct TailOrder {
    int first, step, nt;
    __device__ __forceinline__ void init(int K, int G, int b) { const int stride = (G >= 64 && G % 64 == 0) ? G / 64 : 1; first = (b % stride == 0) ? b / stride : 64; step = G / stride; nt = K / BK; }
    __device__ __forceinline__ bool next(int i, Unit& u) const { const int j = first + i * step; if (j >= 64) return false; u.pm = j; u.pn = (NW_MAIN - C_F8) / BM; u.kofs = 0; u.nt = nt; u.tag = 0; return true; }
};
struct BranchOrder {
    StaticOrder so;
    __device__ __forceinline__ bool next(int i, Unit& u) const {
        const int j = i / 3, br = i - 3 * j; if (!so.tile(j, u)) return false;
        u.kofs = br * 512; u.nt = (br == 2) ? 2 : 4; u.tag = br; return true;
    }
};

typedef int i32x8 __attribute__((ext_vector_type(8)));
typedef int i32x4_t __attribute__((ext_vector_type(4)));
template <class Epi, class Sched, bool F8 = false, int F8PITCH = LD, bool ABLK = false>
__device__ __forceinline__ void gemm_phase(LAS unsigned char* lds, const Gemm g, const Sched& S, const Epi& E, int wave) {
    wave = opaque_wave(wave);
    const int tid = opaque_tid(wave), wid = wave, lane = tid & 63, wr = wid >> 2, wc = wid & 3, fr = lane & 15, fq = lane >> 4;
    unsigned voffA[2], voffB[2];
#pragma unroll
    for (int i = 0; i < 2; ++i) { int R, C; stage_rc(tid * 16 + i * 8192, R, C); const int Rb = Epi::PERM ? ((R & ~31) + perm32(R & 31)) : R;
        voffA[i] = ABLK ? (unsigned)g_off(R, C * 2, F8 ? F8PITCH : LD * 2) : (unsigned)(R * (F8 ? F8PITCH / 2 : LD) + C) * 2u; voffB[i] = (unsigned)(Rb * (F8 ? F8PITCH / 2 : LD) + C) * 2u; }
    constexpr size_t kstep = (size_t)(BK * 2);
    constexpr size_t kstepA = ABLK ? 2048 : kstep, kofA = ABLK ? 16 : 1;
    constexpr size_t ESZ = F8 ? 1 : 2;
    constexpr size_t hsA = F8 ? (size_t)HALF * F8PITCH : (size_t)HALF * LD * 2, hsB = hsA;
    constexpr size_t tsA = 2 * hsA, tsB = 2 * hsB;
    const unsigned ldsw = (unsigned)wid * 1024u;
    const int aoff = lds_byte(wr * 64 + fr, fq * 8), boff = lds_byte(wc * 32 + fr, fq * 8);
#define PG8_SA(b, h) (((b) * 2 + (h)) * HTB)
#define PG8_SB(b, h) ((4 + (b) * 2 + (h)) * HTB)
#define PG8_STAGE(bufoff, gbase, voff) do { _Pragma("unroll") for (int _i = 0; _i < 2; ++_i) { unsigned vo_ = (voff)[_i]; if (F8) asm volatile("" : "+v"(vo_));     \
        __builtin_amdgcn_global_load_lds((const unsigned*)((const char*)(gbase) + vo_), (LAS unsigned*)(lds + (bufoff) + ldsw + _i * 8192), 16, 0, 0); } } while (0)
#define PG8_LDA(dst, b, h) do { _Pragma("unroll") for (int m = 0; m < 4; ++m) { if (F8) { const i32x4_t lo_ = *(const LAS i32x4_t*)(lds + PG8_SA(b, h) + aoff + m * 2048), hi_ = *(const LAS i32x4_t*)(lds + PG8_SA(b, h) + aoff + m * 2048 + 1024); \
        dst##8[m] = __builtin_shufflevector(lo_, hi_, 0, 1, 2, 3, 4, 5, 6, 7); } else { _Pragma("unroll") for (int k = 0; k < 2; ++k) dst[m][k] = *(const LAS bf16x8*)(lds + PG8_SA(b, h) + aoff + m * 2048 + k * 1024); } } } while (0)
#define PG8_LDB(dst, b, h) do { _Pragma("unroll") for (int n = 0; n < 2; ++n) { if (F8) { const i32x4_t lo_ = *(const LAS i32x4_t*)(lds + PG8_SB(b, h) + boff + n * 2048), hi_ = *(const LAS i32x4_t*)(lds + PG8_SB(b, h) + boff + n * 2048 + 1024); \
        dst##8[n] = __builtin_shufflevector(lo_, hi_, 0, 1, 2, 3, 4, 5, 6, 7); } else { _Pragma("unroll") for (int k = 0; k < 2; ++k) dst[n][k] = *(const LAS bf16x8*)(lds + PG8_SB(b, h) + boff + n * 2048 + k * 1024); } } } while (0)
#define PG8_MMA(ai, bj, At, Bt) do { __builtin_amdgcn_s_setprio(1); _Pragma("unroll") for (int m = 0; m < 4; ++m) _Pragma("unroll") for (int n = 0; n < 2; ++n) { \
        if (F8) acc[ai][bj][m][n] = __builtin_amdgcn_mfma_scale_f32_16x16x128_f8f6f4(Bt##8[n], At##8[m], acc[ai][bj][m][n], 0, 0, 0, 0x7f7f7f7f, 0, 0x7f7f7f7f); \
        else { _Pragma("unroll") for (int k = 0; k < 2; ++k) acc[ai][bj][m][n] = __builtin_amdgcn_mfma_f32_16x16x32_bf16(Bt[n][k], At[m][k], acc[ai][bj][m][n], 0, 0, 0); } } \
        __builtin_amdgcn_s_setprio(0); } while (0)
#define PG8_WAIT_V(n) asm volatile("s_waitcnt vmcnt(" #n ")" ::: "memory")
#define PG8_WAIT_L(n) asm volatile("s_waitcnt lgkmcnt(" #n ")" ::: "memory")
#define PG8_BAR __builtin_amdgcn_s_barrier()
#define PG8_SCHED __builtin_amdgcn_sched_barrier(0)
    Unit cur, nxt; int ui = 0;
    if (!S.next(0, cur)) return;
    f32x4 acc[2][2][4][2];
#pragma unroll
    for (int a = 0; a < 2; ++a)
#pragma unroll
        for (int b = 0; b < 2; ++b)
#pragma unroll
            for (int m = 0; m < 4; ++m)
#pragma unroll
                for (int n = 0; n < 2; ++n) acc[a][b][m][n] = (f32x4){0.f, 0.f, 0.f, 0.f};
    bf16x8 At[4][2], B0[2][2], B1[2][2];
    i32x8 At8[4], B08[2], B18[2];
    const char* cA = (const char*)g.A + (size_t)cur.pm * tsA + (size_t)cur.kofs * ESZ * kofA; const char* cB = (const char*)g.Bt + (size_t)cur.pn * tsB + (size_t)cur.kofs * ESZ;
    PG8_STAGE(PG8_SB(0, 0), cB, voffB); PG8_STAGE(PG8_SB(0, 1), cB + hsB, voffB); PG8_STAGE(PG8_SA(0, 0), cA, voffA); PG8_STAGE(PG8_SA(0, 1), cA + hsA, voffA);
    if (wr == 1) PG8_BAR;
    PG8_WAIT_V(2); PG8_BAR;
    PG8_STAGE(PG8_SB(1, 0), cB + kstep, voffB); PG8_STAGE(PG8_SA(1, 0), cA + kstepA, voffA); PG8_STAGE(PG8_SB(1, 1), cB + hsB + kstep, voffB);
    PG8_WAIT_V(6); PG8_BAR;
    for (;;) {
        const bool has_next = S.next(ui + 1, nxt);
        const char* nA = has_next ? (const char*)g.A + (size_t)nxt.pm * tsA + (size_t)nxt.kofs * ESZ * kofA : cA; const char* nB = has_next ? (const char*)g.Bt + (size_t)nxt.pn * tsB + (size_t)nxt.kofs * ESZ : cB;
        const int nt = cur.nt;
        for (int t = 0; t < nt; t += 2) {
            const bool last = (t == nt - 2);
            const char* a1 = cA + (size_t)(t + 1) * kstepA;
            const char* a2 = last ? nA : cA + (size_t)(t + 2) * kstepA; const char* b2 = last ? nB : cB + (size_t)(t + 2) * kstep;
            const char* a3 = a2 + kstepA; const char* b3 = b2 + kstep;
            PG8_LDB(B0, 0, 0); PG8_LDB(B1, 0, 1); PG8_SCHED; PG8_LDA(At, 0, 0); PG8_STAGE(PG8_SA(1, 1), a1 + hsA, voffA);
            PG8_WAIT_V(8); PG8_WAIT_L(0); PG8_BAR; PG8_MMA(0, 0, At, B0); PG8_MMA(0, 1, At, B1); PG8_BAR; PG8_SCHED;
            PG8_LDA(At, 0, 1); PG8_STAGE(PG8_SB(0, 0), b2, voffB); PG8_STAGE(PG8_SB(0, 1), b2 + hsB, voffB); PG8_STAGE(PG8_SA(0, 0), a2, voffA);
            PG8_WAIT_V(8); PG8_WAIT_L(0); PG8_BAR; PG8_MMA(1, 0, At, B0); PG8_MMA(1, 1, At, B1); PG8_BAR; PG8_SCHED;
            PG8_LDB(B0, 1, 0); PG8_LDB(B1, 1, 1); PG8_SCHED; PG8_LDA(At, 1, 0); PG8_STAGE(PG8_SA(0, 1), a2 + hsA, voffA);
            PG8_WAIT_V(8); PG8_WAIT_L(0); PG8_BAR; PG8_MMA(0, 0, At, B0); PG8_MMA(0, 1, At, B1); PG8_BAR; PG8_SCHED;
            PG8_LDA(At, 1, 1); PG8_STAGE(PG8_SB(1, 0), b3, voffB); PG8_STAGE(PG8_SB(1, 1), b3 + hsB, voffB); PG8_STAGE(PG8_SA(1, 0), a3, voffA);
            PG8_WAIT_V(8); PG8_WAIT_L(0); PG8_BAR; PG8_MMA(1, 0, At, B0); PG8_MMA(1, 1, At, B1); PG8_BAR; PG8_SCHED;
        }
        if (wr == 0) PG8_BAR;
        E(acc, cur, wr, wc, fr, fq);
        if (!has_next) break;
        if (!(Epi::KEEP_ACC && cur.tag < 2))
#pragma unroll
        for (int a = 0; a < 2; ++a)
#pragma unroll
            for (int b = 0; b < 2; ++b)
#pragma unroll
                for (int m = 0; m < 4; ++m)
#pragma unroll
                    for (int n = 0; n < 2; ++n) acc[a][b][m][n] = (f32x4){0.f, 0.f, 0.f, 0.f};
        cur = nxt; cA = nA; cB = nB; ++ui;
        if (wr == 1) PG8_BAR;
    }
    PG8_WAIT_V(0);
    PG8_BAR;
#undef PG8_SA
#undef PG8_SB
#undef PG8_STAGE
#undef PG8_LDA
#undef PG8_LDB
#undef PG8_MMA
#undef PG8_WAIT_V
#undef PG8_WAIT_L
#undef PG8_BAR
#undef PG8_SCHED
}

__device__ __forceinline__ float sigmoidf_(float x) { return __builtin_amdgcn_rcpf(1.f + __expf(-x)); }

__device__ __forceinline__ size_t mg8_off(int row, int col) { return ((size_t)(row >> 4) * 96 + (size_t)(col >> 5)) * 512 + (size_t)((row & 15) * 32 + (col & 31)); }
struct EpiProj {
    static constexpr bool PERM = true, KEEP_ACC = false;
    bf16_t* P; unsigned char* MG8; const float* cosT; const float* sinT; int coloff; float ascale;
    __device__ __forceinline__ void operator()(const f32x4 (&acc)[2][2][4][2], const Unit& u, int wr, int wc, int fr, int fq) const {
        { const int l_ = opaque_lane(); fr = l_ & 15; fq = l_ >> 4; }
        const int row0 = u.pm * BM + wr * 64 + fr;
#pragma unroll
        for (int bj = 0; bj < 2; ++bj) {
            const int colg = coloff + u.pn * BM + bj * HALF + wc * 32;
            const int col = colg + 8 * fq;
            const bool cik = (colg >= C_IK && colg < C_IK + 64);
            bf16_t* dbase = cik ? (bf16_t*)((char*)P - (WS_P - WS_IKC)) + (size_t)((col - C_IK) >> 5) * MC * 32 + ((col - C_IK) & 31) : P + p_col(col);
            #define DROW(row_) (cik ? (size_t)(row_) * 32 : p_off((row_), 0))
            if (colg < C_ROPE_END) {
                const int f4 = ((col & 63) >> 3) * 4;
                const float sc = ((colg < C_IQ || (colg >= C_BQ && colg < C_CK)) ? QSCALE : 1.f) * ascale;
#pragma unroll
                for (int ai = 0; ai < 2; ++ai) {
                    f32x4 cc[4], ss[4];
#pragma unroll
                    for (int m = 0; m < 4; ++m) { const int t = (row0 + ai * HALF + m * 16) & (SEQ - 1); cc[m] = *(const f32x4*)(cosT + t * 32 + f4); ss[m] = *(const f32x4*)(sinT + t * 32 + f4); }
#pragma unroll
                    for (int m = 0; m < 4; ++m) {
                        const int row = row0 + ai * HALF + m * 16;
                        const f32x4 c = cc[m], s = ss[m];
                        const f32x4 v0 = acc[ai][bj][m][0], v1 = acc[ai][bj][m][1];
                        const f32x4 o0 = (v0 * c - v1 * s) * sc, o1 = (v0 * s + v1 * c) * sc;
                        u32x4 w; w.x = cvtpk(o0[0], o0[1]); w.y = cvtpk(o0[2], o0[3]); w.z = cvtpk(o1[0], o1[1]); w.w = cvtpk(o1[2], o1[3]);
                        *(u32x4*)(dbase + DROW(row)) = w;
                    }
                    asm volatile("" ::: "memory");
                }
                asm volatile("" ::: "memory");
            } else if (colg < C_SIG_END) {
                const int mode = (colg < C_PLAIN_END) ? 0 : (colg < C_SILU_END ? 1 : 2);
#pragma unroll
                for (int ai = 0; ai < 2; ++ai)
#pragma unroll
                    for (int m = 0; m < 4; ++m) {
                        const int row = row0 + ai * HALF + m * 16;
                        f32x4 v0 = acc[ai][bj][m][0] * ascale, v1 = acc[ai][bj][m][1] * ascale;
                        if (mode != 0) {
#pragma unroll
                            for (int e = 0; e < 4; ++e) { const float s0 = sigmoidf_(v0[e]), s1 = sigmoidf_(v1[e]); v0[e] = (mode == 1) ? v0[e] * s0 : s0; v1[e] = (mode == 1) ? v1[e] * s1 : s1; }
                        }
                        if (mode == 2) { u32x2 w; w.x = pk4_fp8(v0[0], v0[1], v0[2], v0[3]); w.y = pk4_fp8(v1[0], v1[1], v1[2], v1[3]);
                            *(u32x2*)(MG8 + mg8_off(row, col - C_MG)) = w; }
                        else { u32x4 w; w.x = cvtpk(v0[0], v0[1]); w.y = cvtpk(v0[2], v0[3]); w.z = cvtpk(v1[0], v1[1]); w.w = cvtpk(v1[2], v1[3]);
                            *(u32x4*)(P + p_off(row, col)) = w; }
                    }
            }
        }
    }
};

struct EpiMerge {
    static constexpr bool PERM = true, KEEP_ACC = true;
    const unsigned char* MG8; bf16_t* Mg; float ascale;
    __device__ __forceinline__ void operator()(f32x4 (&acc)[2][2][4][2], const Unit& u, int wr, int wc, int fr, int fq) const {
        { const int l_ = opaque_lane(); fr = l_ & 15; fq = l_ >> 4; }
        const int row0 = u.pm * BM + wr * 64 + fr; const int br = u.tag;
        const int colb = u.pn * BM + wc * 32 + 8 * fq;
        const float GMIN = 1e-18f;
#pragma unroll
        for (int ai = 0; ai < 2; ++ai) {
            u32x2 gt[4][2], gn[4][2];
#pragma unroll
            for (int m = 0; m < 4; ++m)
#pragma unroll
                for (int bj = 0; bj < 2; ++bj) gt[m][bj] = *(const u32x2*)(MG8 + mg8_off(row0 + ai * HALF + m * 16, br * 1024 + colb + bj * HALF));
            if (br != 2) {
#pragma unroll
                for (int m = 0; m < 4; ++m)
#pragma unroll
                    for (int bj = 0; bj < 2; ++bj) gn[m][bj] = *(const u32x2*)(MG8 + mg8_off(row0 + ai * HALF + m * 16, (br + 1) * 1024 + colb + bj * HALF));
            }
#pragma unroll
            for (int m = 0; m < 4; ++m)
#pragma unroll
                for (int bj = 0; bj < 2; ++bj) {
                    f32x4 v0 = acc[ai][bj][m][0], v1 = acc[ai][bj][m][1];
                    { const f32x2 a = __builtin_amdgcn_cvt_pk_f32_fp8((int)gt[m][bj].x, false), b = __builtin_amdgcn_cvt_pk_f32_fp8((int)gt[m][bj].x, true), c = __builtin_amdgcn_cvt_pk_f32_fp8((int)gt[m][bj].y, false), d = __builtin_amdgcn_cvt_pk_f32_fp8((int)gt[m][bj].y, true);
                      v0[0] *= __builtin_fmaxf(a.x, GMIN); v0[1] *= __builtin_fmaxf(a.y, GMIN); v0[2] *= __builtin_fmaxf(b.x, GMIN); v0[3] *= __builtin_fmaxf(b.y, GMIN);
                      v1[0] *= __builtin_fmaxf(c.x, GMIN); v1[1] *= __builtin_fmaxf(c.y, GMIN); v1[2] *= __builtin_fmaxf(d.x, GMIN); v1[3] *= __builtin_fmaxf(d.y, GMIN); }
                    if (br != 2) {
                        { const f32x2 a = __builtin_amdgcn_cvt_pk_f32_fp8((int)gn[m][bj].x, false), b = __builtin_amdgcn_cvt_pk_f32_fp8((int)gn[m][bj].x, true), c = __builtin_amdgcn_cvt_pk_f32_fp8((int)gn[m][bj].y, false), d = __builtin_amdgcn_cvt_pk_f32_fp8((int)gn[m][bj].y, true);
                          v0[0] *= __builtin_amdgcn_rcpf(__builtin_fmaxf(a.x, GMIN)); v0[1] *= __builtin_amdgcn_rcpf(__builtin_fmaxf(a.y, GMIN)); v0[2] *= __builtin_amdgcn_rcpf(__builtin_fmaxf(b.x, GMIN)); v0[3] *= __builtin_amdgcn_rcpf(__builtin_fmaxf(b.y, GMIN));
                          v1[0] *= __builtin_amdgcn_rcpf(__builtin_fmaxf(c.x, GMIN)); v1[1] *= __builtin_amdgcn_rcpf(__builtin_fmaxf(c.y, GMIN)); v1[2] *= __builtin_amdgcn_rcpf(__builtin_fmaxf(d.x, GMIN)); v1[3] *= __builtin_amdgcn_rcpf(__builtin_fmaxf(d.y, GMIN)); }
                        acc[ai][bj][m][0] = v0; acc[ai][bj][m][1] = v1;
                    } else {
                        const float sm_ = F8_SM * ascale;
                        u32x2 w; w.x = pk4_fp8(v0[0] * sm_, v0[1] * sm_, v0[2] * sm_, v0[3] * sm_); w.y = pk4_fp8(v1[0] * sm_, v1[1] * sm_, v1[2] * sm_, v1[3] * sm_);
                        *(u32x2*)((unsigned char*)Mg + g_off(row0 + ai * HALF + m * 16, colb + bj * HALF, DM)) = w;
                    }
                }
            asm volatile("" ::: "memory");
        }
    }
};

struct EpiResid {
    static constexpr bool PERM = false, KEEP_ACC = false;
    const float* xin; float* out; float ascale;
    __device__ __forceinline__ void operator()(const f32x4 (&acc)[2][2][4][2], const Unit& u, int wr, int wc, int fr, int fq) const {
        { const int l_ = opaque_lane(); fr = l_ & 15; fq = l_ >> 4; }
        const int row0 = u.pm * BM + wr * 64 + fr; const int col0 = u.pn * BM + wc * 32 + 4 * fq;
#pragma unroll
        for (int ai = 0; ai < 2; ++ai)
#pragma unroll
            for (int mp = 0; mp < 4; mp += 2) {
                f32x4 bs[2][2][2];
#pragma unroll
                for (int m = 0; m < 2; ++m)
#pragma unroll
                    for (int bj = 0; bj < 2; ++bj)
#pragma unroll
                        for (int n = 0; n < 2; ++n) bs[m][bj][n] = *(const f32x4*)(xin + (size_t)(row0 + ai * HALF + (mp + m) * 16) * DM + col0 + bj * HALF + n * 16);
#pragma unroll
                for (int m = 0; m < 2; ++m)
#pragma unroll
                    for (int bj = 0; bj < 2; ++bj)
#pragma unroll
                        for (int n = 0; n < 2; ++n) *(f32x4*)(out + (size_t)(row0 + ai * HALF + (mp + m) * 16) * DM + col0 + bj * HALF + n * 16) = bs[m][bj][n] + acc[ai][bj][mp + m][n] * ascale;
                asm volatile("" ::: "memory");
            }
    }
};
}

template <class T> __device__ __forceinline__ T* launder(T* p) { asm volatile("" : "+s"(p)); return p; }
#define XB_TMO      128
#define XB_XCNT(j)  (256  + 64 * (j))
#define XB_XSUB(j)  (1280 + 64 * (j))
#define XB_XGEN(j)  (2304 + 64 * (j))
#define XB_TOP      3328
#define XB_TOPGEN   3392
#define XCD_BAR_WORDS 3456
#define XB_SPIN_CAP (1u << 18)
__device__ __forceinline__ unsigned xb_ld(unsigned* p)              { return __hip_atomic_load(p, __ATOMIC_RELAXED, __HIP_MEMORY_SCOPE_AGENT); }
__device__ __forceinline__ unsigned xb_add(unsigned* p, unsigned v) { return __hip_atomic_fetch_add(p, v, __ATOMIC_RELAXED, __HIP_MEMORY_SCOPE_AGENT); }
__device__ __forceinline__ unsigned xb_xcc_id() { return (unsigned)__builtin_amdgcn_s_getreg((3 << 11) | 20) & 0xFu; }
#define XB_SPIN(cond, bar) do { unsigned _sp = 0; while (cond) { __builtin_amdgcn_s_sleep(1); \
    if ((++_sp & 255u) == 0u) { if (xb_ld(&(bar)[XB_TMO])) break; if (_sp > XB_SPIN_CAP) { atomicAdd(&(bar)[XB_TMO], 1u); break; } } } } while (0)
struct XcdBarrier { unsigned* bar; unsigned x; volatile LAS unsigned* st; };
__device__ __forceinline__ XcdBarrier xcd_barrier_post(unsigned* bar, volatile LAS unsigned* st) {
    XcdBarrier b; b.bar = bar; b.x = xb_xcc_id(); b.st = st;
    if (threadIdx.x == 0) (void)xb_add(&bar[XB_XCNT(b.x)], 1u);
    return b;
}
__device__ __forceinline__ void xcd_barrier_complete(unsigned* bar, unsigned x, unsigned& nloc, unsigned& nx) {
    const unsigned G = gridDim.x * gridDim.y * gridDim.z;
    unsigned sum, cnt, mine, sp = 0u;
    for (;;) {
        sum = 0u; cnt = 0u; mine = 0u;
#pragma unroll
        for (unsigned j = 0; j < 16; ++j) { const unsigned c = xb_ld(&bar[XB_XCNT(j)]); sum += c; cnt += (c > 0u) ? 1u : 0u; mine = (j == x) ? c : mine; }
        if (sum == G) break;
        __builtin_amdgcn_s_sleep(1);
        if ((++sp & 255u) == 0u) { if (xb_ld(&bar[XB_TMO])) break; if (sp > XB_SPIN_CAP) { atomicAdd(&bar[XB_TMO], 1u); break; } }
    }
    nloc = mine > 0u ? mine : 1u; nx = cnt > 0u ? cnt : 1u;
}
template <bool FIRST> __device__ __forceinline__ void xcd_barrier(const XcdBarrier& b, int wave) {
    asm volatile("s_waitcnt vmcnt(0)" ::: "memory");
    __syncthreads();
    if (opaque_tid(wave) == 0) {
        unsigned* bar = launder(b.bar);
        unsigned bx = b.x; asm volatile("" : "+s"(bx));
        __builtin_amdgcn_s_waitcnt(0);
        unsigned nloc = b.st[0], nx = b.st[1];
        if (FIRST) { xcd_barrier_complete(bar, bx, nloc, nx); b.st[0] = nloc; b.st[1] = nx; }
        const unsigned old = xb_add(&bar[XB_XSUB(bx)], 1u);
        const unsigned gen = old / nloc;
        if (old + 1u == (gen + 1u) * nloc) {
            __builtin_amdgcn_fence(__ATOMIC_RELEASE, "agent");
            asm volatile("s_waitcnt vmcnt(0)" ::: "memory");
            const unsigned og = xb_add(&bar[XB_TOP], 1u);
            const unsigned tg = og / nx;
            if (og + 1u == (tg + 1u) * nx) xb_add(&bar[XB_TOPGEN], 1u);
            else XB_SPIN(xb_ld(&bar[XB_TOPGEN]) == tg, bar);
            __builtin_amdgcn_fence(__ATOMIC_ACQUIRE, "agent");
            xb_add(&bar[XB_XGEN(bx)], 1u);
            asm volatile("s_waitcnt vmcnt(0)" ::: "memory");
        } else {
            XB_SPIN(xb_ld(&bar[XB_XGEN(bx)]) == gen, bar);
            __builtin_amdgcn_fence(__ATOMIC_ACQUIRE, "agent");
            asm volatile("s_waitcnt vmcnt(0)" ::: "memory");
        }
    }
    __syncthreads();
}

struct Frame {
    LAS unsigned char* lds;
    volatile LAS unsigned* MISC;
    gu32* ctl;
    int tid, lane, wave, G;
};

__device__ __forceinline__ float wave_sum(float v) {
    v += __int_as_float(__builtin_amdgcn_update_dpp(0, __float_as_int(v), 0xB1, 0xf, 0xf, false));
    v += __int_as_float(__builtin_amdgcn_update_dpp(0, __float_as_int(v), 0x4E, 0xf, 0xf, false));
    v += __int_as_float(__builtin_amdgcn_update_dpp(0, __float_as_int(v), 0x141, 0xf, 0xf, false));
    v += __int_as_float(__builtin_amdgcn_update_dpp(0, __float_as_int(v), 0x140, 0xf, 0xf, false));
    v += __int_as_float(__builtin_amdgcn_update_dpp(0, __float_as_int(v), 0x142, 0xa, 0xf, false));
    v += __int_as_float(__builtin_amdgcn_update_dpp(0, __float_as_int(v), 0x143, 0xc, 0xf, false));
    return __int_as_float(__builtin_amdgcn_readlane(__float_as_int(v), 63));
}
__device__ __forceinline__ float shfl_xor_l(float v, int mask, int lane) { return __int_as_float(__builtin_amdgcn_ds_bpermute((lane ^ mask) << 2, __float_as_int(v))); }

__device__ __forceinline__ int src_col(int n) {
    if (n < C_ROPE_END) {
        int bn, bo;
        if (n < 384) { bn = 0; bo = 0; } else if (n < 640) { bn = 384; bo = 2432; } else if (n < 704) { bn = 640; bo = 2688; }
        else if (n < 768) { bn = 704; bo = 1920; } else if (n < 1152) { bn = 768; bo = 384; } else if (n < 1536) { bn = 1152; bo = 1536; }
        else if (n < 2304) { bn = 1536; bo = 2756; } else { bn = 2304; bo = 3524; }
        const int r = n - bn, head = r >> 6, p = r & 63, i = p >> 3, e = p & 7;
        const int dim = (e < 4) ? 4 * i + e : 32 + 4 * i + (e - 4);
        return bo + head * 64 + dim;
    }
    if (n < 3456) return 768 + (n - 3072);
    if (n < 3520) return 1984 + (n - 3456);
    if (n < 4288) return 4292 + (n - 3520);
    if (n < 4672) return 1152 + (n - 4288);
    if (n < 5056) return 2048 + (n - 4672);
    if (n < 5312) return 5060 + (n - 5056);
    if (n < 8384) return 5316 + (n - 5312);
    return -1;
}

template <bool PERMUTE, bool F8OUT = false>
__device__ __forceinline__ void transpose_item(const float* W, int ldw, int nblk, bf16_t* WT, int ldt, int koff, LAS float* scr, int item, int lane, int nbase = 0, int nrow0 = 0) {
    const int kb = item / nblk, nb = item % nblk, k0 = 64 * kb, n0 = nbase + 32 * nb;
    const int sc = PERMUTE ? src_col(n0 + (lane & 31)) : (n0 + (lane & 31));
    float wv[32];
    const float* wp = W + (size_t)(k0 + (lane >> 5)) * ldw + (sc >= 0 ? sc : 0);
#pragma unroll
    for (int i = 0; i < 32; ++i) wv[i] = wp[(size_t)(2 * i) * ldw];
#pragma unroll
    for (int i = 0; i < 32; ++i) { const int kk = 2 * i + (lane >> 5); scr[kk * 33 + (lane & 31)] = (sc >= 0) ? wv[i] : 0.f; }
    LDS_WAIT(); asm volatile("" ::: "memory");
    const int c = lane & 7;
#pragma unroll
    for (int j = 0; j < 4; ++j) { const int n = (lane >> 3) + 8 * j; const LAS float* s = scr + (8 * c) * 33 + n;
        if (F8OUT) { u32x2 o; o.x = pk4_fp8(s[0 * 33] * F8_SB, s[1 * 33] * F8_SB, s[2 * 33] * F8_SB, s[3 * 33] * F8_SB); o.y = pk4_fp8(s[4 * 33] * F8_SB, s[5 * 33] * F8_SB, s[6 * 33] * F8_SB, s[7 * 33] * F8_SB);
            *(u32x2*)((unsigned char*)WT + (size_t)(n0 - nrow0 + n) * ldt + koff + k0 + 8 * c) = o; }
        else { u32x4 o; o.x = pk2(s[0 * 33], s[1 * 33]); o.y = pk2(s[2 * 33], s[3 * 33]); o.z = pk2(s[4 * 33], s[5 * 33]); o.w = pk2(s[6 * 33], s[7 * 33]);
            *(u32x4*)(WT + (size_t)(n0 + n) * ldt + koff + k0 + 8 * c) = o; } }
    LDS_WAIT(); asm volatile("" ::: "memory");
}

template <bool TO_BF16, int NB>
__device__ __forceinline__ void rms_rows(const float* xrow, const float* g, void* orow, unsigned char* o8row, float* iwrow, const float* wiw, int lane) {
    f32x4 v[NB][4];
#pragma unroll
    for (int r = 0; r < NB; ++r) { const f32x4* xr = (const f32x4*)(xrow + (size_t)r * DM) + lane;
#pragma unroll
        for (int j = 0; j < 4; ++j) v[r][j] = xr[64 * j]; }
    const f32x4* gr = (const f32x4*)g + lane;
    f32x4 gv[4];
#pragma unroll
    for (int j = 0; j < 4; ++j) gv[j] = gr[64 * j];
#pragma unroll
    for (int r = 0; r < NB; ++r) {
        float s = 0.f;
#pragma unroll
        for (int j = 0; j < 4; ++j) s += (v[r][j].x * v[r][j].x + v[r][j].y * v[r][j].y) + (v[r][j].z * v[r][j].z + v[r][j].w * v[r][j].w);
        const float rs = 1.f / sqrtf(wave_sum(s) * (1.f / DM) + RMS_EPS);
#pragma unroll
        for (int j = 0; j < 4; ++j) v[r][j] = v[r][j] * rs * gv[j];
        if (TO_BF16) {
            u64* o8 = (u64*)((bf16_t*)orow + (size_t)r * DM) + lane;
            unsigned* o4 = (unsigned*)(o8row + (size_t)r * DM) + lane;
#pragma unroll
            for (int j = 0; j < 4; ++j) { const f32x4 w = v[r][j]; o8[64 * j] = (u64)pk2(w.x, w.y) | ((u64)pk2(w.z, w.w) << 32);
                o4[64 * j] = pk4_fp8(w.x * F8_SA, w.y * F8_SA, w.z * F8_SA, w.w * F8_SA); }
        } else {
            f32x4* o = (f32x4*)((float*)orow + (size_t)r * DM) + lane;
#pragma unroll
            for (int j = 0; j < 4; ++j) o[64 * j] = v[r][j];
        }
    }
    if (TO_BF16) {
        f32x4 acc[NB];
#pragma unroll
        for (int r = 0; r < NB; ++r) acc[r] = (f32x4){0.f, 0.f, 0.f, 0.f};
#pragma unroll
        for (int j = 0; j < 4; ++j) {
            f32x4 wk[4];
#pragma unroll
            for (int e = 0; e < 4; ++e) wk[e] = *(const f32x4*)(wiw + (size_t)(256 * j + 4 * lane + e) * INW);
#pragma unroll
            for (int r = 0; r < NB; ++r) acc[r] += wk[0] * v[r][j].x + wk[1] * v[r][j].y + wk[2] * v[r][j].z + wk[3] * v[r][j].w;
        }
#pragma unroll
        for (int r = 0; r < NB; ++r) { f32x4 t; t.x = wave_sum(acc[r].x); t.y = wave_sum(acc[r].y); t.z = wave_sum(acc[r].z); t.w = wave_sum(acc[r].w);
            if (lane == 0) *(f32x4*)(iwrow + (size_t)r * 4) = t * 0.0625f; }
    }
}

namespace att {
constexpr int SLOTB = 8192, NSLOT = 4;
constexpr size_t PO_STRIDE = (size_t)MC * 4 * 64, PML_STRIDE = (size_t)MC * 4 * 2;
constexpr int L_K = 0, L_V = NSLOT * SLOTB, L_M = 2 * NSLOT * SLOTB, L_KM = L_M + NSLOT * 2048, L_LUT = L_KM + 2048;
typedef LAS const char* lds_cptr;
typedef short v4i16_t __attribute__((ext_vector_type(4)));
__device__ __forceinline__ s16x4 vtr(lds_cptr p) { return __builtin_bit_cast(s16x4, __builtin_amdgcn_ds_read_tr16_b64_v4i16((LAS v4i16_t*)p)); }
__device__ __forceinline__ float swap_add(float v) { auto rr = __builtin_amdgcn_permlane32_swap(__float_as_uint(v), __float_as_uint(v), false, false); return __uint_as_float(rr[0]) + __uint_as_float(rr[1]); }
__device__ __forceinline__ float swap_max(float v) { auto rr = __builtin_amdgcn_permlane32_swap(__float_as_uint(v), __float_as_uint(v), false, false); return __builtin_fmaxf(__uint_as_float(rr[0]), __uint_as_float(rr[1])); }
__device__ __forceinline__ float fadd_s(float a, float b) { float r; asm("v_add_f32_e32 %0, %1, %2" : "=v"(r) : "v"(a), "v"(b)); return r; }
__device__ __forceinline__ float fmax_s(float a, float b) { float r; asm("v_max_f32_e32 %0, %1, %2" : "=v"(r) : "v"(a), "v"(b)); return r; }
__device__ __forceinline__ float fmax3_s(float a, float b, float c) { float r; asm("v_max3_f32 %0, %1, %2, %3" : "=v"(r) : "v"(a), "v"(b), "v"(c)); return r; }
__device__ __forceinline__ void glds16(const void* gsrc, unsigned lds_dst) { unsigned keep;
    asm volatile("s_mov_b32 %0, m0\n\ts_mov_b32 m0, %2\n\ts_nop 0\n\tglobal_load_lds_dwordx4 %1, off\n\ts_mov_b32 m0, %0" : "=&s"(keep) : "v"(gsrc), "s"(lds_dst) : "memory"); }
__device__ __forceinline__ void glds4(const void* gsrc, unsigned lds_dst) { unsigned keep;
    asm volatile("s_mov_b32 %0, m0\n\ts_mov_b32 m0, %2\n\ts_nop 0\n\tglobal_load_lds_dword %1, off\n\ts_mov_b32 m0, %0" : "=&s"(keep) : "v"(gsrc), "s"(lds_dst) : "memory"); }
#define WAITBAR(N) asm volatile("s_waitcnt vmcnt(" #N ") lgkmcnt(0)\n\ts_barrier" ::: "memory")

template <int MODE>
__device__ __forceinline__ void attn_unit(LAS unsigned char* lds, const bf16_t* __restrict__ P, bf16_t* __restrict__ Y, const u64* __restrict__ bits, float* __restrict__ PO, float* __restrict__ PML, int rowbase, int hsel, int blk, int wave) {
    wave = opaque_wave(wave);
    const int tid = opaque_tid(wave), lane = tid & 63, r32 = lane & 31, hi = lane >> 5; const int wid = wave;
    constexpr int RS = (MODE == 3) ? 8 : (MODE == 4) ? 4 : 1;
    const int roff = (MODE == 3) ? blk : (MODE == 4) ? (blk & 3) : 0;
    const int T0 = (MODE == 3) ? 0 : (MODE == 4) ? 256 * (blk >> 2) : blk * 256, qw0 = T0 + wid * 32, qpos = qw0 + r32;
    const int qtok = roff + RS * qpos;
    const float NEG = -INFINITY;
    constexpr int NDMA = (MODE == 1) ? 3 : 2;
    int n0 = 0, n1 = 0, s0 = 0, s1 = 0, NT;
    if (MODE == 0) NT = 4 + 4 * blk;
    else if (MODE == 1) NT = 4 * (blk + 1);
    else if (MODE == 3) NT = 4;
    else { s0 = T0 >= 128 ? T0 - 128 : 0; n0 = (T0 + 256 - s0) >> 6; NT = n0; }
    const int ycol = (MODE == 0) ? 64 * hsel : (MODE == 1) ? 384 + 64 * hsel : 768 + 64 * hsel;
    const int ycol8 = (MODE == 0) ? 64 * hsel : (MODE == 1) ? 512 + 64 * hsel : 1024 + 64 * hsel;
#define TILE_INFO(t, row0, seg) do { if (MODE == 0) { if ((t) < 4) { seg = 0; row0 = T0 + 64 * (t); } else { seg = 1; row0 = 64 * ((t) - 4); } } \
        else if (MODE == 1 || MODE == 3) { seg = (MODE == 3) ? 2 : 0; row0 = 64 * (t); } \
        else { seg = (MODE == 4) ? 1 : 0; row0 = s0 + 64 * (t); } } while (0)
#define KCOL(seg) ((MODE == 0) ? (C_AK + 64 * hsel) : (MODE == 1) ? C_BK : (C_CK + 64 * (4 * (seg) + hsel)))
#define VCOL(seg) ((MODE == 0) ? (C_AV + 64 * hsel) : (MODE == 1) ? C_BV : (C_CV + 64 * (4 * (seg) + hsel)))
#define QCOL(seg) ((MODE == 0) ? (C_AQ + 64 * hsel) : (MODE == 1) ? (C_BQ + 64 * hsel) : (C_CQ + 64 * (4 * (seg) + hsel)))
    const unsigned lds0 = (unsigned)(uintptr_t)lds;
    const u64* brow_dma = bits + (size_t)(rowbase + T0 + 32 * wid + (lane >> 1)) * 32;
    const char* kbase_l = (const char*)(P + p_off(rowbase + roff + RS * lane, wid * 8));
    const char* vbase_l = (const char*)(P + p_off(rowbase + roff + RS * (16 * (wid & 3) + (lane >> 2)), (wid >> 2) * 32 + (lane & 3) * 8));
#define ISSUE(t) do { int row0_, seg_; TILE_INFO((t), row0_, seg_); const int slot_ = (t) & (NSLOT - 1); \
        const size_t ko_ = (p_off(row0_ * RS, 0) + p_col(KCOL(seg_))) * 2, vo_ = (p_off(row0_ * RS, 0) + p_col(VCOL(seg_))) * 2;     \
        glds16(kbase_l + ko_, (unsigned)__builtin_amdgcn_readfirstlane(lds0 + L_K + slot_ * SLOTB + wid * 1024)); \
        glds16(vbase_l + vo_, (unsigned)__builtin_amdgcn_readfirstlane(lds0 + L_V + slot_ * SLOTB + wid * 1024)); \
        if (MODE == 1) glds4((const unsigned*)(brow_dma + (t)) + (lane & 1), (unsigned)__builtin_amdgcn_readfirstlane(lds0 + L_M + slot_ * 2048 + wid * 256)); } while (0)

    const bf16_t* qrow = P + p_off(rowbase + qtok, 0);
    asm volatile("s_waitcnt vmcnt(0)" ::: "memory");
    ISSUE(0);
    if (NT > 1) ISSUE(1);
    if (NT > 2) ISSUE(2);
    constexpr int NQ = 1;
    constexpr int QS0 = (MODE == 3) ? 2 : (MODE == 4) ? 1 : 0;
    bf16x8 qr[NQ][4];
#pragma unroll
    for (int sg = 0; sg < NQ; ++sg)
#pragma unroll
        for (int d0 = 0; d0 < 4; ++d0) qr[sg][d0] = *(const bf16x8*)(qrow + p_col(QCOL(QS0 + sg) + d0 * 16 + hi * 8));
    unsigned sel = 0u;
    if (MODE == 0) {
        LAS float* km = (LAS float*)(lds + L_KM);
        if (wid < blk) {
            const int c = lane & 7, rg = lane >> 3; float a[8];
#pragma unroll
            for (int e = 0; e < 8; ++e) a[e] = 0.f;
            const bf16_t* kp = P + p_off(rowbase + 256 * wid + rg, C_AK + 64 * hsel + 8 * c);
#pragma unroll 8
            for (int i = 0; i < 32; ++i) { const bf16x8 v = *(const bf16x8*)(kp + (size_t)(i >> 1) * PBLK * 512 + (size_t)(i & 1) * 256);
#pragma unroll
                for (int e = 0; e < 8; ++e) a[e] += bf2f(v[e]); }
#pragma unroll
            for (int e = 0; e < 8; ++e) { a[e] += shfl_xor_l(a[e], 8, lane); a[e] += shfl_xor_l(a[e], 16, lane); a[e] += shfl_xor_l(a[e], 32, lane); }
            if (rg == 0) {
#pragma unroll
                for (int e = 0; e < 8; ++e) km[wid * 64 + 8 * c + e] = a[e] * (1.f / 256.f);
            }
        }
        __syncthreads();
        float g[7];
#pragma unroll
        for (int j = 0; j < 7; ++j) {
            float part = 0.f;
            if (j < blk) {
#pragma unroll
                for (int d0 = 0; d0 < 4; ++d0) { const f32x4 k0 = *(const LAS f32x4*)(km + j * 64 + 16 * d0 + 8 * hi), k1 = *(const LAS f32x4*)(km + j * 64 + 16 * d0 + 8 * hi + 4);
#pragma unroll
                    for (int e = 0; e < 4; ++e) part += bf2f(qr[0][d0][e]) * k0[e] + bf2f(qr[0][d0][4 + e]) * k1[e]; }
                part = swap_add(part);
            }
            g[j] = (j < blk) ? part : NEG;
        }
#pragma unroll
        for (int rep = 0; rep < 3; ++rep) { float bv = NEG; int best = -1;
#pragma unroll
            for (int j = 0; j < 7; ++j) { const bool ok = (j < blk) && !((sel >> j) & 1u) && (g[j] > bv); if (ok) { bv = g[j]; best = j; } }
            if (best >= 0) sel |= 1u << best; }
    }
    f32x16 o0 = {}, o1 = {}; float m_run = 0.f, l_run = 0.f; f32x16 negm = {}; asm volatile("" : "+v"(negm));
    constexpr float DEFER_THR = 8.f;
    bool fresh = true;
    const lds_cptr lds3 = (lds_cptr)lds;
    const lds_cptr kp0 = lds3 + L_K + hi * 1024 + r32 * 16;
    const lds_cptr vp0 = lds3 + L_V + ((lane >> 4) & 1) * 32 + (lane & 3) * 8 + (4 * hi + ((lane & 15) >> 2)) * 64;
    const lds_cptr mp0 = lds3 + L_M + (32 * wid + r32) * 8;
#pragma unroll
    for (int sg = 0; sg < NQ; ++sg)
#pragma unroll
        for (int d0 = 0; d0 < 4; ++d0) asm volatile("" : "+v"(qr[sg][d0]));
    WAITBAR(0);
    for (int t = 0; t < NT; ++t) {
        int row0, seg; TILE_INFO(t, row0, seg);
        bool active;
        if (MODE == 0) active = (seg == 0) ? (row0 <= qw0 + 31) : (__any((sel >> (row0 >> 8)) & 1u) != 0);
        else if (MODE == 1 || MODE == 3) active = (row0 <= qw0 + 31);
        else active = (row0 <= qw0 + 31) && (row0 + 63 + 128 >= qw0);
        if (!active) { if (t + 3 < NT) ISSUE(t + 3); }
        if (active) {
            const int slot = (t & (NSLOT - 1)) * SLOTB;
            u32x2 mw = {0u, 0u}; if (MODE == 1) mw = *(const LAS u32x2*)(mp0 + (t & (NSLOT - 1)) * 2048);
            bf16x8 kf[8];
            { const lds_cptr kp = kp0 + slot;
#pragma unroll
              for (int j = 0; j < 4; ++j) { kf[2 * j] = *(const LAS bf16x8*)(kp + j * 2048); kf[2 * j + 1] = *(const LAS bf16x8*)(kp + j * 2048 + 512); } }
            if (t + 3 < NT) ISSUE(t + 3);
            s16x4 vlo[2][4], vhi[2][4];
            { const lds_cptr vp = vp0 + slot;
#pragma unroll
              for (int d0 = 0; d0 < 2; ++d0)
#pragma unroll
                  for (int ks = 0; ks < 4; ++ks) { vlo[d0][ks] = vtr(vp + d0 * 4096 + ks * 1024); vhi[d0][ks] = vtr(vp + d0 * 4096 + ks * 1024 + 512); } }
            f32x16 p0 = __builtin_amdgcn_mfma_f32_32x32x16_bf16(kf[0], qr[0][0], negm, 0, 0, 0), p1 = __builtin_amdgcn_mfma_f32_32x32x16_bf16(kf[1], qr[0][0], negm, 0, 0, 0);
#pragma unroll
            for (int d0 = 1; d0 < 4; ++d0) { p0 = __builtin_amdgcn_mfma_f32_32x32x16_bf16(kf[2 * d0], qr[0][d0], p0, 0, 0, 0); p1 = __builtin_amdgcn_mfma_f32_32x32x16_bf16(kf[2 * d0 + 1], qr[0][d0], p1, 0, 0, 0); }
            if (MODE == 0) {
                if (seg == 0) { if (row0 + 63 > qw0) { const int kb = row0 + 4 * hi;
#pragma unroll
                    for (int r = 0; r < 16; ++r) { const int kv = kb + (r & 3) + 8 * (r >> 2); if (kv > qpos) p0[r] = NEG; if (kv + 32 > qpos) p1[r] = NEG; } } }
                else { if (!((sel >> (row0 >> 8)) & 1u)) {
#pragma unroll
                    for (int r = 0; r < 16; ++r) { p0[r] = NEG; p1[r] = NEG; } } }
            } else if (MODE == 1) {
                const int lo = (int)(mw.x >> (4 * hi)), hw = (int)(mw.y >> (4 * hi));
#pragma unroll
                for (int r = 0; r < 16; ++r) { const unsigned m0_ = (unsigned)__builtin_amdgcn_sbfe(lo, (r & 3) + 8 * (r >> 2), 1), m1_ = (unsigned)__builtin_amdgcn_sbfe(hw, (r & 3) + 8 * (r >> 2), 1);
                    p0[r] = __uint_as_float((__float_as_uint(p0[r]) & m0_) | (0xff800000u & ~m0_)); p1[r] = __uint_as_float((__float_as_uint(p1[r]) & m1_) | (0xff800000u & ~m1_)); }
            } else {
                const int lg = (MODE == 3) ? 1 : 0; const int base = qpos - row0 - 4 * hi;
#pragma unroll
                for (int r = 0; r < 16; ++r) { const unsigned d0_ = (unsigned)(base - ((r & 3) + 8 * (r >> 2))), d1_ = d0_ - 32u;
                    if (__builtin_rotateright32(d0_, (unsigned)lg) > 128u) p0[r] = NEG; if (__builtin_rotateright32(d1_, (unsigned)lg) > 128u) p1[r] = NEG; }
            }
            asm volatile("s_nop 11" : "+v"(p0), "+v"(p1));
            float ma = fmax3_s(p0[0], p0[1], p1[0]), mb = fmax3_s(p0[2], p0[3], p1[1]);
            ma = fmax3_s(ma, p1[2], p1[3]);
#pragma unroll
            for (int r = 4; r < 16; r += 4) { ma = fmax3_s(ma, p0[r], p0[r + 1]); mb = fmax3_s(mb, p0[r + 2], p0[r + 3]);
                ma = fmax3_s(ma, p1[r], p1[r + 1]); mb = fmax3_s(mb, p1[r + 2], p1[r + 3]); }
            const float rm = swap_max(__builtin_fmaxf(ma, mb));
            if (fresh || __any(rm > DEFER_THR)) {
                const float dl = fresh ? ((rm == NEG) ? 0.f : rm) : __builtin_fmaxf(rm, 0.f); m_run += dl; fresh = false;
                const float f = __builtin_amdgcn_exp2f(-dl); l_run *= f;
#pragma unroll
                for (int r = 0; r < 16; ++r) { p0[r] -= dl; p1[r] -= dl; o0[r] *= f; o1[r] *= f; negm[r] = -m_run; }
                asm volatile("" : "+v"(negm));
            }
            float ls0 = 0.f, ls1 = 0.f;
#pragma unroll
            for (int r = 0; r < 16; ++r) { p0[r] = __builtin_amdgcn_exp2f(p0[r]); p1[r] = __builtin_amdgcn_exp2f(p1[r]); }
            asm volatile("" : "+v"(p0), "+v"(p1));
#pragma unroll
            for (int r = 0; r < 16; ++r) { ls0 = fadd_s(ls0, p0[r]); ls1 = fadd_s(ls1, p1[r]); }
            l_run = fadd_s(l_run, fadd_s(ls0, ls1));
            u32x4 pw[4];
            pw[0] = (u32x4){cvtpk(p0[0], p0[1]), cvtpk(p0[2], p0[3]), cvtpk(p0[4], p0[5]), cvtpk(p0[6], p0[7])};
            pw[1] = (u32x4){cvtpk(p0[8], p0[9]), cvtpk(p0[10], p0[11]), cvtpk(p0[12], p0[13]), cvtpk(p0[14], p0[15])};
            pw[2] = (u32x4){cvtpk(p1[0], p1[1]), cvtpk(p1[2], p1[3]), cvtpk(p1[4], p1[5]), cvtpk(p1[6], p1[7])};
            pw[3] = (u32x4){cvtpk(p1[8], p1[9]), cvtpk(p1[10], p1[11]), cvtpk(p1[12], p1[13]), cvtpk(p1[14], p1[15])};
#pragma unroll
            for (int d0 = 0; d0 < 2; ++d0)
#pragma unroll
                for (int ks = 0; ks < 4; ++ks) {
                    const bf16x8 vf = (bf16x8){vlo[d0][ks][0], vlo[d0][ks][1], vlo[d0][ks][2], vlo[d0][ks][3], vhi[d0][ks][0], vhi[d0][ks][1], vhi[d0][ks][2], vhi[d0][ks][3]};
                    if (d0 == 0) o0 = __builtin_amdgcn_mfma_f32_32x32x16_bf16(vf, __builtin_bit_cast(bf16x8, pw[ks]), o0, 0, 0, 0);
                    else         o1 = __builtin_amdgcn_mfma_f32_32x32x16_bf16(vf, __builtin_bit_cast(bf16x8, pw[ks]), o1, 0, 0, 0);
                }
        }
        const int ahead = NT - 2 - t;
        if (MODE == 1) { if (ahead >= 2) WAITBAR(6); else if (ahead == 1) WAITBAR(3); else WAITBAR(0); }
        else           { if (ahead >= 2) WAITBAR(4); else if (ahead == 1) WAITBAR(2); else WAITBAR(0); }
    }
    const float l_tot = swap_add(l_run);
    if (MODE == 3 || MODE == 4) {
        constexpr size_t PSEL = (MODE == 4) ? 1 : 0;
        float* po = PO + PSEL * PO_STRIDE + ((size_t)(rowbase + qtok) * 4 + hsel) * 64;
#pragma unroll
        for (int d0 = 0; d0 < 2; ++d0)
#pragma unroll
            for (int g4 = 0; g4 < 4; ++g4) { const int dim = 32 * d0 + 8 * g4 + 4 * hi;
                *(f32x4*)(po + dim) = (d0 == 0) ? (f32x4){o0[4 * g4], o0[4 * g4 + 1], o0[4 * g4 + 2], o0[4 * g4 + 3]} : (f32x4){o1[4 * g4], o1[4 * g4 + 1], o1[4 * g4 + 2], o1[4 * g4 + 3]}; }
        if (hi == 0) *(f32x2*)(PML + PSEL * PML_STRIDE + ((size_t)(rowbase + qtok) * 4 + hsel) * 2) = (f32x2){m_run, l_tot};
    } else {
        float sc_o = 1.f, sc_p = 0.f, sc_q = 0.f, L = l_tot;
        const float* po = PO + ((size_t)(rowbase + qtok) * 4 + hsel) * 64;
        if (MODE == 2) {
            const f32x2 ml = *(const f32x2*)(PML + ((size_t)(rowbase + qtok) * 4 + hsel) * 2), ml1 = *(const f32x2*)(PML + PML_STRIDE + ((size_t)(rowbase + qtok) * 4 + hsel) * 2);
            const float M = __builtin_fmaxf(__builtin_fmaxf(m_run, ml.x), ml1.x);
            sc_o = __builtin_amdgcn_exp2f(m_run - M); sc_p = __builtin_amdgcn_exp2f(ml.x - M); sc_q = __builtin_amdgcn_exp2f(ml1.x - M);
            L = l_tot * sc_o + ml.y * sc_p + ml1.y * sc_q;
        }
        const float inv = 1.f / L;
        const bf16_t* grow = qrow + p_col(C_GA + ycol); const int yr_ = rowbase + qtok;
#pragma unroll
        for (int d0 = 0; d0 < 2; ++d0)
#pragma unroll
            for (int g4 = 0; g4 < 4; ++g4) {
                const int dim = 32 * d0 + 8 * g4 + 4 * hi;
                const s16x4 gt = *(const s16x4*)(grow + p_col(dim));
                f32x4 pp = {0.f, 0.f, 0.f, 0.f}, pq = {0.f, 0.f, 0.f, 0.f}; if (MODE == 2) { pp = *(const f32x4*)(po + dim); pq = *(const f32x4*)(po + PO_STRIDE + dim); }
                float v[4];
#pragma unroll
                for (int e = 0; e < 4; ++e) v[e] = ((d0 == 0 ? o0[4 * g4 + e] : o1[4 * g4 + e]) * sc_o + pp[e] * sc_p + pq[e] * sc_q) * inv * bf2f(gt[e]);
                *(unsigned*)((unsigned char*)Y + g_off(yr_, ycol8 + dim, YP)) = pk4_fp8(v[0] * F8_SY, v[1] * F8_SY, v[2] * F8_SY, v[3] * F8_SY);
            }
        if ((MODE == 0 || MODE == 1) && hsel == 5) {
#pragma unroll
            for (int j = 0; j < 4; ++j) *(u32x4*)((unsigned char*)Y + g_off(yr_, ycol8 + 64 + 64 * hi + 16 * j, YP)) = (u32x4){0u, 0u, 0u, 0u};
        }
    }
#undef TILE_INFO
#undef KCOL
#undef VCOL
#undef QCOL
#undef ISSUE
}

template <int MODE>
__device__ __forceinline__ void attn_unit2(LAS unsigned char* lds, const bf16_t* __restrict__ P, bf16_t* __restrict__ Y, const u64* __restrict__ bits, int rowbase, int hsel, int blk, int wave) {
    wave = opaque_wave(wave);
    const int tid = opaque_tid(wave), lane = tid & 63, r32 = lane & 31, hi = lane >> 5; const int wid = wave;
    const float NEG = -INFINITY;
    const int T0a = (MODE == 0) ? 512 * blk : 256 * blk, T0b = (MODE == 0) ? T0a + 256 : T0a;
    const int NT = (MODE == 0) ? 8 * (blk + 1) : 4 * (blk + 1);
    const int kcol = (MODE == 0) ? (C_AK + 64 * hsel) : C_BK, vcol = (MODE == 0) ? (C_AV + 64 * hsel) : C_BV;
#define T2_ROW0(t) ((MODE == 1) ? 64 * (t) : ((t) < 4) ? (T0b + 64 * (t)) : ((t) < 8) ? (T0a + 64 * ((t) - 4)) : 64 * ((t) - 8))
    int qw0[2], qpos[2]; qw0[0] = T0a + wid * 32; qw0[1] = T0b + wid * 32; qpos[0] = qw0[0] + r32; qpos[1] = qw0[1] + r32;
    const unsigned lds0 = (unsigned)(uintptr_t)lds;
    const u64* brow_dma = bits + ((size_t)((rowbase + T0a) >> 5) + wid) * 1024 + (lane >> 1);
    const char* kbase_l = (const char*)(P + p_off(rowbase + lane, wid * 8));
    const char* vbase_l = (const char*)(P + p_off(rowbase + 16 * (wid & 3) + (lane >> 2), (wid >> 2) * 32 + (lane & 3) * 8));
#define ISSUE2(t) do { const int row0_ = T2_ROW0(t); const int slot_ = (t) & (NSLOT - 1); \
        const size_t ko_ = (p_off(row0_, 0) + p_col(kcol)) * 2, vo_ = (p_off(row0_, 0) + p_col(vcol)) * 2;     \
        glds16(kbase_l + ko_, (unsigned)__builtin_amdgcn_readfirstlane(lds0 + L_K + slot_ * SLOTB + wid * 1024)); \
        glds16(vbase_l + vo_, (unsigned)__builtin_amdgcn_readfirstlane(lds0 + L_V + slot_ * SLOTB + wid * 1024)); \
        if (MODE == 1) glds4((const unsigned*)(brow_dma + (t) * 32) + (lane & 1), (unsigned)__builtin_amdgcn_readfirstlane(lds0 + L_M + slot_ * 2048 + wid * 256)); } while (0)
    asm volatile("s_waitcnt vmcnt(0)" ::: "memory");
    ISSUE2(0); ISSUE2(1); ISSUE2(2);
    bf16x8 qr[2][4];
#pragma unroll
    for (int g = 0; g < 2; ++g) { const bf16_t* qrow = P + p_off(rowbase + qpos[g], (MODE == 0) ? (C_AQ + 64 * hsel) : (C_BQ + 64 * (2 * hsel + g)));
#pragma unroll
        for (int d0 = 0; d0 < 4; ++d0) qr[g][d0] = *(const bf16x8*)(qrow + p_col(d0 * 16 + hi * 8)); }
    unsigned sel[2] = {0u, 0u};
    if (MODE == 0) {
        LAS float* km = (LAS float*)(lds + L_KM);
        if (wid < 2 * blk + 1) {
            const int c = lane & 7, rg = lane >> 3; float a[8];
#pragma unroll
            for (int e = 0; e < 8; ++e) a[e] = 0.f;
            const bf16_t* kp = P + p_off(rowbase + 256 * wid + rg, C_AK + 64 * hsel + 8 * c);
#pragma unroll 8
            for (int i = 0; i < 32; ++i) { const bf16x8 v = *(const bf16x8*)(kp + (size_t)(i >> 1) * PBLK * 512 + (size_t)(i & 1) * 256);
#pragma unroll
                for (int e = 0; e < 8; ++e) a[e] += bf2f(v[e]); }
#pragma unroll
            for (int e = 0; e < 8; ++e) { a[e] += shfl_xor_l(a[e], 8, lane); a[e] += shfl_xor_l(a[e], 16, lane); a[e] += shfl_xor_l(a[e], 32, lane); }
            if (rg == 0) {
#pragma unroll
                for (int e = 0; e < 8; ++e) km[wid * 64 + 8 * c + e] = a[e] * (1.f / 256.f);
            }
        }
        __syncthreads();
#pragma unroll
        for (int g = 0; g < 2; ++g) {
            const int nb = 2 * blk + g;
            float gt[7];
#pragma unroll
            for (int j = 0; j < 7; ++j) {
                float part = 0.f;
                if (j < nb) {
#pragma unroll
                    for (int d0 = 0; d0 < 4; ++d0) { const f32x4 k0 = *(const LAS f32x4*)(km + j * 64 + 16 * d0 + 8 * hi), k1 = *(const LAS f32x4*)(km + j * 64 + 16 * d0 + 8 * hi + 4);
#pragma unroll
                        for (int e = 0; e < 4; ++e) part += bf2f(qr[g][d0][e]) * k0[e] + bf2f(qr[g][d0][4 + e]) * k1[e]; }
                    part = swap_add(part);
                }
                gt[j] = (j < nb) ? part : NEG;
            }
            unsigned s_ = 0u;
#pragma unroll
            for (int rep = 0; rep < 3; ++rep) { float bv = NEG; int best = -1;
#pragma unroll
                for (int j = 0; j < 7; ++j) { const bool ok = (j < nb) && !((s_ >> j) & 1u) && (gt[j] > bv); if (ok) { bv = gt[j]; best = j; } }
                if (best >= 0) s_ |= 1u << best; }
            sel[g] = s_;
        }
    }
    f32x16 o0[2], o1[2]; float m_run[2], l_run[2], mx_run[2]; bool shifted[2];
#pragma unroll
    for (int g = 0; g < 2; ++g) { o0[g] = (f32x16){}; o1[g] = (f32x16){}; m_run[g] = 0.f; l_run[g] = 0.f; mx_run[g] = NEG; shifted[g] = false; }
    constexpr float SHIFT_THR = 64.f;
    const lds_cptr lds3 = (lds_cptr)lds;
    const lds_cptr kp0 = lds3 + L_K + hi * 1024 + r32 * 16;
    const lds_cptr vp0 = lds3 + L_V + ((lane >> 4) & 1) * 32 + (lane & 3) * 8 + (4 * hi + ((lane & 15) >> 2)) * 64;
    const lds_cptr mp0 = lds3 + L_M + (32 * wid + r32) * 8;
#pragma unroll
    for (int g = 0; g < 2; ++g)
#pragma unroll
        for (int d0 = 0; d0 < 4; ++d0) asm volatile("" : "+v"(qr[g][d0]));
    if (MODE == 1 && tid < 16) {
        f32x4 e; e[0] = (tid & 1) ? 0.f : NEG; e[1] = (tid & 2) ? 0.f : NEG; e[2] = (tid & 4) ? 0.f : NEG; e[3] = (tid & 8) ? 0.f : NEG;
        *(LAS f32x4*)(lds + L_LUT + 16 * tid) = e;
    }
    WAITBAR(0);
    if (wid < 4) __builtin_amdgcn_s_setprio(2); else __builtin_amdgcn_s_setprio(0);
    for (int t = 0; t < NT; ++t) {
        const int row0 = T2_ROW0(t);
        bool act[2];
        if (MODE == 0) {
            const int b = row0 >> 8;
#pragma unroll
            for (int g = 0; g < 2; ++g) { const int own = 2 * blk + g; act[g] = (b == own) ? (row0 <= qw0[g] + 31) : (b < own) ? (__any((sel[g] >> b) & 1u) != 0) : false; }
        } else { act[0] = act[1] = (row0 <= qw0[0] + 31); }
        const int slot = (t & (NSLOT - 1)) * SLOTB;
        u32x2 mw = {0u, 0u}; if (MODE == 1 && act[0]) mw = *(const LAS u32x2*)(mp0 + (t & (NSLOT - 1)) * 2048);
        if (t + 3 < NT) ISSUE2(t + 3);
#pragma unroll
        for (int g = 0; g < 2; ++g) {
          if (act[g]) {
            f32x16 p0 = {}, p1 = {};
            if (MODE == 1) {
                const unsigned lo = mw.x >> (4 * hi), hw = mw.y >> (4 * hi);
                const lds_cptr lut = lds3 + L_LUT;
#pragma unroll
                for (int k = 0; k < 4; ++k) {
                    const f32x4 b0 = *(const LAS f32x4*)(lut + (((lo >> (8 * k)) & 15u) << 4)), b1 = *(const LAS f32x4*)(lut + (((hw >> (8 * k)) & 15u) << 4));
#pragma unroll
                    for (int j = 0; j < 4; ++j) { p0[4 * k + j] = b0[j]; p1[4 * k + j] = b1[j]; }
                }
            }
            __builtin_amdgcn_sched_barrier(0);
            { const lds_cptr kp = kp0 + slot;
              bf16x8 ka[4], kb[4];
#pragma unroll
              for (int j = 0; j < 4; ++j) { ka[j] = *(const LAS bf16x8*)(kp + j * 2048); kb[j] = *(const LAS bf16x8*)(kp + j * 2048 + 512); }
              p0 = __builtin_amdgcn_mfma_f32_32x32x16_bf16(ka[0], qr[g][0], p0, 0, 0, 0);
              p1 = __builtin_amdgcn_mfma_f32_32x32x16_bf16(kb[0], qr[g][0], p1, 0, 0, 0);
#pragma unroll
              for (int d0 = 1; d0 < 4; ++d0) { p0 = __builtin_amdgcn_mfma_f32_32x32x16_bf16(ka[d0], qr[g][d0], p0, 0, 0, 0); p1 = __builtin_amdgcn_mfma_f32_32x32x16_bf16(kb[d0], qr[g][d0], p1, 0, 0, 0); } }
            __builtin_amdgcn_sched_group_barrier(0x100, 4, 0);
#pragma unroll
            for (int i = 0; i < 4; ++i) { __builtin_amdgcn_sched_group_barrier(0x008, 1, 0); __builtin_amdgcn_sched_group_barrier(0x100, 1, 0); }
            __builtin_amdgcn_sched_group_barrier(0x008, 4, 0);
            __builtin_amdgcn_sched_barrier(0);
            s16x4 vl0[4], vh0[4];
            { const lds_cptr vp = vp0 + slot;
#pragma unroll
              for (int ks = 0; ks < 4; ++ks) { vl0[ks] = vtr(vp + ks * 1024); vh0[ks] = vtr(vp + ks * 1024 + 512); } }
            __builtin_amdgcn_sched_barrier(0);
            if (shifted[g]) {
#pragma unroll
                for (int r = 0; r < 16; ++r) { p0[r] -= m_run[g]; p1[r] -= m_run[g]; } }
            if (MODE == 0) {
                if ((row0 >> 8) == 2 * blk + g) { if (row0 + 63 > qw0[g]) { const int kb_ = row0 + 4 * hi;
#pragma unroll
                    for (int r = 0; r < 16; ++r) { const int kv = kb_ + (r & 3) + 8 * (r >> 2); if (kv > qpos[g]) p0[r] = NEG; if (kv + 32 > qpos[g]) p1[r] = NEG; } } }
                else { if (!((sel[g] >> (row0 >> 8)) & 1u)) { float ng = NEG; asm volatile("" : "+v"(ng));
#pragma unroll
                    for (int r = 0; r < 16; ++r) { p0[r] = ng; p1[r] = ng; } } }
            }
            asm volatile("s_nop 11" : "+v"(p0), "+v"(p1));
            float ma = fmax3_s(p0[0], p0[1], p1[0]), mb = fmax3_s(p0[2], p0[3], p1[1]);
            ma = fmax3_s(ma, p1[2], p1[3]);
#pragma unroll
            for (int r = 4; r < 16; r += 4) { ma = fmax3_s(ma, p0[r], p0[r + 1]); mb = fmax3_s(mb, p0[r + 2], p0[r + 3]);
                ma = fmax3_s(ma, p1[r], p1[r + 1]); mb = fmax3_s(mb, p1[r + 2], p1[r + 3]); }
            const float rm = swap_max(__builtin_fmaxf(ma, mb));
            const bool up = rm > SHIFT_THR, down = (mx_run[g] == NEG) && (rm < -SHIFT_THR) && (rm != NEG);
            if (__any(up || down)) {
                const float dl = (up || down) ? rm : 0.f; m_run[g] += dl; shifted[g] = true;
                const float f = __builtin_amdgcn_exp2f(-dl); l_run[g] *= f;
#pragma unroll
                for (int r = 0; r < 16; ++r) { p0[r] -= dl; p1[r] -= dl; o0[g][r] *= f; o1[g][r] *= f; }
                mx_run[g] = __builtin_fmaxf(mx_run[g], rm);
            } else mx_run[g] = __builtin_fmaxf(mx_run[g], rm);
            float ls0 = 0.f, ls1 = 0.f;
#pragma unroll
            for (int r = 0; r < 16; ++r) { p0[r] = __builtin_amdgcn_exp2f(p0[r]); p1[r] = __builtin_amdgcn_exp2f(p1[r]); }
            asm volatile("" : "+v"(p0), "+v"(p1));
#pragma unroll
            for (int r = 0; r < 16; ++r) { ls0 = fadd_s(ls0, p0[r]); ls1 = fadd_s(ls1, p1[r]); }
            l_run[g] = fadd_s(l_run[g], fadd_s(ls0, ls1));
            u32x4 pw[4];
            pw[0] = (u32x4){cvtpk(p0[0], p0[1]), cvtpk(p0[2], p0[3]), cvtpk(p0[4], p0[5]), cvtpk(p0[6], p0[7])};
            pw[1] = (u32x4){cvtpk(p0[8], p0[9]), cvtpk(p0[10], p0[11]), cvtpk(p0[12], p0[13]), cvtpk(p0[14], p0[15])};
            pw[2] = (u32x4){cvtpk(p1[0], p1[1]), cvtpk(p1[2], p1[3]), cvtpk(p1[4], p1[5]), cvtpk(p1[6], p1[7])};
            pw[3] = (u32x4){cvtpk(p1[8], p1[9]), cvtpk(p1[10], p1[11]), cvtpk(p1[12], p1[13]), cvtpk(p1[14], p1[15])};
            __builtin_amdgcn_sched_barrier(0);
            { const lds_cptr vp = vp0 + slot + 4096;
              s16x4 vl1[4], vh1[4];
#pragma unroll
              for (int ks = 0; ks < 4; ++ks) { vl1[ks] = vtr(vp + ks * 1024); vh1[ks] = vtr(vp + ks * 1024 + 512); }
#pragma unroll
              for (int ks = 0; ks < 4; ++ks) { const bf16x8 vf = (bf16x8){vl0[ks][0], vl0[ks][1], vl0[ks][2], vl0[ks][3], vh0[ks][0], vh0[ks][1], vh0[ks][2], vh0[ks][3]};
                  o0[g] = __builtin_amdgcn_mfma_f32_32x32x16_bf16(vf, __builtin_bit_cast(bf16x8, pw[ks]), o0[g], 0, 0, 0); }
#pragma unroll
              for (int ks = 0; ks < 4; ++ks) { const bf16x8 vf = (bf16x8){vl1[ks][0], vl1[ks][1], vl1[ks][2], vl1[ks][3], vh1[ks][0], vh1[ks][1], vh1[ks][2], vh1[ks][3]};
                  o1[g] = __builtin_amdgcn_mfma_f32_32x32x16_bf16(vf, __builtin_bit_cast(bf16x8, pw[ks]), o1[g], 0, 0, 0); } }
#pragma unroll
            for (int i = 0; i < 4; ++i) { __builtin_amdgcn_sched_group_barrier(0x100, 2, 0); __builtin_amdgcn_sched_group_barrier(0x008, 1, 0); }
            __builtin_amdgcn_sched_group_barrier(0x008, 4, 0);
            __builtin_amdgcn_sched_barrier(0);
          }
          __builtin_amdgcn_sched_barrier(0);
        }
        const int ahead = NT - 2 - t;
        if (MODE == 1) { if (ahead >= 2) WAITBAR(6); else if (ahead == 1) WAITBAR(3); else WAITBAR(0); }
        else           { if (ahead >= 2) WAITBAR(4); else if (ahead == 1) WAITBAR(2); else WAITBAR(0); }
    }
    __builtin_amdgcn_s_setprio(0);
#pragma unroll
    for (int g = 0; g < 2; ++g) {
        const int head = (MODE == 0) ? hsel : 2 * hsel + g;
        const float inv = 1.f / swap_add(l_run[g]);
        const bf16_t* grow = P + p_off(rowbase + qpos[g], C_GA + ((MODE == 0) ? 0 : 384) + 64 * head);
        const int yr_ = rowbase + qpos[g], yc_ = ((MODE == 0) ? 0 : 512) + 64 * head;
#pragma unroll
        for (int d0 = 0; d0 < 2; ++d0)
#pragma unroll
            for (int g4 = 0; g4 < 4; ++g4) {
                const int dim = 32 * d0 + 8 * g4 + 4 * hi;
                const s16x4 gt = *(const s16x4*)(grow + p_col(dim));
                float v[4];
#pragma unroll
                for (int e = 0; e < 4; ++e) v[e] = (d0 == 0 ? o0[g][4 * g4 + e] : o1[g][4 * g4 + e]) * inv * bf2f(gt[e]);
                *(unsigned*)((unsigned char*)Y + g_off(yr_, yc_ + dim, YP)) = pk4_fp8(v[0] * F8_SY, v[1] * F8_SY, v[2] * F8_SY, v[3] * F8_SY);
            }
        if (head == 5) {
#pragma unroll
            for (int j = 0; j < 4; ++j) *(u32x4*)((unsigned char*)Y + g_off(yr_, yc_ + 64 + 64 * hi + 16 * j, YP)) = (u32x4){0u, 0u, 0u, 0u};
        }
    }
#undef T2_ROW0
#undef ISSUE2
}

__device__ __forceinline__ unsigned f2key(float f) { unsigned u = __float_as_uint(f); if (u == 0x80000000u) u = 0u; return (u & 0x80000000u) ? ~u : (u | 0x80000000u); }
__device__ __forceinline__ float key2f(unsigned k) { const unsigned u = (k & 0x80000000u) ? (k & 0x7fffffffu) : ~k; return __uint_as_float(u); }
__device__ __forceinline__ unsigned wave_sum_dpp(unsigned x) {
    x += (unsigned)__builtin_amdgcn_update_dpp(0, (int)x, 0xB1, 0xf, 0xf, false);
    x += (unsigned)__builtin_amdgcn_update_dpp(0, (int)x, 0x4E, 0xf, 0xf, false);
    x += (unsigned)__builtin_amdgcn_update_dpp(0, (int)x, 0x141, 0xf, 0xf, false);
    x += (unsigned)__builtin_amdgcn_update_dpp(0, (int)x, 0x140, 0xf, 0xf, false);
    x += (unsigned)__builtin_amdgcn_update_dpp(0, (int)x, 0x142, 0xa, 0xf, false);
    x += (unsigned)__builtin_amdgcn_update_dpp(0, (int)x, 0x143, 0xc, 0xf, false);
    return (unsigned)__builtin_amdgcn_readlane((int)x, 63);
}
__device__ __forceinline__ void cnt4(unsigned& na, unsigned& nb, unsigned ka0, unsigned ka1, unsigned kb0, unsigned kb1, unsigned ca, unsigned cb) {
    u64 t1, t2, t3;
    asm("v_cmp_ge_u32_e64 vcc, %[ka0], %[ca]\n\t"
        "v_cmp_ge_u32_e64 %[t1], %[kb0], %[cb]\n\t"
        "v_cmp_ge_u32_e64 %[t2], %[ka1], %[ca]\n\t"
        "v_cmp_ge_u32_e64 %[t3], %[kb1], %[cb]\n\t"
        "v_addc_co_u32_e64 %[na], vcc, 0, %[na], vcc\n\t"
        "v_addc_co_u32_e64 %[nb], %[t1], 0, %[nb], %[t1]\n\t"
        "v_addc_co_u32_e64 %[na], %[t2], 0, %[na], %[t2]\n\t"
        "v_addc_co_u32_e64 %[nb], %[t3], 0, %[nb], %[t3]"
        : [na] "+v"(na), [nb] "+v"(nb), [t1] "=&s"(t1), [t2] "=&s"(t2), [t3] "=&s"(t3)
        : [ka0] "v"(ka0), [ka1] "v"(ka1), [kb0] "v"(kb0), [kb1] "v"(kb1), [ca] "v"(ca), [cb] "v"(cb)
        : "vcc");
}
template <int NREG> __device__ __forceinline__ int count_ge(const unsigned (&key)[32], unsigned cand) {
    unsigned cnt = 0u;
#pragma unroll
    for (int i = 0; i < NREG; ++i) cnt += (key[i] >= cand) ? 1u : 0u;
    int tot = 0;
#pragma unroll
    for (int b = 0; b < 6; ++b) tot += __popcll(__ballot((cnt >> b) & 1u)) << b;
    return tot;
}
template <int NREG> __device__ __forceinline__ void select_unit(LAS unsigned char* lds, const bf16_t* __restrict__ P, const float* __restrict__ IW, u64* __restrict__ bits, int rowbase, int q16, int wave) {
    wave = opaque_wave(wave);
    const int tid = opaque_tid(wave), lane = tid & 63; const int wid = wave;
    const int t0 = 16 * q16, ngroups = q16 + 1;
    const int qi = lane & 15, kq = lane >> 4;
    LAS float* sc = (LAS float*)lds;
    const bool triv = (NREG == 8) && (t0 + 16 <= 256);
    if (!triv) {
        bf16x8 bq[4][2]; float w[4];
        const bf16_t* qp = P + p_off(rowbase + t0 + qi, C_IQ + 8 * kq);
#pragma unroll
        for (int h = 0; h < 4; ++h) { bq[h][0] = *(const bf16x8*)(qp + p_col(64 * h)); bq[h][1] = *(const bf16x8*)(qp + p_col(64 * h + 32)); }
        { const f32x4 wv = *(const f32x4*)(IW + (size_t)(rowbase + t0 + qi) * 4); w[0] = wv[0]; w[1] = wv[1]; w[2] = wv[2]; w[3] = wv[3]; }
        const bf16_t* kbase = (const bf16_t*)((const char*)P - (WS_P - WS_IKC)) + (size_t)(rowbase + qi) * 32 + 8 * kq;
        constexpr int NG = NREG / 2;
        bf16x8 a[NG][2];
#pragma unroll
        for (int u = 0; u < NG; ++u) { int g = wid + 8 * u; g = g < ngroups ? g : ngroups - 1; const bf16_t* kp = kbase + (size_t)(16 * g) * 32; a[u][0] = *(const bf16x8*)kp; a[u][1] = *(const bf16x8*)(kp + (size_t)MC * 32); }
#pragma unroll
        for (int u = 0; u < NG; ++u) {
            const int g = wid + 8 * u;
            f32x4 s = {0.f, 0.f, 0.f, 0.f};
            f32x4 d[4];
#pragma unroll
            for (int h = 0; h < 4; ++h) {
                d[h] = (f32x4){0.f, 0.f, 0.f, 0.f};
                d[h] = __builtin_amdgcn_mfma_f32_16x16x32_bf16(a[u][0], bq[h][0], d[h], 0, 0, 0);
                d[h] = __builtin_amdgcn_mfma_f32_16x16x32_bf16(a[u][1], bq[h][1], d[h], 0, 0, 0);
            }
            asm volatile("s_nop 11" : "+v"(d[0]), "+v"(d[1]), "+v"(d[2]), "+v"(d[3]));
#pragma unroll
            for (int h = 0; h < 4; ++h)
#pragma unroll
                for (int e = 0; e < 4; ++e) { float r_; asm("v_max_f32_e32 %0, 0, %1" : "=v"(r_) : "v"(d[h][e])); float se = s[e]; asm("v_fmac_f32_e32 %0, %1, %2" : "+v"(se) : "v"(r_), "v"(w[h])); s[e] = se; }
            if (g < ngroups) *(LAS f32x4*)(sc + qi * SCORE_PITCH + 16 * g + 4 * kq) = s;
        }
    }
    __syncthreads();
    {
        const int qA = 2 * wid, tA = t0 + qA, tB = tA + 1;
        unsigned kA[32], kB[32];
#pragma unroll
        for (int i = 0; i < NREG; ++i) {
            const int idx = lane + 64 * i;
            const float va = sc[qA * SCORE_PITCH + idx], vb = sc[(qA + 1) * SCORE_PITCH + idx];
            const unsigned ka = triv ? 2u : f2key(va), kb = triv ? 2u : f2key(vb);
            kA[i] = (idx <= tA) ? ka : 0u; kB[i] = (idx <= tB) ? kb : 0u;
        }
        unsigned TA = 1u, TB = 1u; bool dA = (tA + 1 <= 256), dB = (tB + 1 <= 256);
        if (!dB) {
            TA = dA ? 1u : 0u; TB = 0u;
            for (int bit = 31; bit >= 0; --bit) {
                if (dA && dB) break;
                const unsigned cA = TA | (1u << bit), cB = TB | (1u << bit);
                unsigned ca = 0u, cb = 0u;
#pragma unroll
                for (int i = 0; i < NREG; i += 2) cnt4(ca, cb, kA[i], kA[i + 1], kB[i], kB[i + 1], cA, cB);
                const unsigned tot = wave_sum_dpp(ca | (cb << 16));
                const int nA = (int)(tot & 0xffffu), nB = (int)(tot >> 16);
                if (!dA) { if (nA >= 256) TA = cA; if (nA == 256) dA = true; }
                if (!dB) { if (nB >= 256) TB = cB; if (nB == 256) dB = true; }
            }
        }
        const u64 lt_mask = (lane == 0) ? 0ull : (~0ull >> (64 - lane));
#pragma unroll 1
        for (int rr = 0; rr < 2; ++rr) {
            const unsigned T = rr ? TB : TA; const int t = tA + rr;
            unsigned cge = 0u;
#pragma unroll
            for (int i = 0; i < NREG; ++i) { const unsigned kk_ = rr ? kB[i] : kA[i]; cge += (kk_ > T) ? 1u : 0u; cge += (kk_ == T) ? 0x10000u : 0u; }
            const unsigned tote = wave_sum_dpp(cge);
            const int cgt = (int)(tote & 0xffffu), ceq = (int)(tote >> 16);
            const int need = 256 - cgt;
            unsigned mine_lo = 0u, mine_hi = 0u;
            if (need <= 0 || need >= ceq) {
                const unsigned Tc = (need <= 0) ? T + 1u : T;
#define SEL_FAST(i) do { if ((i) < NREG) { const unsigned kk_ = rr ? kB[i] : kA[i]; const u64 wsel = __ballot(kk_ >= Tc); \
            const unsigned wl_ = (unsigned)wsel, wh_ = (unsigned)(wsel >> 32); \
            asm volatile("s_nop 1\n\tv_writelane_b32 %0, %2, " #i "\n\tv_writelane_b32 %1, %3, " #i : "+v"(mine_lo), "+v"(mine_hi) : "s"(wl_), "s"(wh_)); if (((i) & 3) == 3) __builtin_amdgcn_sched_barrier(0); } } while (0)
                SEL_FAST(0); SEL_FAST(1); SEL_FAST(2); SEL_FAST(3); SEL_FAST(4); SEL_FAST(5); SEL_FAST(6); SEL_FAST(7);
                SEL_FAST(8); SEL_FAST(9); SEL_FAST(10); SEL_FAST(11); SEL_FAST(12); SEL_FAST(13); SEL_FAST(14); SEL_FAST(15);
                SEL_FAST(16); SEL_FAST(17); SEL_FAST(18); SEL_FAST(19); SEL_FAST(20); SEL_FAST(21); SEL_FAST(22); SEL_FAST(23);
                SEL_FAST(24); SEL_FAST(25); SEL_FAST(26); SEL_FAST(27); SEL_FAST(28); SEL_FAST(29); SEL_FAST(30); SEL_FAST(31);
#undef SEL_FAST
            } else {
                int run = 0;
#define SEL_EMIT(i) do { if ((i) < NREG) { const unsigned kk_ = rr ? kB[i] : kA[i]; const bool eq = (kk_ == T) && (kk_ != 0u); const u64 beq = __ballot(eq); const int rank = run + __popcll(beq & lt_mask); \
            const bool s_ = (kk_ > T) || (eq && rank < need); const u64 wsel = __ballot(s_); run += __popcll(beq); \
            const unsigned wl_ = (unsigned)wsel, wh_ = (unsigned)(wsel >> 32); \
            asm volatile("s_nop 1\n\tv_writelane_b32 %0, %2, " #i "\n\tv_writelane_b32 %1, %3, " #i : "+v"(mine_lo), "+v"(mine_hi) : "s"(wl_), "s"(wh_)); if (((i) & 3) == 3) __builtin_amdgcn_sched_barrier(0); } } while (0)
                SEL_EMIT(0); SEL_EMIT(1); SEL_EMIT(2); SEL_EMIT(3); SEL_EMIT(4); SEL_EMIT(5); SEL_EMIT(6); SEL_EMIT(7);
                SEL_EMIT(8); SEL_EMIT(9); SEL_EMIT(10); SEL_EMIT(11); SEL_EMIT(12); SEL_EMIT(13); SEL_EMIT(14); SEL_EMIT(15);
                SEL_EMIT(16); SEL_EMIT(17); SEL_EMIT(18); SEL_EMIT(19); SEL_EMIT(20); SEL_EMIT(21); SEL_EMIT(22); SEL_EMIT(23);
                SEL_EMIT(24); SEL_EMIT(25); SEL_EMIT(26); SEL_EMIT(27); SEL_EMIT(28); SEL_EMIT(29); SEL_EMIT(30); SEL_EMIT(31);
#undef SEL_EMIT
            }
            if (lane < 32) bits[((size_t)((rowbase + t) >> 5) * 32 + lane) * 32 + ((rowbase + t) & 31)] = ((u64)mine_hi << 32) | (u64)mine_lo;
        }
    }
    __syncthreads();
}
}

struct Args { const float* x; const float* norm_g; const float* w_in; const float* w_br_a; const float* w_br_b; const float* w_br_c; const float* w_out; const float* final_g;
              float* out; unsigned char* ws; int ph_lo, ph_hi; };

constexpr int WI_IN = (DM / 64) * (C_F8 / 32), WI_IN8 = (DM / 64) * ((NW - C_F8) / 32), WI_BA = (384 / 64) * (DM / 32), WI_BC = (256 / 64) * (DM / 32), WI_O = (DM / 64) * (DM / 32);
constexpr int WPER_L = WI_IN + WI_IN8 + 2 * WI_BA + WI_BC + WI_O;
__device__ __forceinline__ void weight_item(const Args& args, bf16_t* WIN, bf16_t* WBR, bf16_t* WOUT, int l, int r, LAS float* scr, int lane_) {
    if (r < WI_IN) { transpose_item<true>(args.w_in + (size_t)l * DM * INW, INW, C_F8 / 32, WIN + (size_t)l * NW * DM, DM, 0, scr, r, lane_); return; } r -= WI_IN;
    if (r < WI_IN8) { transpose_item<true, true>(args.w_in + (size_t)l * DM * INW, INW, (NW - C_F8) / 32, WIN + (size_t)l * NW * DM + (size_t)C_F8 * DM, DM, 0, scr, r, lane_, C_F8, C_F8); return; } r -= WI_IN8;
    if (r < WI_BA) { transpose_item<false, true>(args.w_br_a + (size_t)l * 384 * DM, DM, DM / 32, WBR + (size_t)l * DM * DM, YP, 0, scr, r, lane_); return; } r -= WI_BA;
    if (r < WI_BA) { transpose_item<false, true>(args.w_br_b + (size_t)l * 384 * DM, DM, DM / 32, WBR + (size_t)l * DM * DM, YP, 512, scr, r, lane_); return; } r -= WI_BA;
    if (r < WI_BC) { transpose_item<false, true>(args.w_br_c + (size_t)l * 256 * DM, DM, DM / 32, WBR + (size_t)l * DM * DM, YP, 1024, scr, r, lane_); return; } r -= WI_BC;
    transpose_item<false, true>(args.w_out + (size_t)l * DM * DM, DM, DM / 32, WOUT + (size_t)l * DM * DM, DM, 0, scr, r, lane_);
}

__device__ __forceinline__ bool attn_work(int idx, int& mode, int& level, int& sub) {
    int r = idx;
#define AW(m_, l_) do { const int cnt = ((m_) == 2) ? 32 : ((m_) == 1) ? 24 : 48; if (r < cnt) { mode = (m_); level = (l_); sub = r; return true; } r -= cnt; } while (0)
    AW(1, 7); AW(0, 3); AW(1, 6); AW(1, 5); AW(0, 2); AW(1, 4); AW(1, 3); AW(0, 1); AW(1, 2); AW(1, 1); AW(0, 0); AW(1, 0);
    AW(2, 7); AW(2, 6); AW(2, 5); AW(2, 4); AW(2, 3); AW(2, 2); AW(2, 1); AW(2, 0);
#undef AW
    return false;
}

__global__ void __launch_bounds__(NWAVES * 64, 2) mega_fwd(Args args) {
    extern __shared__ __attribute__((aligned(16))) unsigned char lds_raw[];
    Frame F;
    F.lds = (LAS unsigned char*)lds_raw;
    F.MISC = (volatile LAS unsigned*)(F.lds + MISC_OFF);
    F.tid = threadIdx.x; F.lane = F.tid & 63; F.wave = __builtin_amdgcn_readfirstlane(F.tid >> 6);
    F.G = gridDim.x;
    unsigned char* ws = args.ws;
    F.ctl = (gu32*)(ws + WS_CTL);
    for (int u = F.tid; u < (LDS_BYTES - LDSCTL_OFF) / 4; u += NWAVES * 64) ((LAS unsigned*)(F.lds + LDSCTL_OFF))[u] = 0u;
    __syncthreads();
    XcdBarrier bar; bar.bar = (unsigned*)(F.ctl + CW_BAR); bar.x = 0; bar.st = nullptr;
    if (MK_N_LAUNCHES == 1) bar = xcd_barrier_post((unsigned*)(F.ctl + CW_BAR), F.MISC + 8);
#define GRID_BAR() do { if (MK_N_LAUNCHES == 1) xcd_barrier<false>(bar, F.wave); } while (0)
#define GRID_BAR_FIRST() do { if (MK_N_LAUNCHES == 1) xcd_barrier<true>(bar, F.wave); } while (0)
    const int lo = args.ph_lo, hi = args.ph_hi;
#define IN(k) (lo <= (k) && (k) < hi)
#define BOTH(k) (IN(k) && IN((k) + 1))

#define WSPTRS() unsigned char* wsl = launder(args.ws); float* cosT = (float*)(wsl + WS_ROPE); float* sinT = cosT + SEQ * 32; float* IWb = (float*)(wsl + WS_IW); unsigned char* H8b = wsl + WS_H8; \
    bf16_t* WIN = (bf16_t*)(wsl + WS_WIN); bf16_t* WBR = (bf16_t*)(wsl + WS_WBR); bf16_t* WOUT = (bf16_t*)(wsl + WS_WOUT); u64* BITS = (u64*)(wsl + WS_BITS); \
    bf16_t* Hb = (bf16_t*)(wsl + WS_H); bf16_t* Hb1 = (bf16_t*)(wsl + WS_H1); float* POb = (float*)(wsl + WS_PO); float* PMLb = (float*)(wsl + WS_PML); bf16_t* Yb = (bf16_t*)(wsl + WS_Y); bf16_t* MGb = (bf16_t*)(wsl + WS_MERGED); bf16_t* Pb = (bf16_t*)(wsl + WS_P); unsigned char* MG8b = wsl + WS_MG8; \
    gu32* ctl = (gu32*)(wsl + WS_CTL); \
    (void)cosT; (void)sinT; (void)IWb; (void)H8b; (void)WIN; (void)WBR; (void)WOUT; (void)BITS; (void)Hb; (void)Hb1; (void)POb; (void)PMLb; (void)Yb; (void)MGb; (void)Pb; (void)MG8b; (void)ctl
    const int NGW = F.G * NWAVES;
#define PHASE_IDS() const int wave_ = opaque_wave(F.wave); const int tid_ = opaque_tid(wave_); const int lane_ = tid_ & 63; const int gw = blockIdx.x * NWAVES + wave_; (void)lane_; (void)gw

    if (EN(0)) {
        WSPTRS(); PHASE_IDS();
        LAS float* scr = (LAS float*)(F.lds + wave_ * 16384);
        for (int it = gw; it < WPER_L; it += NGW) weight_item(args, WIN, WBR, WOUT, 0, it, scr, lane_);
        for (int e = blockIdx.x * (NWAVES * 64) + tid_; e < DEPTH * DM * 16; e += F.G * NWAVES * 64) {
            const int l = e / (DM * 16), n = (e / 16) % DM, j = e % 16;
            *(u32x4*)((unsigned char*)(WBR + (size_t)l * DM * DM) + (size_t)n * YP + (j < 8 ? 384 : 896 - 128) + 16 * j) = (u32x4){0u, 0u, 0u, 0u};
        }
        for (int e = blockIdx.x * (NWAVES * 64) + tid_; e < SEQ * 32; e += F.G * NWAVES * 64) {
            const int t = e >> 5, f = e & 31;
            const float inv_freq = 1.0f / powf(10000.0f, (float)(2 * f) / 64.0f);
            const float ang = (float)t * inv_freq;
            const double rev = (double)ang * 0.15915494309189535;
            const float fr = (float)(rev - __builtin_rint(rev));
            cosT[e] = __builtin_amdgcn_cosf(fr); sinT[e] = __builtin_amdgcn_sinf(fr);
        }
        for (int m = 4 * gw; m < BATCH * SEQ; m += 4 * NGW) rms_rows<true, 4>(args.x + (size_t)m * DM, args.norm_g, (m < MC ? Hb + (size_t)m * DM : Hb1 + (size_t)(m - MC) * DM), H8b + (size_t)m * DM, IWb + (size_t)m * 4, args.w_in + 2752, lane_);
    }
    GRID_BAR_FIRST();

#pragma nounroll
    for (int lcx = -1; lcx < DEPTH * NCH; ++lcx) {
        if (lcx >= 0) {
            const int lc = lcx;
            const int l = lc / NCH, c = lc % NCH;
            const float* xin = ((l == 0) ? args.x : (const float*)args.out) + (size_t)c * MC * DM;
            float* xout = args.out + (size_t)c * MC * DM;
            if (EN(3)) for (int rep = 0; rep < NREP(3); ++rep) {
                WSPTRS();
                gu32* qc = ctl + CW_Q + 64 * (((l * NCH + c) * 2 + 0) * 4 + rep);
                for (int nq = 0;; ++nq) {
                    __syncthreads();
                    if (opaque_tid(F.wave) == 0) F.MISC[0] = (nq == 0) ? (unsigned)blockIdx.x : (unsigned)F.G + __hip_atomic_fetch_add(qc, 1u, RLX_AGENT);
                    __syncthreads();
                    const int idx = (int)F.MISC[0];
                    constexpr int NSEL = BPC * 128, NG2 = 2 * BPC * 4 * 8;
                    if (idx >= NSEL + NG2 + ((rep == 0) ? (lc > 0 ? MC / 64 : WPER_L / 8) : 0)) break;
                    if (idx >= NSEL && idx < NSEL + NG2) { const int j = idx - NSEL;
                        if (j < NG2 / 2) att::attn_unit<4>(F.lds, Pb, Yb, BITS, POb, PMLb, ((j >> 5) & 7) * SEQ, (j >> 3) & 3, 7 - (j & 7), F.wave);
                        else att::attn_unit<3>(F.lds, Pb, Yb, BITS, POb, PMLb, ((j >> 5) & 7) * SEQ, (j >> 3) & 3, j & 7, F.wave);
                        continue; }
                    if (idx >= NSEL + NG2) {
                        PHASE_IDS();
                        if (lc == 0) {
                            static_assert(WPER_L % 8 == 0, "weight items per layer");
                            weight_item(args, WIN, WBR, WOUT, 1, (idx - NSEL - NG2) * 8 + wave_, (LAS float*)(F.lds + wave_ * 16384), lane_);
                            continue;
                        }
                        const int r0 = (idx - NSEL - NG2) * 64 + wave_ * 8;
                        if (lc == 3) { for (int j = 0; j < 8; j += 4) rms_rows<false, 4>(args.out + (size_t)(r0 + j) * DM, args.final_g, args.out + (size_t)(r0 + j) * DM, nullptr, nullptr, nullptr, lane_); }
                        else { const float* src = args.out + (size_t)(lc - 1) * MC * DM; bf16_t* dst = (lc == 1) ? Hb : Hb1;
                            for (int j = 0; j < 8; j += 4) rms_rows<true, 4>(src + (size_t)(r0 + j) * DM, args.norm_g + DM, dst + (size_t)(r0 + j) * DM, H8b + ((size_t)(lc - 1) * MC + r0 + j) * DM, IWb + ((size_t)(lc - 1) * MC + r0 + j) * 4, args.w_in + (size_t)DM * INW + 2752, lane_); }
                        continue;
                    }
                    const int q16 = 127 - (idx >> 3), b = idx & 7;
                    if (q16 < 32) att::select_unit<8>(F.lds, Pb, IWb + (size_t)c * MC * 4, BITS, b * SEQ, q16, F.wave);
                    else if (q16 < 48) att::select_unit<12>(F.lds, Pb, IWb + (size_t)c * MC * 4, BITS, b * SEQ, q16, F.wave);
                    else if (q16 < 64) att::select_unit<16>(F.lds, Pb, IWb + (size_t)c * MC * 4, BITS, b * SEQ, q16, F.wave);
                    else if (q16 < 80) att::select_unit<20>(F.lds, Pb, IWb + (size_t)c * MC * 4, BITS, b * SEQ, q16, F.wave);
                    else if (q16 < 96) att::select_unit<24>(F.lds, Pb, IWb + (size_t)c * MC * 4, BITS, b * SEQ, q16, F.wave);
                    else if (q16 < 112) att::select_unit<28>(F.lds, Pb, IWb + (size_t)c * MC * 4, BITS, b * SEQ, q16, F.wave);
                    else att::select_unit<32>(F.lds, Pb, IWb + (size_t)c * MC * 4, BITS, b * SEQ, q16, F.wave);
                }
                GRID_BAR();
            }
            if (EN(4)) for (int rep = 0; rep < NREP(4); ++rep) {
                WSPTRS();
                gu32* qc = ctl + CW_Q + 64 * (((l * NCH + c) * 2 + 1) * 4 + rep);
                for (int nq = 0;; ++nq) {
                    __syncthreads();
                    if (opaque_tid(F.wave) == 0) F.MISC[0] = (nq == 0) ? (unsigned)blockIdx.x : (unsigned)F.G + __hip_atomic_fetch_add(qc, 1u, RLX_AGENT);
                    __syncthreads();
                    const int idx = (int)F.MISC[0];
                    int mode, level, sub;
                    if (!attn_work(idx, mode, level, sub)) break;
                    if (mode == 0) att::attn_unit2<0>(F.lds, Pb, Yb, BITS, (sub / 6) * SEQ, sub % 6, level, F.wave);
                    else if (mode == 1) att::attn_unit2<1>(F.lds, Pb, Yb, BITS, (sub / 3) * SEQ, sub % 3, level, F.wave);
                    else att::attn_unit<2>(F.lds, Pb, Yb, BITS, POb, PMLb, (sub >> 2) * SEQ, sub & 3, level, F.wave);
                }
                GRID_BAR();
            }
            if (EN(5)) for (int rep = 0; rep < NREP(5); ++rep) {
                WSPTRS();
                pg8::Gemm g{Yb, WBR + (size_t)l * DM * DM}; pg8::BranchOrder S; S.so.init(MC, DM, DM, F.G, (int)blockIdx.x);
                pg8::EpiMerge E{MG8b, MGb, 1.f / (F8_SY * F8_SB)};
                pg8::gemm_phase<pg8::EpiMerge, pg8::BranchOrder, true, YP, true>(F.lds, g, S, E, F.wave);
                GRID_BAR();
            }
            if (EN(6)) {
                WSPTRS();
                pg8::Gemm g{MGb, WOUT + (size_t)l * DM * DM}; pg8::StaticOrder S; S.init(MC, DM, DM, F.G, (int)blockIdx.x); S.nt = DM / 128;
                pg8::EpiResid E{xin, xout, 1.f / (F8_SM * F8_SB)};
                pg8::gemm_phase<pg8::EpiResid, pg8::StaticOrder, true, pg8::LD, true>(F.lds, g, S, E, F.wave);
            }
        }
        if (lcx + 1 < DEPTH * NCH) {
            const int lc = lcx + 1;
            const int l = lc / NCH, c = lc % NCH;
            if (EN(2)) for (int rep = 0; rep < NREP(2); ++rep) {
                WSPTRS();
                {
                    pg8::Gemm g{c ? Hb1 : Hb, WIN + (size_t)l * NW * DM}; pg8::StaticOrder S; S.init(MC, C_F8, DM, F.G, (int)blockIdx.x);
                    pg8::EpiProj E{Pb, MG8b, cosT, sinT, 0, 1.f};
                    pg8::gemm_phase<pg8::EpiProj, pg8::StaticOrder, false>(F.lds, g, S, E, F.wave);
                }
                {
                    pg8::Gemm g{(const bf16_t*)(H8b + (size_t)c * MC * DM), WIN + (size_t)l * NW * DM + (size_t)C_F8 * DM}; pg8::TailOrder S;
                    S.first = ((int)blockIdx.x >= (int)F.G - 64) ? (int)blockIdx.x - ((int)F.G - 64) : 64; S.step = 64; S.nt = DM / 128;
                    pg8::EpiProj E{Pb, MG8b, cosT, sinT, C_F8, 1.f / (F8_SA * F8_SB)};
                    pg8::gemm_phase<pg8::EpiProj, pg8::TailOrder, true>(F.lds, g, S, E, F.wave);
                }
                {
                    pg8::Gemm g{(const bf16_t*)(H8b + (size_t)c * MC * DM), WIN + (size_t)l * NW * DM + (size_t)C_F8 * DM}; pg8::StaticOrder S; S.init(MC, NW_MAIN - C_F8, DM, F.G, (int)((blockIdx.x + 64) % F.G)); S.nt = DM / 128;
                    pg8::EpiProj E{Pb, MG8b, cosT, sinT, C_F8, 1.f / (F8_SA * F8_SB)};
                    pg8::gemm_phase<pg8::EpiProj, pg8::StaticOrder, true>(F.lds, g, S, E, F.wave);
                }
            }
        }
        GRID_BAR();
    }
    if (EN(7)) {
        PHASE_IDS();
        for (int m = MC + 4 * gw; m < BATCH * SEQ; m += 4 * NGW) rms_rows<false, 4>(args.out + (size_t)m * DM, args.final_g, args.out + (size_t)m * DM, nullptr, nullptr, nullptr, lane_);
    }
#undef IN
#undef BOTH
#undef GRID_BAR
}

extern "C" void kernel_launch(void* const* d_in, const int* in_sizes, int n_in, void* d_out, int out_size, void* d_ws, size_t ws_size, hipStream_t stream) {
    static int grid = 0;
    if (grid == 0) {
        if (n_in != 8 || in_sizes[0] != BATCH * SEQ * DM || out_size != BATCH * SEQ * DM || ws_size < WS_END) {
            fprintf(stderr, "kernel_launch: unexpected shapes / workspace (n_in %d, in0 %d, out %d, ws %zu, need %zu); nothing launched\n", n_in, n_in > 0 ? in_sizes[0] : -1, out_size, ws_size, (size_t)WS_END);
            grid = -1; return; }
        int dev = 0, cus = 0, per_cu = 0;
        if (hipGetDevice(&dev) != hipSuccess || hipDeviceGetAttribute(&cus, hipDeviceAttributeMultiprocessorCount, dev) != hipSuccess) { grid = -1; return; }
        if (hipFuncSetAttribute((const void*)mega_fwd, hipFuncAttributeMaxDynamicSharedMemorySize, LDS_BYTES) != hipSuccess) { fprintf(stderr, "kernel_launch: hipFuncSetAttribute failed\n"); grid = -1; return; }
        if (hipOccupancyMaxActiveBlocksPerMultiprocessor(&per_cu, (const void*)mega_fwd, NWAVES * 64, LDS_BYTES) != hipSuccess || per_cu < 1)
            fprintf(stderr, "kernel_launch: note: occupancy query reports %d workgroups per CU\n", per_cu);
        (void)hipGetLastError();
        grid = cus;
    }
    if (grid < 0) return;
    if (hipMemsetAsync((char*)d_ws + WS_CTL, 0, CTL_ZERO_BYTES, stream) != hipSuccess) return;
    Args a{};
    a.x = (const float*)d_in[0]; a.norm_g = (const float*)d_in[1]; a.w_in = (const float*)d_in[2]; a.w_br_a = (const float*)d_in[3];
    a.w_br_b = (const float*)d_in[4]; a.w_br_c = (const float*)d_in[5]; a.w_out = (const float*)d_in[6]; a.final_g = (const float*)d_in[7];
    a.out = (float*)d_out; a.ws = (unsigned char*)d_ws;
    if (MK_N_LAUNCHES == 1) {
        a.ph_lo = 0; a.ph_hi = NPHASES;
        hipLaunchKernelGGL(mega_fwd, dim3(grid), dim3(NWAVES * 64), LDS_BYTES, stream, a);
    } else {
        for (int p = 0; p < NPHASES; ++p) { a.ph_lo = p; a.ph_hi = p + 1; hipLaunchKernelGGL(mega_fwd, dim3(grid), dim3(NWAVES * 64), LDS_BYTES, stream, a); }
    }
}
```

```cpp
#include <hip/hip_runtime.h>
#include <cstdio>
#include <cstdint>

#ifndef MK_N_LAUNCHES
#define MK_N_LAUNCHES 1
#endif

#ifndef EN_MASK
#define EN_MASK 0xFF
#endif
#define EN(k) (((EN_MASK) >> (k)) & 1)
#ifndef REP_KIND
#define REP_KIND -1
#endif
#ifndef REP_N
#define REP_N 2
#endif
#define NREP(k) (((k) == (REP_KIND)) ? (REP_N) : 1)
#define GAS __attribute__((address_space(1)))
#define LAS __attribute__((address_space(3)))
typedef unsigned short bf16_t;
typedef short bf16x8 __attribute__((ext_vector_type(8)));
typedef short s16x4 __attribute__((ext_vector_type(4)));
typedef float f32x4 __attribute__((ext_vector_type(4)));
typedef float f32x2 __attribute__((ext_vector_type(2)));
typedef float f32x16 __attribute__((ext_vector_type(16)));
typedef unsigned u32x4 __attribute__((ext_vector_type(4)));
typedef unsigned u32x2 __attribute__((ext_vector_type(2)));
typedef GAS unsigned gu32;
typedef unsigned long long u64;

constexpr int BATCH = 16, SEQ = 2048, DM = 1024, DEPTH = 2;
constexpr int NCH = 2, BPC = BATCH / NCH, MC = BPC * SEQ;
constexpr int INW = 8388;
constexpr int NW = 8448;
constexpr int C_AQ = 0, C_IQ = 384, C_IK = 640, C_BK = 704, C_AK = 768, C_BQ = 1152, C_CQ = 1536, C_CK = 2304, C_ROPE_END = 3072;
constexpr int C_AV = 3072, C_BV = 3456, C_CV = 3520, C_PLAIN_END = 4288;
constexpr int C_GA = 4288, C_SILU_END = 5312;
constexpr int C_MG = 5312, C_SIG_END = 8384;
constexpr int NP = 5312;
constexpr int NW_MAIN = 8192;
constexpr int C_F8 = 1024;
constexpr int PBLK = NP / 32;
__host__ __device__ constexpr size_t p_col(int col) { return (size_t)(col >> 5) * 512 + (size_t)(col & 31); }
__host__ __device__ constexpr size_t p_off(int row, int col) { return (size_t)(row >> 4) * PBLK * 512 + (size_t)(row & 15) * 32 + p_col(col); }
__host__ __device__ constexpr size_t g_off(int row, int bc, int pitchB) { return ((size_t)(row >> 4) * (size_t)(pitchB / 64) + (size_t)(bc >> 6)) * 1024 + (size_t)((row & 15) * 64 + (bc & 63)); }
constexpr int YP = 1280;
constexpr float F8_SA = 16.f, F8_SB = 256.f, F8_SM = 16.f, F8_SY = 4.f;
constexpr float RMS_EPS = 1e-6f;
constexpr float QSCALE = 0.125f * 1.4426950408889634f;

constexpr size_t MiB = 1u << 20;
constexpr size_t WS_CTL = 0, CTL_ZERO_BYTES = 128 * 1024;
constexpr size_t WS_ROPE = 1 * MiB;
constexpr size_t WS_IW = 2 * MiB;
constexpr size_t WS_WIN = 4 * MiB;
constexpr size_t WS_WBR = 38 * MiB;
constexpr size_t WS_WOUT = 42 * MiB;
constexpr size_t WS_BITS = 46 * MiB;
constexpr size_t WS_H = 50 * MiB;
constexpr size_t WS_Y = 82 * MiB;
constexpr size_t WS_MERGED = 114 * MiB;
constexpr size_t WS_P = 146 * MiB;
constexpr size_t WS_MG8 = 312 * MiB;
constexpr size_t WS_H1 = 410 * MiB;
constexpr size_t WS_PO = 442 * MiB;
constexpr size_t WS_PML = 474 * MiB;
constexpr size_t WS_H8 = 476 * MiB;
constexpr size_t WS_IKC = 102 * MiB;
constexpr size_t WS_END = 508 * MiB;
static_assert(WS_P + (size_t)MC * NP * 2 <= WS_MG8 && WS_MG8 + (size_t)MC * 3072 <= WS_H1, "ws map");
static_assert(WS_Y + (size_t)MC * YP <= WS_IKC && WS_IKC + (size_t)2 * MC * 64 <= WS_MERGED, "ws map (compact indexer keys)");
static_assert(WS_WIN + (size_t)2 * NW * 1024 * 2 <= WS_WBR, "ws map");

constexpr int CW_TMO = 0;
constexpr int CW_BAR = 4096;
constexpr int CW_Q = 16384;

constexpr int RING_BYTES = 131072;
constexpr int SCORE_PITCH = 2052;
constexpr int LDSCTL_OFF = 135168, MISC_OFF = LDSCTL_OFF + 320;
constexpr int LDS_BYTES = 147456;
static_assert(16 * SCORE_PITCH * 4 <= LDSCTL_OFF, "lds map");

constexpr int NWAVES = 8;
constexpr int NPHASES = 2 + DEPTH * NCH * 5;

#define LDS_WAIT() asm volatile("s_waitcnt lgkmcnt(0)" ::: "memory")
#define VM_WAIT() asm volatile("s_waitcnt vmcnt(0)" ::: "memory")
#define RLX_AGENT __ATOMIC_RELAXED, __HIP_MEMORY_SCOPE_AGENT

__device__ __forceinline__ unsigned f2bf(float f) { unsigned u = __builtin_bit_cast(unsigned, f); return (u + 0x7fffu + ((u >> 16) & 1u)) >> 16; }
__device__ __forceinline__ unsigned pk2(float lo, float hi) { return f2bf(lo) | (f2bf(hi) << 16); }
__device__ __forceinline__ unsigned pk4_fp8(float a, float b, float c, float d) { int w = 0; w = __builtin_amdgcn_cvt_pk_fp8_f32(a, b, w, false); w = __builtin_amdgcn_cvt_pk_fp8_f32(c, d, w, true); return (unsigned)w; }
__device__ __forceinline__ float bf2f(short s) { return __builtin_bit_cast(float, ((unsigned)(unsigned short)s) << 16); }
typedef __bf16 bf16x2_t __attribute__((ext_vector_type(2)));
__device__ __forceinline__ unsigned cvtpk(float lo, float hi) { f32x2 v = {lo, hi}; bf16x2_t b = __builtin_convertvector(v, bf16x2_t); return __builtin_bit_cast(unsigned, b); }

__device__ __forceinline__ int opaque_wave(int wave) { asm volatile("" : "+s"(wave)); return wave; }
__device__ __forceinline__ int opaque_lane() { int l; asm volatile("v_mbcnt_lo_u32_b32 %0, -1, 0\n\tv_mbcnt_hi_u32_b32 %0, -1, %0" : "=v"(l)); return l; }
__device__ __forceinline__ int opaque_tid(int wave) { int l; asm volatile("v_mbcnt_lo_u32_b32 %0, -1, 0\n\tv_mbcnt_hi_u32_b32 %0, -1, %0" : "=v"(l)); return (wave << 6) | l; }
namespace pg8 {
constexpr int BM = 256, BK = 64, HALF = 128, HTB = HALF * BK * 2, STAGE_BYTES = 8 * HTB, NXCD = 8, WGM = 8;
__host__ __device__ __forceinline__ int lds_byte(int r, int c) { const int st = (r >> 4) * 2 + (c >> 5), rr = r & 15, cc = c & 31, ob = rr * 64 + cc * 2; return st * 1024 + (ob ^ (((ob >> 9) & 1) << 5)); }
__host__ __device__ __forceinline__ void stage_rc(int b, int& R, int& C) { const int st = b / 1024, sb = b % 1024, swz = sb ^ (((sb >> 9) & 1) << 5); R = (st >> 1) * 16 + swz / 64; C = (st & 1) * 32 + (swz % 64) / 2; }
__host__ __device__ __forceinline__ int perm32(int rho) { const int n = rho >> 4, i = rho & 15; return 8 * (i >> 2) + 4 * n + (i & 3); }

struct Unit { int pm, pn, kofs, nt, tag; };
constexpr int LD = 1024;
struct Gemm { const bf16_t* A; const bf16_t* Bt; };

struct StaticOrder {
    static constexpr bool UNIFORM = true;
    int nM, nN, nwg, G, c, nt;
    __device__ __forceinline__ void init(int M, int N, int K, int G_, int c_) { nM = M / BM; nN = N / BM; nwg = nM * nN; G = G_; c = c_; nt = K / BK; }
    __device__ __forceinline__ bool tile(int j, Unit& u) const {
        const long L = (long)j * G + c; if (L >= nwg) return false;
        int wgid = (int)L; { const int q = nwg / NXCD, r = nwg % NXCD, xcd = wgid % NXCD, off = wgid / NXCD; wgid = (xcd < r ? xcd * (q + 1) : r * (q + 1) + (xcd - r) * q) + off; }
        const int nig = WGM * nN, gid = wgid / nig, fm = gid * WGM, gsz = (nM - fm) < WGM ? (nM - fm) : WGM;
        u.pm = fm + ((wgid % nig) % gsz); u.pn = (wgid % nig) / gsz; return true;
    }
    __device__ __forceinline__ bool next(int i, Unit& u) const { if (!tile(i, u)) return false; u.kofs = 0; u.nt = nt; u.tag = 0; return true; }
};
struct TailOrder {
    static constexpr bool UNIFORM = false;
    int first, step, nt;
    __device__ __forceinline__ void init(int K, int G, int b) { const int stride = (G >= 64 && G % 64 == 0) ? G / 64 : 1; first = (b % stride == 0) ? b / stride : 64; step = G / stride; nt = K / BK; }
    __device__ __forceinline__ bool next(int i, Unit& u) const { const int j = first + i * step; if (j >= 64) return false; u.pm = j; u.pn = (NW_MAIN - C_F8) / BM; u.kofs = 0; u.nt = nt; u.tag = 0; return true; }
};
struct BranchOrder {
    static constexpr bool UNIFORM = false;
    StaticOrder so;
    __device__ __forceinline__ bool next(int i, Unit& u) const {
        const int j = i / 3, br = i - 3 * j; if (!so.tile(j, u)) return false;
        u.kofs = br * 512; u.nt = (br == 2) ? 2 : 4; u.tag = br; return true;
    }
};

typedef int i32x8 __attribute__((ext_vector_type(8)));
typedef int i32x4_t __attribute__((ext_vector_type(4)));
template <class Epi, class Sched, bool F8 = false, int F8PITCH = LD, bool ABLK = false>
__device__ __forceinline__ void gemm_phase(LAS unsigned char* lds, const Gemm g, const Sched& S, const Epi& E, int wave) {
    wave = opaque_wave(wave);
    const int tid = opaque_tid(wave), wid = wave, lane = tid & 63, wr = wid >> 2, wc = wid & 3, fr = lane & 15, fq = lane >> 4;
    unsigned voffA[2], voffB[2];
#pragma unroll
    for (int i = 0; i < 2; ++i) { int R, C; stage_rc(tid * 16 + i * 8192, R, C); const int Rb = Epi::PERM ? ((R & ~31) + perm32(R & 31)) : R;
        voffA[i] = ABLK ? (unsigned)g_off(R, C * 2, F8 ? F8PITCH : LD * 2) : (unsigned)(R * (F8 ? F8PITCH / 2 : LD) + C) * 2u; voffB[i] = (unsigned)(Rb * (F8 ? F8PITCH / 2 : LD) + C) * 2u; }
    constexpr size_t kstep = (size_t)(BK * 2);
    constexpr size_t kstepA = ABLK ? 2048 : kstep, kofA = ABLK ? 16 : 1;
    constexpr size_t ESZ = F8 ? 1 : 2;
    constexpr size_t hsA = F8 ? (size_t)HALF * F8PITCH : (size_t)HALF * LD * 2, hsB = hsA;
    constexpr size_t tsA = 2 * hsA, tsB = 2 * hsB;
    const unsigned ldsw = (unsigned)wid * 1024u;
    const int aoff = lds_byte(wr * 64 + fr, fq * 8), boff = lds_byte(wc * 32 + fr, fq * 8);
#define PG8_SA(b, h) (((b) * 2 + (h)) * HTB)
#define PG8_SB(b, h) ((4 + (b) * 2 + (h)) * HTB)
#define PG8_STAGE(bufoff, gbase, voff) do { _Pragma("unroll") for (int _i = 0; _i < 2; ++_i) { unsigned vo_ = (voff)[_i]; if (F8) asm volatile("" : "+v"(vo_));     \
        __builtin_amdgcn_global_load_lds((const unsigned*)((const char*)(gbase) + vo_), (LAS unsigned*)(lds + (bufoff) + ldsw + _i * 8192), 16, 0, 0); } } while (0)
#define PG8_LDA(dst, b, h) do { _Pragma("unroll") for (int m = 0; m < 4; ++m) { if (F8) { const i32x4_t lo_ = *(const LAS i32x4_t*)(lds + PG8_SA(b, h) + aoff + m * 2048), hi_ = *(const LAS i32x4_t*)(lds + PG8_SA(b, h) + aoff + m * 2048 + 1024); \
        dst##8[m] = __builtin_shufflevector(lo_, hi_, 0, 1, 2, 3, 4, 5, 6, 7); } else { _Pragma("unroll") for (int k = 0; k < 2; ++k) dst[m][k] = *(const LAS bf16x8*)(lds + PG8_SA(b, h) + aoff + m * 2048 + k * 1024); } } } while (0)
#define PG8_LDB(dst, b, h) do { _Pragma("unroll") for (int n = 0; n < 2; ++n) { if (F8) { const i32x4_t lo_ = *(const LAS i32x4_t*)(lds + PG8_SB(b, h) + boff + n * 2048), hi_ = *(const LAS i32x4_t*)(lds + PG8_SB(b, h) + boff + n * 2048 + 1024); \
        dst##8[n] = __builtin_shufflevector(lo_, hi_, 0, 1, 2, 3, 4, 5, 6, 7); } else { _Pragma("unroll") for (int k = 0; k < 2; ++k) dst[n][k] = *(const LAS bf16x8*)(lds + PG8_SB(b, h) + boff + n * 2048 + k * 1024); } } } while (0)
#define PG8_MMA(ai, bj, At, Bt) do { __builtin_amdgcn_s_setprio(1); _Pragma("unroll") for (int m = 0; m < 4; ++m) _Pragma("unroll") for (int n = 0; n < 2; ++n) { \
        if (F8) acc[ai][bj][m][n] = __builtin_amdgcn_mfma_scale_f32_16x16x128_f8f6f4(Bt##8[n], At##8[m], acc[ai][bj][m][n], 0, 0, 0, 0x7f7f7f7f, 0, 0x7f7f7f7f); \
        else { _Pragma("unroll") for (int k = 0; k < 2; ++k) acc[ai][bj][m][n] = __builtin_amdgcn_mfma_f32_16x16x32_bf16(Bt[n][k], At[m][k], acc[ai][bj][m][n], 0, 0, 0); } } \
        __builtin_amdgcn_s_setprio(0); } while (0)
#define PG8_WAIT_V(n) asm volatile("s_waitcnt vmcnt(" #n ")" ::: "memory")
#define PG8_WAIT_RELAX(nr, n, flag) asm volatile("s_waitcnt vmcnt(%0)\n\ts_cmp_lg_u32 %2, 0\n\ts_cbranch_scc1 1f\n\ts_waitcnt vmcnt(%1)\n1:" :: "n"(nr), "n"(n), "s"(flag) : "memory", "scc")
#define PG8_WAIT_L(n) asm volatile("s_waitcnt lgkmcnt(" #n ")" ::: "memory")
#define PG8_BAR __builtin_amdgcn_s_barrier()
#define PG8_SCHED __builtin_amdgcn_sched_barrier(0)
    Unit cur, nxt; int ui = 0;
    if (!S.next(0, cur)) return;
    f32x4 acc[2][2][4][2];
#pragma unroll
    for (int a = 0; a < 2; ++a)
#pragma unroll
        for (int b = 0; b < 2; ++b)
#pragma unroll
            for (int m = 0; m < 4; ++m)
#pragma unroll
                for (int n = 0; n < 2; ++n) acc[a][b][m][n] = (f32x4){0.f, 0.f, 0.f, 0.f};
    bf16x8 At[4][2], B0[2][2], B1[2][2];
    i32x8 At8[4], B08[2], B18[2];
    const char* cA = (const char*)g.A + (size_t)cur.pm * tsA + (size_t)cur.kofs * ESZ * kofA; const char* cB = (const char*)g.Bt + (size_t)cur.pn * tsB + (size_t)cur.kofs * ESZ;
    PG8_STAGE(PG8_SB(0, 0), cB, voffB); PG8_STAGE(PG8_SB(0, 1), cB + hsB, voffB); PG8_STAGE(PG8_SA(0, 0), cA, voffA); PG8_STAGE(PG8_SA(0, 1), cA + hsA, voffA);
    if (wr == 1) PG8_BAR;
    PG8_WAIT_V(2); PG8_BAR;
    PG8_STAGE(PG8_SB(1, 0), cB + kstep, voffB); PG8_STAGE(PG8_SA(1, 0), cA + kstepA, voffA); PG8_STAGE(PG8_SB(1, 1), cB + hsB + kstep, voffB);
    PG8_WAIT_V(6); PG8_BAR;
    for (;;) {
        const bool has_next = S.next(ui + 1, nxt);
        const char* nA = has_next ? (const char*)g.A + (size_t)nxt.pm * tsA + (size_t)nxt.kofs * ESZ * kofA : cA; const char* nB = has_next ? (const char*)g.Bt + (size_t)nxt.pn * tsB + (size_t)nxt.kofs * ESZ : cB;
        const int nt = cur.nt;
        for (int t = 0; t < nt; t += 2) {
            const bool last = (t == nt - 2);
            const char* a1 = cA + (size_t)(t + 1) * kstepA;
            const char* a2 = last ? nA : cA + (size_t)(t + 2) * kstepA; const char* b2 = last ? nB : cB + (size_t)(t + 2) * kstep;
            const char* a3 = a2 + kstepA; const char* b3 = b2 + kstep;
            PG8_LDB(B0, 0, 0); PG8_LDB(B1, 0, 1); PG8_SCHED; PG8_LDA(At, 0, 0); PG8_STAGE(PG8_SA(1, 1), a1 + hsA, voffA);
            if (Epi::NSTORE > 0 && Sched::UNIFORM) PG8_WAIT_RELAX(8 + Epi::NSTORE, 8, __builtin_amdgcn_readfirstlane((int)(ui > 0 && t == 0))); else PG8_WAIT_V(8);
            PG8_WAIT_L(0); PG8_BAR; PG8_MMA(0, 0, At, B0); PG8_MMA(0, 1, At, B1); PG8_BAR; PG8_SCHED;
            PG8_LDA(At, 0, 1); PG8_STAGE(PG8_SB(0, 0), b2, voffB); PG8_STAGE(PG8_SB(0, 1), b2 + hsB, voffB); PG8_STAGE(PG8_SA(0, 0), a2, voffA);
            if (Epi::NSTORE > 0 && Sched::UNIFORM) PG8_WAIT_RELAX(8 + Epi::NSTORE, 8, __builtin_amdgcn_readfirstlane((int)(ui > 0 && t == 0))); else PG8_WAIT_V(8);
            PG8_WAIT_L(0); PG8_BAR; PG8_MMA(1, 0, At, B0); PG8_MMA(1, 1, At, B1); PG8_BAR; PG8_SCHED;
            PG8_LDB(B0, 1, 0); PG8_LDB(B1, 1, 1); PG8_SCHED; PG8_LDA(At, 1, 0); PG8_STAGE(PG8_SA(0, 1), a2 + hsA, voffA);
            PG8_WAIT_V(8); PG8_WAIT_L(0); PG8_BAR; PG8_MMA(0, 0, At, B0); PG8_MMA(0, 1, At, B1); PG8_BAR; PG8_SCHED;
            PG8_LDA(At, 1, 1); PG8_STAGE(PG8_SB(1, 0), b3, voffB); PG8_STAGE(PG8_SB(1, 1), b3 + hsB, voffB); PG8_STAGE(PG8_SA(1, 0), a3, voffA);
            PG8_WAIT_V(8); PG8_WAIT_L(0); PG8_BAR; PG8_MMA(1, 0, At, B0); PG8_MMA(1, 1, At, B1); PG8_BAR; PG8_SCHED;
        }
        if (wr == 0) PG8_BAR;
        E(acc, cur, wr, wc, fr, fq);
        if (!has_next) break;
        if (!(Epi::KEEP_ACC && cur.tag < 2))
#pragma unroll
        for (int a = 0; a < 2; ++a)
#pragma unroll
            for (int b = 0; b < 2; ++b)
#pragma unroll
                for (int m = 0; m < 4; ++m)
#pragma unroll
                    for (int n = 0; n < 2; ++n) acc[a][b][m][n] = (f32x4){0.f, 0.f, 0.f, 0.f};
        cur = nxt; cA = nA; cB = nB; ++ui;
        if (wr == 1) PG8_BAR;
    }
    PG8_WAIT_V(0);
    PG8_BAR;
#undef PG8_SA
#undef PG8_SB
#undef PG8_STAGE
#undef PG8_LDA
#undef PG8_LDB
#undef PG8_MMA
#undef PG8_WAIT_V
#undef PG8_WAIT_RELAX
#undef PG8_WAIT_L
#undef PG8_BAR
#undef PG8_SCHED
}

__device__ __forceinline__ float sigmoidf_(float x) { return __builtin_amdgcn_rcpf(1.f + __expf(-x)); }

__device__ __forceinline__ size_t mg8_off(int row, int col) { return ((size_t)(row >> 4) * 96 + (size_t)(col >> 5)) * 512 + (size_t)((row & 15) * 32 + (col & 31)); }
struct EpiProj {
    static constexpr bool PERM = true, KEEP_ACC = false; static constexpr int NSTORE = 16;
    bf16_t* P; unsigned char* MG8; const float* cosT; const float* sinT; int coloff; float ascale;
    __device__ __forceinline__ void operator()(const f32x4 (&acc)[2][2][4][2], const Unit& u, int wr, int wc, int fr, int fq) const {
        { const int l_ = opaque_lane(); fr = l_ & 15; fq = l_ >> 4; }
        const int row0 = u.pm * BM + wr * 64 + fr;
#pragma unroll
        for (int bj = 0; bj < 2; ++bj) {
            const int colg = coloff + u.pn * BM + bj * HALF + wc * 32;
            const int col = colg + 8 * fq;
            const bool cik = (colg >= C_IK && colg < C_IK + 64);
            bf16_t* dbase = cik ? (bf16_t*)((char*)P - (WS_P - WS_IKC)) + (size_t)((col - C_IK) >> 5) * MC * 32 + ((col - C_IK) & 31) : P + p_col(col);
            #define DROW(row_) (cik ? (size_t)(row_) * 32 : p_off((row_), 0))
            if (colg < C_ROPE_END) {
                const int f4 = ((col & 63) >> 3) * 4;
                const float sc = ((colg < C_IQ || (colg >= C_BQ && colg < C_CK)) ? QSCALE : 1.f) * ascale;
#pragma unroll
                for (int ai = 0; ai < 2; ++ai) {
                    f32x4 cc[4], ss[4];
#pragma unroll
                    for (int m = 0; m < 4; ++m) { const int t = (row0 + ai * HALF + m * 16) & (SEQ - 1); cc[m] = *(const f32x4*)(cosT + t * 32 + f4); ss[m] = *(const f32x4*)(sinT + t * 32 + f4); }
#pragma unroll
                    for (int m = 0; m < 4; ++m) {
                        const int row = row0 + ai * HALF + m * 16;
                        const f32x4 c = cc[m], s = ss[m];
                        const f32x4 v0 = acc[ai][bj][m][0], v1 = acc[ai][bj][m][1];
                        const f32x4 o0 = (v0 * c - v1 * s) * sc, o1 = (v0 * s + v1 * c) * sc;
                        u32x4 w; w.x = cvtpk(o0[0], o0[1]); w.y = cvtpk(o0[2], o0[3]); w.z = cvtpk(o1[0], o1[1]); w.w = cvtpk(o1[2], o1[3]);
                        *(u32x4*)(dbase + DROW(row)) = w;
                    }
                    asm volatile("" ::: "memory");
                }
                asm volatile("" ::: "memory");
            } else if (colg < C_SIG_END) {
                const int mode = (colg < C_PLAIN_END) ? 0 : (colg < C_SILU_END ? 1 : 2);
#pragma unroll
                for (int ai = 0; ai < 2; ++ai)
#pragma unroll
                    for (int m = 0; m < 4; ++m) {
                        const int row = row0 + ai * HALF + m * 16;
                        f32x4 v0 = acc[ai][bj][m][0] * ascale, v1 = acc[ai][bj][m][1] * ascale;
                        if (mode != 0) {
#pragma unroll
                            for (int e = 0; e < 4; ++e) { const float s0 = sigmoidf_(v0[e]), s1 = sigmoidf_(v1[e]); v0[e] = (mode == 1) ? v0[e] * s0 : s0; v1[e] = (mode == 1) ? v1[e] * s1 : s1; }
                        }
                        if (mode == 2) { u32x2 w; w.x = pk4_fp8(v0[0], v0[1], v0[2], v0[3]); w.y = pk4_fp8(v1[0], v1[1], v1[2], v1[3]);
                            *(u32x2*)(MG8 + mg8_off(row, col - C_MG)) = w; }
                        else { u32x4 w; w.x = cvtpk(v0[0], v0[1]); w.y = cvtpk(v0[2], v0[3]); w.z = cvtpk(v1[0], v1[1]); w.w = cvtpk(v1[2], v1[3]);
                            *(u32x4*)(P + p_off(row, col)) = w; }
                    }
            }
        }
    }
};

struct EpiMerge {
    static constexpr bool PERM = true, KEEP_ACC = true; static constexpr int NSTORE = 0;
    const unsigned char* MG8; bf16_t* Mg; float ascale;
    __device__ __forceinline__ void operator()(f32x4 (&acc)[2][2][4][2], const Unit& u, int wr, int wc, int fr, int fq) const {
        { const int l_ = opaque_lane(); fr = l_ & 15; fq = l_ >> 4; }
        const int row0 = u.pm * BM + wr * 64 + fr; const int br = u.tag;
        const int colb = u.pn * BM + wc * 32 + 8 * fq;
        const float GMIN = 1e-18f;
#pragma unroll
        for (int ai = 0; ai < 2; ++ai) {
            u32x2 gt[4][2], gn[4][2];
#pragma unroll
            for (int m = 0; m < 4; ++m)
#pragma unroll
                for (int bj = 0; bj < 2; ++bj) gt[m][bj] = *(const u32x2*)(MG8 + mg8_off(row0 + ai * HALF + m * 16, br * 1024 + colb + bj * HALF));
            if (br != 2) {
#pragma unroll
                for (int m = 0; m < 4; ++m)
#pragma unroll
                    for (int bj = 0; bj < 2; ++bj) gn[m][bj] = *(const u32x2*)(MG8 + mg8_off(row0 + ai * HALF + m * 16, (br + 1) * 1024 + colb + bj * HALF));
            }
#pragma unroll
            for (int m = 0; m < 4; ++m)
#pragma unroll
                for (int bj = 0; bj < 2; ++bj) {
                    f32x4 v0 = acc[ai][bj][m][0], v1 = acc[ai][bj][m][1];
                    { const f32x2 a = __builtin_amdgcn_cvt_pk_f32_fp8((int)gt[m][bj].x, false), b = __builtin_amdgcn_cvt_pk_f32_fp8((int)gt[m][bj].x, true), c = __builtin_amdgcn_cvt_pk_f32_fp8((int)gt[m][bj].y, false), d = __builtin_amdgcn_cvt_pk_f32_fp8((int)gt[m][bj].y, true);
                      v0[0] *= __builtin_fmaxf(a.x, GMIN); v0[1] *= __builtin_fmaxf(a.y, GMIN); v0[2] *= __builtin_fmaxf(b.x, GMIN); v0[3] *= __builtin_fmaxf(b.y, GMIN);
                      v1[0] *= __builtin_fmaxf(c.x, GMIN); v1[1] *= __builtin_fmaxf(c.y, GMIN); v1[2] *= __builtin_fmaxf(d.x, GMIN); v1[3] *= __builtin_fmaxf(d.y, GMIN); }
                    if (br != 2) {
                        { const f32x2 a = __builtin_amdgcn_cvt_pk_f32_fp8((int)gn[m][bj].x, false), b = __builtin_amdgcn_cvt_pk_f32_fp8((int)gn[m][bj].x, true), c = __builtin_amdgcn_cvt_pk_f32_fp8((int)gn[m][bj].y, false), d = __builtin_amdgcn_cvt_pk_f32_fp8((int)gn[m][bj].y, true);
                          v0[0] *= __builtin_amdgcn_rcpf(__builtin_fmaxf(a.x, GMIN)); v0[1] *= __builtin_amdgcn_rcpf(__builtin_fmaxf(a.y, GMIN)); v0[2] *= __builtin_amdgcn_rcpf(__builtin_fmaxf(b.x, GMIN)); v0[3] *= __builtin_amdgcn_rcpf(__builtin_fmaxf(b.y, GMIN));
                          v1[0] *= __builtin_amdgcn_rcpf(__builtin_fmaxf(c.x, GMIN)); v1[1] *= __builtin_amdgcn_rcpf(__builtin_fmaxf(c.y, GMIN)); v1[2] *= __builtin_amdgcn_rcpf(__builtin_fmaxf(d.x, GMIN)); v1[3] *= __builtin_amdgcn_rcpf(__builtin_fmaxf(d.y, GMIN)); }
                        acc[ai][bj][m][0] = v0; acc[ai][bj][m][1] = v1;
                    } else {
                        const float sm_ = F8_SM * ascale;
                        u32x2 w; w.x = pk4_fp8(v0[0] * sm_, v0[1] * sm_, v0[2] * sm_, v0[3] * sm_); w.y = pk4_fp8(v1[0] * sm_, v1[1] * sm_, v1[2] * sm_, v1[3] * sm_);
                        *(u32x2*)((unsigned char*)Mg + g_off(row0 + ai * HALF + m * 16, colb + bj * HALF, DM)) = w;
                    }
                }
            asm volatile("" ::: "memory");
        }
    }
};

struct EpiResid {
    static constexpr bool PERM = false, KEEP_ACC = false; static constexpr int NSTORE = 0;
    const float* xin; float* out; float ascale;
    __device__ __forceinline__ void operator()(const f32x4 (&acc)[2][2][4][2], const Unit& u, int wr, int wc, int fr, int fq) const {
        { const int l_ = opaque_lane(); fr = l_ & 15; fq = l_ >> 4; }
        const int row0 = u.pm * BM + wr * 64 + fr; const int col0 = u.pn * BM + wc * 32 + 4 * fq;
#pragma unroll
        for (int ai = 0; ai < 2; ++ai)
#pragma unroll
            for (int mp = 0; mp < 4; mp += 2) {
                f32x4 bs[2][2][2];
#pragma unroll
                for (int m = 0; m < 2; ++m)
#pragma unroll
                    for (int bj = 0; bj < 2; ++bj)
#pragma unroll
                        for (int n = 0; n < 2; ++n) bs[m][bj][n] = *(const f32x4*)(xin + (size_t)(row0 + ai * HALF + (mp + m) * 16) * DM + col0 + bj * HALF + n * 16);
#pragma unroll
                for (int m = 0; m < 2; ++m)
#pragma unroll
                    for (int bj = 0; bj < 2; ++bj)
#pragma unroll
                        for (int n = 0; n < 2; ++n) *(f32x4*)(out + (size_t)(row0 + ai * HALF + (mp + m) * 16) * DM + col0 + bj * HALF + n * 16) = bs[m][bj][n] + acc[ai][bj][mp + m][n] * ascale;
                asm volatile("" ::: "memory");
            }
    }
};
}

template <class T> __device__ __forceinline__ T* launder(T* p) { asm volatile("" : "+s"(p)); return p; }
#define XB_TMO      128
#define XB_XCNT(j)  (256  + 64 * (j))
#define XB_XSUB(j)  (1280 + 64 * (j))
#define XB_XGEN(j)  (2304 + 64 * (j))
#define XB_TOP      3328
#define XB_TOPGEN   3392
#define XCD_BAR_WORDS 3456
#define XB_SPIN_CAP (1u << 18)
__device__ __forceinline__ unsigned xb_ld(unsigned* p)              { return __hip_atomic_load(p, __ATOMIC_RELAXED, __HIP_MEMORY_SCOPE_AGENT); }
__device__ __forceinline__ unsigned xb_add(unsigned* p, unsigned v) { return __hip_atomic_fetch_add(p, v, __ATOMIC_RELAXED, __HIP_MEMORY_SCOPE_AGENT); }
__device__ __forceinline__ unsigned xb_xcc_id() { return (unsigned)__builtin_amdgcn_s_getreg((3 << 11) | 20) & 0xFu; }
#define XB_SPIN(cond, bar) do { unsigned _sp = 0; while (cond) { __builtin_amdgcn_s_sleep(1); \
    if ((++_sp & 255u) == 0u) { if (xb_ld(&(bar)[XB_TMO])) break; if (_sp > XB_SPIN_CAP) { atomicAdd(&(bar)[XB_TMO], 1u); break; } } } } while (0)
struct XcdBarrier { unsigned* bar; unsigned x; volatile LAS unsigned* st; };
__device__ __forceinline__ XcdBarrier xcd_barrier_post(unsigned* bar, volatile LAS unsigned* st) {
    XcdBarrier b; b.bar = bar; b.x = xb_xcc_id(); b.st = st;
    if (threadIdx.x == 0) (void)xb_add(&bar[XB_XCNT(b.x)], 1u);
    return b;
}
__device__ __forceinline__ void xcd_barrier_complete(unsigned* bar, unsigned x, unsigned& nloc, unsigned& nx) {
    const unsigned G = gridDim.x * gridDim.y * gridDim.z;
    unsigned sum, cnt, mine, sp = 0u;
    for (;;) {
        sum = 0u; cnt = 0u; mine = 0u;
#pragma unroll
        for (unsigned j = 0; j < 16; ++j) { const unsigned c = xb_ld(&bar[XB_XCNT(j)]); sum += c; cnt += (c > 0u) ? 1u : 0u; mine = (j == x) ? c : mine; }
        if (sum == G) break;
        __builtin_amdgcn_s_sleep(1);
        if ((++sp & 255u) == 0u) { if (xb_ld(&bar[XB_TMO])) break; if (sp > XB_SPIN_CAP) { atomicAdd(&bar[XB_TMO], 1u); break; } }
    }
    nloc = mine > 0u ? mine : 1u; nx = cnt > 0u ? cnt : 1u;
}
template <bool FIRST> __device__ __forceinline__ void xcd_barrier(const XcdBarrier& b, int wave) {
    asm volatile("s_waitcnt vmcnt(0)" ::: "memory");
    __syncthreads();
    if (opaque_tid(wave) == 0) {
        unsigned* bar = launder(b.bar);
        unsigned bx = b.x; asm volatile("" : "+s"(bx));
        __builtin_amdgcn_s_waitcnt(0);
        unsigned nloc = b.st[0], nx = b.st[1];
        if (FIRST) { xcd_barrier_complete(bar, bx, nloc, nx); b.st[0] = nloc; b.st[1] = nx; }
        const unsigned old = xb_add(&bar[XB_XSUB(bx)], 1u);
        const unsigned gen = old / nloc;
        if (old + 1u == (gen + 1u) * nloc) {
            __builtin_amdgcn_fence(__ATOMIC_RELEASE, "agent");
            asm volatile("s_waitcnt vmcnt(0)" ::: "memory");
            const unsigned og = xb_add(&bar[XB_TOP], 1u);
            const unsigned tg = og / nx;
            if (og + 1u == (tg + 1u) * nx) xb_add(&bar[XB_TOPGEN], 1u);
            else XB_SPIN(xb_ld(&bar[XB_TOPGEN]) == tg, bar);
            __builtin_amdgcn_fence(__ATOMIC_ACQUIRE, "agent");
            xb_add(&bar[XB_XGEN(bx)], 1u);
            asm volatile("s_waitcnt vmcnt(0)" ::: "memory");
        } else {
            XB_SPIN(xb_ld(&bar[XB_XGEN(bx)]) == gen, bar);
            __builtin_amdgcn_fence(__ATOMIC_ACQUIRE, "agent");
            asm volatile("s_waitcnt vmcnt(0)" ::: "memory");
        }
    }
    __syncthreads();
}

struct Frame {
    LAS unsigned char* lds;
    volatile LAS unsigned* MISC;
    gu32* ctl;
    int tid, lane, wave, G;
};

__device__ __forceinline__ float wave_sum(float v) {
    v += __int_as_float(__builtin_amdgcn_update_dpp(0, __float_as_int(v), 0xB1, 0xf, 0xf, false));
    v += __int_as_float(__builtin_amdgcn_update_dpp(0, __float_as_int(v), 0x4E, 0xf, 0xf, false));
    v += __int_as_float(__builtin_amdgcn_update_dpp(0, __float_as_int(v), 0x141, 0xf, 0xf, false));
    v += __int_as_float(__builtin_amdgcn_update_dpp(0, __float_as_int(v), 0x140, 0xf, 0xf, false));
    v += __int_as_float(__builtin_amdgcn_update_dpp(0, __float_as_int(v), 0x142, 0xa, 0xf, false));
    v += __int_as_float(__builtin_amdgcn_update_dpp(0, __float_as_int(v), 0x143, 0xc, 0xf, false));
    return __int_as_float(__builtin_amdgcn_readlane(__float_as_int(v), 63));
}
__device__ __forceinline__ float shfl_xor_l(float v, int mask, int lane) { return __int_as_float(__builtin_amdgcn_ds_bpermute((lane ^ mask) << 2, __float_as_int(v))); }

__device__ __forceinline__ int src_col(int n) {
    if (n < C_ROPE_END) {
        int bn, bo;
        if (n < 384) { bn = 0; bo = 0; } else if (n < 640) { bn = 384; bo = 2432; } else if (n < 704) { bn = 640; bo = 2688; }
        else if (n < 768) { bn = 704; bo = 1920; } else if (n < 1152) { bn = 768; bo = 384; } else if (n < 1536) { bn = 1152; bo = 1536; }
        else if (n < 2304) { bn = 1536; bo = 2756; } else { bn = 2304; bo = 3524; }
        const int r = n - bn, head = r >> 6, p = r & 63, i = p >> 3, e = p & 7;
        const int dim = (e < 4) ? 4 * i + e : 32 + 4 * i + (e - 4);
        return bo + head * 64 + dim;
    }
    if (n < 3456) return 768 + (n - 3072);
    if (n < 3520) return 1984 + (n - 3456);
    if (n < 4288) return 4292 + (n - 3520);
    if (n < 4672) return 1152 + (n - 4288);
    if (n < 5056) return 2048 + (n - 4672);
    if (n < 5312) return 5060 + (n - 5056);
    if (n < 8384) return 5316 + (n - 5312);
    return -1;
}

template <bool PERMUTE, bool F8OUT = false>
__device__ __forceinline__ void transpose_item(const float* W, int ldw, int nblk, bf16_t* WT, int ldt, int koff, LAS float* scr, int item, int lane, int nbase = 0, int nrow0 = 0) {
    const int kb = item / nblk, nb = item % nblk, k0 = 64 * kb, n0 = nbase + 32 * nb;
    const int sc = PERMUTE ? src_col(n0 + (lane & 31)) : (n0 + (lane & 31));
    float wv[32];
    const float* wp = W + (size_t)(k0 + (lane >> 5)) * ldw + (sc >= 0 ? sc : 0);
#pragma unroll
    for (int i = 0; i < 32; ++i) wv[i] = wp[(size_t)(2 * i) * ldw];
#pragma unroll
    for (int i = 0; i < 32; ++i) { const int kk = 2 * i + (lane >> 5); scr[kk * 33 + (lane & 31)] = (sc >= 0) ? wv[i] : 0.f; }
    LDS_WAIT(); asm volatile("" ::: "memory");
    const int c = lane & 7;
#pragma unroll
    for (int j = 0; j < 4; ++j) { const int n = (lane >> 3) + 8 * j; const LAS float* s = scr + (8 * c) * 33 + n;
        if (F8OUT) { u32x2 o; o.x = pk4_fp8(s[0 * 33] * F8_SB, s[1 * 33] * F8_SB, s[2 * 33] * F8_SB, s[3 * 33] * F8_SB); o.y = pk4_fp8(s[4 * 33] * F8_SB, s[5 * 33] * F8_SB, s[6 * 33] * F8_SB, s[7 * 33] * F8_SB);
            *(u32x2*)((unsigned char*)WT + (size_t)(n0 - nrow0 + n) * ldt + koff + k0 + 8 * c) = o; }
        else { u32x4 o; o.x = pk2(s[0 * 33], s[1 * 33]); o.y = pk2(s[2 * 33], s[3 * 33]); o.z = pk2(s[4 * 33], s[5 * 33]); o.w = pk2(s[6 * 33], s[7 * 33]);
            *(u32x4*)(WT + (size_t)(n0 + n) * ldt + koff + k0 + 8 * c) = o; } }
    LDS_WAIT(); asm volatile("" ::: "memory");
}

template <bool TO_BF16, int NB>
__device__ __forceinline__ void rms_rows(const float* xrow, const float* g, void* orow, unsigned char* o8row, float* iwrow, const float* wiw, int lane) {
    f32x4 v[NB][4];
#pragma unroll
    for (int r = 0; r < NB; ++r) { const f32x4* xr = (const f32x4*)(xrow + (size_t)r * DM) + lane;
#pragma unroll
        for (int j = 0; j < 4; ++j) v[r][j] = xr[64 * j]; }
    const f32x4* gr = (const f32x4*)g + lane;
    f32x4 gv[4];
#pragma unroll
    for (int j = 0; j < 4; ++j) gv[j] = gr[64 * j];
#pragma unroll
    for (int r = 0; r < NB; ++r) {
        float s = 0.f;
#pragma unroll
        for (int j = 0; j < 4; ++j) s += (v[r][j].x * v[r][j].x + v[r][j].y * v[r][j].y) + (v[r][j].z * v[r][j].z + v[r][j].w * v[r][j].w);
        const float rs = 1.f / sqrtf(wave_sum(s) * (1.f / DM) + RMS_EPS);
#pragma unroll
        for (int j = 0; j < 4; ++j) v[r][j] = v[r][j] * rs * gv[j];
        if (TO_BF16) {
            u64* o8 = (u64*)((bf16_t*)orow + (size_t)r * DM) + lane;
            unsigned* o4 = (unsigned*)(o8row + (size_t)r * DM) + lane;
#pragma unroll
            for (int j = 0; j < 4; ++j) { const f32x4 w = v[r][j]; o8[64 * j] = (u64)pk2(w.x, w.y) | ((u64)pk2(w.z, w.w) << 32);
                o4[64 * j] = pk4_fp8(w.x * F8_SA, w.y * F8_SA, w.z * F8_SA, w.w * F8_SA); }
        } else {
            f32x4* o = (f32x4*)((float*)orow + (size_t)r * DM) + lane;
#pragma unroll
            for (int j = 0; j < 4; ++j) o[64 * j] = v[r][j];
        }
    }
    if (TO_BF16) {
        f32x4 acc[NB];
#pragma unroll
        for (int r = 0; r < NB; ++r) acc[r] = (f32x4){0.f, 0.f, 0.f, 0.f};
#pragma unroll
        for (int j = 0; j < 4; ++j) {
            f32x4 wk[4];
#pragma unroll
            for (int e = 0; e < 4; ++e) wk[e] = *(const f32x4*)(wiw + (size_t)(256 * j + 4 * lane + e) * INW);
#pragma unroll
            for (int r = 0; r < NB; ++r) acc[r] += wk[0] * v[r][j].x + wk[1] * v[r][j].y + wk[2] * v[r][j].z + wk[3] * v[r][j].w;
        }
#pragma unroll
        for (int r = 0; r < NB; ++r) { f32x4 t; t.x = wave_sum(acc[r].x); t.y = wave_sum(acc[r].y); t.z = wave_sum(acc[r].z); t.w = wave_sum(acc[r].w);
            if (lane == 0) *(f32x4*)(iwrow + (size_t)r * 4) = t * 0.0625f; }
    }
}

namespace att {
constexpr int SLOTB = 8192, NSLOT = 4;
constexpr size_t PO_STRIDE = (size_t)MC * 4 * 64, PML_STRIDE = (size_t)MC * 4 * 2;
constexpr int L_K = 0, L_V = NSLOT * SLOTB, L_M = 2 * NSLOT * SLOTB, L_KM = L_M + NSLOT * 2048, L_LUT = L_KM + 2048;
typedef LAS const char* lds_cptr;
typedef short v4i16_t __attribute__((ext_vector_type(4)));
__device__ __forceinline__ s16x4 vtr(lds_cptr p) { return __builtin_bit_cast(s16x4, __builtin_amdgcn_ds_read_tr16_b64_v4i16((LAS v4i16_t*)p)); }
__device__ __forceinline__ float swap_add(float v) { auto rr = __builtin_amdgcn_permlane32_swap(__float_as_uint(v), __float_as_uint(v), false, false); return __uint_as_float(rr[0]) + __uint_as_float(rr[1]); }
__device__ __forceinline__ float swap_max(float v) { auto rr = __builtin_amdgcn_permlane32_swap(__float_as_uint(v), __float_as_uint(v), false, false); return __builtin_fmaxf(__uint_as_float(rr[0]), __uint_as_float(rr[1])); }
__device__ __forceinline__ float fadd_s(float a, float b) { float r; asm("v_add_f32_e32 %0, %1, %2" : "=v"(r) : "v"(a), "v"(b)); return r; }
__device__ __forceinline__ float fmax_s(float a, float b) { float r; asm("v_max_f32_e32 %0, %1, %2" : "=v"(r) : "v"(a), "v"(b)); return r; }
__device__ __forceinline__ float fmax3_s(float a, float b, float c) { float r; asm("v_max3_f32 %0, %1, %2, %3" : "=v"(r) : "v"(a), "v"(b), "v"(c)); return r; }
__device__ __forceinline__ void glds16(const void* gsrc, unsigned lds_dst) { unsigned keep;
    asm volatile("s_mov_b32 %0, m0\n\ts_mov_b32 m0, %2\n\ts_nop 0\n\tglobal_load_lds_dwordx4 %1, off\n\ts_mov_b32 m0, %0" : "=&s"(keep) : "v"(gsrc), "s"(lds_dst) : "memory"); }
__device__ __forceinline__ void glds4(const void* gsrc, unsigned lds_dst) { unsigned keep;
    asm volatile("s_mov_b32 %0, m0\n\ts_mov_b32 m0, %2\n\ts_nop 0\n\tglobal_load_lds_dword %1, off\n\ts_mov_b32 m0, %0" : "=&s"(keep) : "v"(gsrc), "s"(lds_dst) : "memory"); }
#define WAITBAR(N) asm volatile("s_waitcnt vmcnt(" #N ") lgkmcnt(0)\n\ts_barrier" ::: "memory")

template <int MODE>
__device__ __forceinline__ void attn_unit(LAS unsigned char* lds, const bf16_t* __restrict__ P, bf16_t* __restrict__ Y, const u64* __restrict__ bits, float* __restrict__ PO, float* __restrict__ PML, int rowbase, int hsel, int blk, int wave) {
    wave = opaque_wave(wave);
    const int tid = opaque_tid(wave), lane = tid & 63, r32 = lane & 31, hi = lane >> 5; const int wid = wave;
    constexpr int RS = (MODE == 3) ? 8 : (MODE == 4) ? 4 : 1;
    const int roff = (MODE == 3) ? blk : (MODE == 4) ? (blk & 3) : 0;
    const int T0 = (MODE == 3) ? 0 : (MODE == 4) ? 256 * (blk >> 2) : blk * 256, qw0 = T0 + wid * 32, qpos = qw0 + r32;
    const int qtok = roff + RS * qpos;
    const float NEG = -INFINITY;
    constexpr int NDMA = (MODE == 1) ? 3 : 2;
    int n0 = 0, n1 = 0, s0 = 0, s1 = 0, NT;
    if (MODE == 0) NT = 4 + 4 * blk;
    else if (MODE == 1) NT = 4 * (blk + 1);
    else if (MODE == 3) NT = 4;
    else { s0 = T0 >= 128 ? T0 - 128 : 0; n0 = (T0 + 256 - s0) >> 6; NT = n0; }
    const int ycol = (MODE == 0) ? 64 * hsel : (MODE == 1) ? 384 + 64 * hsel : 768 + 64 * hsel;
    const int ycol8 = (MODE == 0) ? 64 * hsel : (MODE == 1) ? 512 + 64 * hsel : 1024 + 64 * hsel;
#define TILE_INFO(t, row0, seg) do { if (MODE == 0) { if ((t) < 4) { seg = 0; row0 = T0 + 64 * (t); } else { seg = 1; row0 = 64 * ((t) - 4); } } \
        else if (MODE == 1 || MODE == 3) { seg = (MODE == 3) ? 2 : 0; row0 = 64 * (t); } \
        else { seg = (MODE == 4) ? 1 : 0; row0 = s0 + 64 * (t); } } while (0)
#define KCOL(seg) ((MODE == 0) ? (C_AK + 64 * hsel) : (MODE == 1) ? C_BK : (C_CK + 64 * (4 * (seg) + hsel)))
#define VCOL(seg) ((MODE == 0) ? (C_AV + 64 * hsel) : (MODE == 1) ? C_BV : (C_CV + 64 * (4 * (seg) + hsel)))
#define QCOL(seg) ((MODE == 0) ? (C_AQ + 64 * hsel) : (MODE == 1) ? (C_BQ + 64 * hsel) : (C_CQ + 64 * (4 * (seg) + hsel)))
    const unsigned lds0 = (unsigned)(uintptr_t)lds;
    const u64* brow_dma = bits + (size_t)(rowbase + T0 + 32 * wid + (lane >> 1)) * 32;
    const char* kbase_l = (const char*)(P + p_off(rowbase + roff + RS * lane, wid * 8));
    const char* vbase_l = (const char*)(P + p_off(rowbase + roff + RS * (16 * (wid & 3) + (lane >> 2)), (wid >> 2) * 32 + (lane & 3) * 8));
#define ISSUE(t) do { int row0_, seg_; TILE_INFO((t), row0_, seg_); const int slot_ = (t) & (NSLOT - 1); \
        const size_t ko_ = (p_off(row0_ * RS, 0) + p_col(KCOL(seg_))) * 2, vo_ = (p_off(row0_ * RS, 0) + p_col(VCOL(seg_))) * 2;     \
        glds16(kbase_l + ko_, (unsigned)__builtin_amdgcn_readfirstlane(lds0 + L_K + slot_ * SLOTB + wid * 1024)); \
        glds16(vbase_l + vo_, (unsigned)__builtin_amdgcn_readfirstlane(lds0 + L_V + slot_ * SLOTB + wid * 1024)); \
        if (MODE == 1) glds4((const unsigned*)(brow_dma + (t)) + (lane & 1), (unsigned)__builtin_amdgcn_readfirstlane(lds0 + L_M + slot_ * 2048 + wid * 256)); } while (0)

    const bf16_t* qrow = P + p_off(rowbase + qtok, 0);
    asm volatile("s_waitcnt vmcnt(0)" ::: "memory");
    ISSUE(0);
    if (NT > 1) ISSUE(1);
    if (NT > 2) ISSUE(2);
    constexpr int NQ = 1;
    constexpr int QS0 = (MODE == 3) ? 2 : (MODE == 4) ? 1 : 0;
    bf16x8 qr[NQ][4];
#pragma unroll
    for (int sg = 0; sg < NQ; ++sg)
#pragma unroll
        for (int d0 = 0; d0 < 4; ++d0) qr[sg][d0] = *(const bf16x8*)(qrow + p_col(QCOL(QS0 + sg) + d0 * 16 + hi * 8));
    unsigned sel = 0u;
    if (MODE == 0) {
        LAS float* km = (LAS float*)(lds + L_KM);
        if (wid < blk) {
            const int c = lane & 7, rg = lane >> 3; float a[8];
#pragma unroll
            for (int e = 0; e < 8; ++e) a[e] = 0.f;
            const bf16_t* kp = P + p_off(rowbase + 256 * wid + rg, C_AK + 64 * hsel + 8 * c);
#pragma unroll 8
            for (int i = 0; i < 32; ++i) { const bf16x8 v = *(const bf16x8*)(kp + (size_t)(i >> 1) * PBLK * 512 + (size_t)(i & 1) * 256);
#pragma unroll
                for (int e = 0; e < 8; ++e) a[e] += bf2f(v[e]); }
#pragma unroll
            for (int e = 0; e < 8; ++e) { a[e] += shfl_xor_l(a[e], 8, lane); a[e] += shfl_xor_l(a[e], 16, lane); a[e] += shfl_xor_l(a[e], 32, lane); }
            if (rg == 0) {
#pragma unroll
                for (int e = 0; e < 8; ++e) km[wid * 64 + 8 * c + e] = a[e] * (1.f / 256.f);
            }
        }
        __syncthreads();
        float g[7];
#pragma unroll
        for (int j = 0; j < 7; ++j) {
            float part = 0.f;
            if (j < blk) {
#pragma unroll
                for (int d0 = 0; d0 < 4; ++d0) { const f32x4 k0 = *(const LAS f32x4*)(km + j * 64 + 16 * d0 + 8 * hi), k1 = *(const LAS f32x4*)(km + j * 64 + 16 * d0 + 8 * hi + 4);
#pragma unroll
                    for (int e = 0; e < 4; ++e) part += bf2f(qr[0][d0][e]) * k0[e] + bf2f(qr[0][d0][4 + e]) * k1[e]; }
                part = swap_add(part);
            }
            g[j] = (j < blk) ? part : NEG;
        }
#pragma unroll
        for (int rep = 0; rep < 3; ++rep) { float bv = NEG; int best = -1;
#pragma unroll
            for (int j = 0; j < 7; ++j) { const bool ok = (j < blk) && !((sel >> j) & 1u) && (g[j] > bv); if (ok) { bv = g[j]; best = j; } }
            if (best >= 0) sel |= 1u << best; }
    }
    f32x16 o0 = {}, o1 = {}; float m_run = 0.f, l_run = 0.f; f32x16 negm = {}; asm volatile("" : "+v"(negm));
    constexpr float DEFER_THR = 8.f;
    bool fresh = true;
    const lds_cptr lds3 = (lds_cptr)lds;
    const lds_cptr kp0 = lds3 + L_K + hi * 1024 + r32 * 16;
    const lds_cptr vp0 = lds3 + L_V + ((lane >> 4) & 1) * 32 + (lane & 3) * 8 + (4 * hi + ((lane & 15) >> 2)) * 64;
    const lds_cptr mp0 = lds3 + L_M + (32 * wid + r32) * 8;
#pragma unroll
    for (int sg = 0; sg < NQ; ++sg)
#pragma unroll
        for (int d0 = 0; d0 < 4; ++d0) asm volatile("" : "+v"(qr[sg][d0]));
    WAITBAR(0);
    for (int t = 0; t < NT; ++t) {
        int row0, seg; TILE_INFO(t, row0, seg);
        bool active;
        if (MODE == 0) active = (seg == 0) ? (row0 <= qw0 + 31) : (__any((sel >> (row0 >> 8)) & 1u) != 0);
        else if (MODE == 1 || MODE == 3) active = (row0 <= qw0 + 31);
        else active = (row0 <= qw0 + 31) && (row0 + 63 + 128 >= qw0);
        if (!active) { if (t + 3 < NT) ISSUE(t + 3); }
        if (active) {
            const int slot = (t & (NSLOT - 1)) * SLOTB;
            u32x2 mw = {0u, 0u}; if (MODE == 1) mw = *(const LAS u32x2*)(mp0 + (t & (NSLOT - 1)) * 2048);
            bf16x8 kf[8];
            { const lds_cptr kp = kp0 + slot;
#pragma unroll
              for (int j = 0; j < 4; ++j) { kf[2 * j] = *(const LAS bf16x8*)(kp + j * 2048); kf[2 * j + 1] = *(const LAS bf16x8*)(kp + j * 2048 + 512); } }
            if (t + 3 < NT) ISSUE(t + 3);
            s16x4 vlo[2][4], vhi[2][4];
            { const lds_cptr vp = vp0 + slot;
#pragma unroll
              for (int d0 = 0; d0 < 2; ++d0)
#pragma unroll
                  for (int ks = 0; ks < 4; ++ks) { vlo[d0][ks] = vtr(vp + d0 * 4096 + ks * 1024); vhi[d0][ks] = vtr(vp + d0 * 4096 + ks * 1024 + 512); } }
            f32x16 p0 = __builtin_amdgcn_mfma_f32_32x32x16_bf16(kf[0], qr[0][0], negm, 0, 0, 0), p1 = __builtin_amdgcn_mfma_f32_32x32x16_bf16(kf[1], qr[0][0], negm, 0, 0, 0);
#pragma unroll
            for (int d0 = 1; d0 < 4; ++d0) { p0 = __builtin_amdgcn_mfma_f32_32x32x16_bf16(kf[2 * d0], qr[0][d0], p0, 0, 0, 0); p1 = __builtin_amdgcn_mfma_f32_32x32x16_bf16(kf[2 * d0 + 1], qr[0][d0], p1, 0, 0, 0); }
            if (MODE == 0) {
                if (seg == 0) { if (row0 + 63 > qw0) { const int kb = row0 + 4 * hi;
#pragma unroll
                    for (int r = 0; r < 16; ++r) { const int kv = kb + (r & 3) + 8 * (r >> 2); if (kv > qpos) p0[r] = NEG; if (kv + 32 > qpos) p1[r] = NEG; } } }
                else { if (!((sel >> (row0 >> 8)) & 1u)) {
#pragma unroll
                    for (int r = 0; r < 16; ++r) { p0[r] = NEG; p1[r] = NEG; } } }
            } else if (MODE == 1) {
                const int lo = (int)(mw.x >> (4 * hi)), hw = (int)(mw.y >> (4 * hi));
#pragma unroll
                for (int r = 0; r < 16; ++r) { const unsigned m0_ = (unsigned)__builtin_amdgcn_sbfe(lo, (r & 3) + 8 * (r >> 2), 1), m1_ = (unsigned)__builtin_amdgcn_sbfe(hw, (r & 3) + 8 * (r >> 2), 1);
                    p0[r] = __uint_as_float((__float_as_uint(p0[r]) & m0_) | (0xff800000u & ~m0_)); p1[r] = __uint_as_float((__float_as_uint(p1[r]) & m1_) | (0xff800000u & ~m1_)); }
            } else {
                const int lg = (MODE == 3) ? 1 : 0; const int base = qpos - row0 - 4 * hi;
#pragma unroll
                for (int r = 0; r < 16; ++r) { const unsigned d0_ = (unsigned)(base - ((r & 3) + 8 * (r >> 2))), d1_ = d0_ - 32u;
                    if (__builtin_rotateright32(d0_, (unsigned)lg) > 128u) p0[r] = NEG; if (__builtin_rotateright32(d1_, (unsigned)lg) > 128u) p1[r] = NEG; }
            }
            asm volatile("s_nop 11" : "+v"(p0), "+v"(p1));
            float ma = fmax3_s(p0[0], p0[1], p1[0]), mb = fmax3_s(p0[2], p0[3], p1[1]);
            ma = fmax3_s(ma, p1[2], p1[3]);
#pragma unroll
            for (int r = 4; r < 16; r += 4) { ma = fmax3_s(ma, p0[r], p0[r + 1]); mb = fmax3_s(mb, p0[r + 2], p0[r + 3]);
                ma = fmax3_s(ma, p1[r], p1[r + 1]); mb = fmax3_s(mb, p1[r + 2], p1[r + 3]); }
            const float rm = swap_max(__builtin_fmaxf(ma, mb));
            if (fresh || __any(rm > DEFER_THR)) {
                const float dl = fresh ? ((rm == NEG) ? 0.f : rm) : __builtin_fmaxf(rm, 0.f); m_run += dl; fresh = false;
                const float f = __builtin_amdgcn_exp2f(-dl); l_run *= f;
#pragma unroll
                for (int r = 0; r < 16; ++r) { p0[r] -= dl; p1[r] -= dl; o0[r] *= f; o1[r] *= f; negm[r] = -m_run; }
                asm volatile("" : "+v"(negm));
            }
            float ls0 = 0.f, ls1 = 0.f;
#pragma unroll
            for (int r = 0; r < 16; ++r) { p0[r] = __builtin_amdgcn_exp2f(p0[r]); p1[r] = __builtin_amdgcn_exp2f(p1[r]); }
            asm volatile("" : "+v"(p0), "+v"(p1));
#pragma unroll
            for (int r = 0; r < 16; ++r) { ls0 = fadd_s(ls0, p0[r]); ls1 = fadd_s(ls1, p1[r]); }
            l_run = fadd_s(l_run, fadd_s(ls0, ls1));
            u32x4 pw[4];
            pw[0] = (u32x4){cvtpk(p0[0], p0[1]), cvtpk(p0[2], p0[3]), cvtpk(p0[4], p0[5]), cvtpk(p0[6], p0[7])};
            pw[1] = (u32x4){cvtpk(p0[8], p0[9]), cvtpk(p0[10], p0[11]), cvtpk(p0[12], p0[13]), cvtpk(p0[14], p0[15])};
            pw[2] = (u32x4){cvtpk(p1[0], p1[1]), cvtpk(p1[2], p1[3]), cvtpk(p1[4], p1[5]), cvtpk(p1[6], p1[7])};
            pw[3] = (u32x4){cvtpk(p1[8], p1[9]), cvtpk(p1[10], p1[11]), cvtpk(p1[12], p1[13]), cvtpk(p1[14], p1[15])};
#pragma unroll
            for (int d0 = 0; d0 < 2; ++d0)
#pragma unroll
                for (int ks = 0; ks < 4; ++ks) {
                    const bf16x8 vf = (bf16x8){vlo[d0][ks][0], vlo[d0][ks][1], vlo[d0][ks][2], vlo[d0][ks][3], vhi[d0][ks][0], vhi[d0][ks][1], vhi[d0][ks][2], vhi[d0][ks][3]};
                    if (d0 == 0) o0 = __builtin_amdgcn_mfma_f32_32x32x16_bf16(vf, __builtin_bit_cast(bf16x8, pw[ks]), o0, 0, 0, 0);
                    else         o1 = __builtin_amdgcn_mfma_f32_32x32x16_bf16(vf, __builtin_bit_cast(bf16x8, pw[ks]), o1, 0, 0, 0);
                }
        }
        const int ahead = NT - 2 - t;
        if (MODE == 1) { if (ahead >= 2) WAITBAR(6); else if (ahead == 1) WAITBAR(3); else WAITBAR(0); }
        else           { if (ahead >= 2) WAITBAR(4); else if (ahead == 1) WAITBAR(2); else WAITBAR(0); }
    }
    const float l_tot = swap_add(l_run);
    if (MODE == 3 || MODE == 4) {
        constexpr size_t PSEL = (MODE == 4) ? 1 : 0;
        float* po = PO + PSEL * PO_STRIDE + ((size_t)(rowbase + qtok) * 4 + hsel) * 64;
#pragma unroll
        for (int d0 = 0; d0 < 2; ++d0)
#pragma unroll
            for (int g4 = 0; g4 < 4; ++g4) { const int dim = 32 * d0 + 8 * g4 + 4 * hi;
                *(f32x4*)(po + dim) = (d0 == 0) ? (f32x4){o0[4 * g4], o0[4 * g4 + 1], o0[4 * g4 + 2], o0[4 * g4 + 3]} : (f32x4){o1[4 * g4], o1[4 * g4 + 1], o1[4 * g4 + 2], o1[4 * g4 + 3]}; }
        if (hi == 0) *(f32x2*)(PML + PSEL * PML_STRIDE + ((size_t)(rowbase + qtok) * 4 + hsel) * 2) = (f32x2){m_run, l_tot};
    } else {
        float sc_o = 1.f, sc_p = 0.f, sc_q = 0.f, L = l_tot;
        const float* po = PO + ((size_t)(rowbase + qtok) * 4 + hsel) * 64;
        if (MODE == 2) {
            const f32x2 ml = *(const f32x2*)(PML + ((size_t)(rowbase + qtok) * 4 + hsel) * 2), ml1 = *(const f32x2*)(PML + PML_STRIDE + ((size_t)(rowbase + qtok) * 4 + hsel) * 2);
            const float M = __builtin_fmaxf(__builtin_fmaxf(m_run, ml.x), ml1.x);
            sc_o = __builtin_amdgcn_exp2f(m_run - M); sc_p = __builtin_amdgcn_exp2f(ml.x - M); sc_q = __builtin_amdgcn_exp2f(ml1.x - M);
            L = l_tot * sc_o + ml.y * sc_p + ml1.y * sc_q;
        }
        const float inv = 1.f / L;
        const bf16_t* grow = qrow + p_col(C_GA + ycol); const int yr_ = rowbase + qtok;
#pragma unroll
        for (int d0 = 0; d0 < 2; ++d0)
#pragma unroll
            for (int g4 = 0; g4 < 4; ++g4) {
                const int dim = 32 * d0 + 8 * g4 + 4 * hi;
                const s16x4 gt = *(const s16x4*)(grow + p_col(dim));
                f32x4 pp = {0.f, 0.f, 0.f, 0.f}, pq = {0.f, 0.f, 0.f, 0.f}; if (MODE == 2) { pp = *(const f32x4*)(po + dim); pq = *(const f32x4*)(po + PO_STRIDE + dim); }
                float v[4];
#pragma unroll
                for (int e = 0; e < 4; ++e) v[e] = ((d0 == 0 ? o0[4 * g4 + e] : o1[4 * g4 + e]) * sc_o + pp[e] * sc_p + pq[e] * sc_q) * inv * bf2f(gt[e]);
                *(unsigned*)((unsigned char*)Y + g_off(yr_, ycol8 + dim, YP)) = pk4_fp8(v[0] * F8_SY, v[1] * F8_SY, v[2] * F8_SY, v[3] * F8_SY);
            }
        if ((MODE == 0 || MODE == 1) && hsel == 5) {
#pragma unroll
            for (int j = 0; j < 4; ++j) *(u32x4*)((unsigned char*)Y + g_off(yr_, ycol8 + 64 + 64 * hi + 16 * j, YP)) = (u32x4){0u, 0u, 0u, 0u};
        }
    }
#undef TILE_INFO
#undef KCOL
#undef VCOL
#undef QCOL
#undef ISSUE
}

template <int MODE>
__device__ __forceinline__ void attn_unit2(LAS unsigned char* lds, const bf16_t* __restrict__ P, bf16_t* __restrict__ Y, const u64* __restrict__ bits, int rowbase, int hsel, int blk, int wave) {
    wave = opaque_wave(wave);
    const int tid = opaque_tid(wave), lane = tid & 63, r32 = lane & 31, hi = lane >> 5; const int wid = wave;
    const float NEG = -INFINITY;
    const int T0a = (MODE == 0) ? 512 * blk : 256 * blk, T0b = (MODE == 0) ? T0a + 256 : T0a;
    const int NT = (MODE == 0) ? 8 * (blk + 1) : 4 * (blk + 1);
    const int kcol = (MODE == 0) ? (C_AK + 64 * hsel) : C_BK, vcol = (MODE == 0) ? (C_AV + 64 * hsel) : C_BV;
#define T2_ROW0(t) ((MODE == 1) ? 64 * (t) : ((t) < 4) ? (T0b + 64 * (t)) : ((t) < 8) ? (T0a + 64 * ((t) - 4)) : 64 * ((t) - 8))
    int qw0[2], qpos[2]; qw0[0] = T0a + wid * 32; qw0[1] = T0b + wid * 32; qpos[0] = qw0[0] + r32; qpos[1] = qw0[1] + r32;
    const unsigned lds0 = (unsigned)(uintptr_t)lds;
    const u64* brow_dma = bits + ((size_t)((rowbase + T0a) >> 5) + wid) * 1024 + (lane >> 1);
    const char* kbase_l = (const char*)(P + p_off(rowbase + lane, wid * 8));
    const char* vbase_l = (const char*)(P + p_off(rowbase + 16 * (wid & 3) + (lane >> 2), (wid >> 2) * 32 + (lane & 3) * 8));
#define ISSUE2(t) do { const int row0_ = T2_ROW0(t); const int slot_ = (t) & (NSLOT - 1); \
        const size_t ko_ = (p_off(row0_, 0) + p_col(kcol)) * 2, vo_ = (p_off(row0_, 0) + p_col(vcol)) * 2;     \
        glds16(kbase_l + ko_, (unsigned)__builtin_amdgcn_readfirstlane(lds0 + L_K + slot_ * SLOTB + wid * 1024)); \
        glds16(vbase_l + vo_, (unsigned)__builtin_amdgcn_readfirstlane(lds0 + L_V + slot_ * SLOTB + wid * 1024)); \
        if (MODE == 1) glds4((const unsigned*)(brow_dma + (t) * 32) + (lane & 1), (unsigned)__builtin_amdgcn_readfirstlane(lds0 + L_M + slot_ * 2048 + wid * 256)); } while (0)
    asm volatile("s_waitcnt vmcnt(0)" ::: "memory");
    ISSUE2(0); ISSUE2(1); ISSUE2(2);
    bf16x8 qr[2][4];
#pragma unroll
    for (int g = 0; g < 2; ++g) { const bf16_t* qrow = P + p_off(rowbase + qpos[g], (MODE == 0) ? (C_AQ + 64 * hsel) : (C_BQ + 64 * (2 * hsel + g)));
#pragma unroll
        for (int d0 = 0; d0 < 4; ++d0) qr[g][d0] = *(const bf16x8*)(qrow + p_col(d0 * 16 + hi * 8)); }
    unsigned sel[2] = {0u, 0u};
    if (MODE == 0) {
        LAS float* km = (LAS float*)(lds + L_KM);
        if (wid < 2 * blk + 1) {
            const int c = lane & 7, rg = lane >> 3; float a[8];
#pragma unroll
            for (int e = 0; e < 8; ++e) a[e] = 0.f;
            const bf16_t* kp = P + p_off(rowbase + 256 * wid + rg, C_AK + 64 * hsel + 8 * c);
#pragma unroll 8
            for (int i = 0; i < 32; ++i) { const bf16x8 v = *(const bf16x8*)(kp + (size_t)(i >> 1) * PBLK * 512 + (size_t)(i & 1) * 256);
#pragma unroll
                for (int e = 0; e < 8; ++e) a[e] += bf2f(v[e]); }
#pragma unroll
            for (int e = 0; e < 8; ++e) { a[e] += shfl_xor_l(a[e], 8, lane); a[e] += shfl_xor_l(a[e], 16, lane); a[e] += shfl_xor_l(a[e], 32, lane); }
            if (rg == 0) {
#pragma unroll
                for (int e = 0; e < 8; ++e) km[wid * 64 + 8 * c + e] = a[e] * (1.f / 256.f);
            }
        }
        __syncthreads();
#pragma unroll
        for (int g = 0; g < 2; ++g) {
            const int nb = 2 * blk + g;
            float gt[7];
#pragma unroll
            for (int j = 0; j < 7; ++j) {
                float part = 0.f;
                if (j < nb) {
#pragma unroll
                    for (int d0 = 0; d0 < 4; ++d0) { const f32x4 k0 = *(const LAS f32x4*)(km + j * 64 + 16 * d0 + 8 * hi), k1 = *(const LAS f32x4*)(km + j * 64 + 16 * d0 + 8 * hi + 4);
#pragma unroll
                        for (int e = 0; e < 4; ++e) part += bf2f(qr[g][d0][e]) * k0[e] + bf2f(qr[g][d0][4 + e]) * k1[e]; }
                    part = swap_add(part);
                }
                gt[j] = (j < nb) ? part : NEG;
            }
            unsigned s_ = 0u;
#pragma unroll
            for (int rep = 0; rep < 3; ++rep) { float bv = NEG; int best = -1;
#pragma unroll
                for (int j = 0; j < 7; ++j) { const bool ok = (j < nb) && !((s_ >> j) & 1u) && (gt[j] > bv); if (ok) { bv = gt[j]; best = j; } }
                if (best >= 0) s_ |= 1u << best; }
            sel[g] = s_;
        }
    }
    f32x16 o0[2], o1[2]; float m_run[2], l_run[2], mx_run[2]; bool shifted[2];
#pragma unroll
    for (int g = 0; g < 2; ++g) { o0[g] = (f32x16){}; o1[g] = (f32x16){}; m_run[g] = 0.f; l_run[g] = 0.f; mx_run[g] = NEG; shifted[g] = false; }
    constexpr float SHIFT_THR = 64.f;
    const lds_cptr lds3 = (lds_cptr)lds;
    const lds_cptr kp0 = lds3 + L_K + hi * 1024 + r32 * 16;
    const lds_cptr vp0 = lds3 + L_V + ((lane >> 4) & 1) * 32 + (lane & 3) * 8 + (4 * hi + ((lane & 15) >> 2)) * 64;
    const lds_cptr mp0 = lds3 + L_M + (32 * wid + r32) * 8;
#pragma unroll
    for (int g = 0; g < 2; ++g)
#pragma unroll
        for (int d0 = 0; d0 < 4; ++d0) asm volatile("" : "+v"(qr[g][d0]));
    if (MODE == 1 && tid < 16) {
        f32x4 e; e[0] = (tid & 1) ? 0.f : NEG; e[1] = (tid & 2) ? 0.f : NEG; e[2] = (tid & 4) ? 0.f : NEG; e[3] = (tid & 8) ? 0.f : NEG;
        *(LAS f32x4*)(lds + L_LUT + 16 * tid) = e;
    }
    WAITBAR(0);
    if (wid < 4) __builtin_amdgcn_s_setprio(2); else __builtin_amdgcn_s_setprio(0);
    for (int t = 0; t < NT; ++t) {
        const int row0 = T2_ROW0(t);
        bool act[2];
        if (MODE == 0) {
            const int b = row0 >> 8;
#pragma unroll
            for (int g = 0; g < 2; ++g) { const int own = 2 * blk + g; act[g] = (b == own) ? (row0 <= qw0[g] + 31) : (b < own) ? (__any((sel[g] >> b) & 1u) != 0) : false; }
        } else { act[0] = act[1] = (row0 <= qw0[0] + 31); }
        const int slot = (t & (NSLOT - 1)) * SLOTB;
        u32x2 mw = {0u, 0u}; if (MODE == 1 && act[0]) mw = *(const LAS u32x2*)(mp0 + (t & (NSLOT - 1)) * 2048);
        if (t + 3 < NT) ISSUE2(t + 3);
#pragma unroll
        for (int g = 0; g < 2; ++g) {
          if (act[g]) {
            f32x16 p0 = {}, p1 = {};
            if (MODE == 1) {
                const unsigned lo = mw.x >> (4 * hi), hw = mw.y >> (4 * hi);
                const lds_cptr lut = lds3 + L_LUT;
#pragma unroll
                for (int k = 0; k < 4; ++k) {
                    const f32x4 b0 = *(const LAS f32x4*)(lut + (((lo >> (8 * k)) & 15u) << 4)), b1 = *(const LAS f32x4*)(lut + (((hw >> (8 * k)) & 15u) << 4));
#pragma unroll
                    for (int j = 0; j < 4; ++j) { p0[4 * k + j] = b0[j]; p1[4 * k + j] = b1[j]; }
                }
            }
            __builtin_amdgcn_sched_barrier(0);
            { const lds_cptr kp = kp0 + slot;
              bf16x8 ka[4], kb[4];
#pragma unroll
              for (int j = 0; j < 4; ++j) { ka[j] = *(const LAS bf16x8*)(kp + j * 2048); kb[j] = *(const LAS bf16x8*)(kp + j * 2048 + 512); }
              p0 = __builtin_amdgcn_mfma_f32_32x32x16_bf16(ka[0], qr[g][0], p0, 0, 0, 0);
              p1 = __builtin_amdgcn_mfma_f32_32x32x16_bf16(kb[0], qr[g][0], p1, 0, 0, 0);
#pragma unroll
              for (int d0 = 1; d0 < 4; ++d0) { p0 = __builtin_amdgcn_mfma_f32_32x32x16_bf16(ka[d0], qr[g][d0], p0, 0, 0, 0); p1 = __builtin_amdgcn_mfma_f32_32x32x16_bf16(kb[d0], qr[g][d0], p1, 0, 0, 0); } }
            __builtin_amdgcn_sched_group_barrier(0x100, 4, 0);
#pragma unroll
            for (int i = 0; i < 4; ++i) { __builtin_amdgcn_sched_group_barrier(0x008, 1, 0); __builtin_amdgcn_sched_group_barrier(0x100, 1, 0); }
            __builtin_amdgcn_sched_group_barrier(0x008, 4, 0);
            __builtin_amdgcn_sched_barrier(0);
            s16x4 vl0[4], vh0[4];
            { const lds_cptr vp = vp0 + slot;
#pragma unroll
              for (int ks = 0; ks < 4; ++ks) { vl0[ks] = vtr(vp + ks * 1024); vh0[ks] = vtr(vp + ks * 1024 + 512); } }
            __builtin_amdgcn_sched_barrier(0);
            if (shifted[g]) {
#pragma unroll
                for (int r = 0; r < 16; ++r) { p0[r] -= m_run[g]; p1[r] -= m_run[g]; } }
            if (MODE == 0) {
                if ((row0 >> 8) == 2 * blk + g) { if (row0 + 63 > qw0[g]) { const int kb_ = row0 + 4 * hi;
#pragma unroll
                    for (int r = 0; r < 16; ++r) { const int kv = kb_ + (r & 3) + 8 * (r >> 2); if (kv > qpos[g]) p0[r] = NEG; if (kv + 32 > qpos[g]) p1[r] = NEG; } } }
                else { if (!((sel[g] >> (row0 >> 8)) & 1u)) { float ng = NEG; asm volatile("" : "+v"(ng));
#pragma unroll
                    for (int r = 0; r < 16; ++r) { p0[r] = ng; p1[r] = ng; } } }
            }
            asm volatile("s_nop 11" : "+v"(p0), "+v"(p1));
            float ma = fmax3_s(p0[0], p0[1], p1[0]), mb = fmax3_s(p0[2], p0[3], p1[1]);
            ma = fmax3_s(ma, p1[2], p1[3]);
#pragma unroll
            for (int r = 4; r < 16; r += 4) { ma = fmax3_s(ma, p0[r], p0[r + 1]); mb = fmax3_s(mb, p0[r + 2], p0[r + 3]);
                ma = fmax3_s(ma, p1[r], p1[r + 1]); mb = fmax3_s(mb, p1[r + 2], p1[r + 3]); }
            const float rm = swap_max(__builtin_fmaxf(ma, mb));
            const bool up = rm > SHIFT_THR, down = (mx_run[g] == NEG) && (rm < -SHIFT_THR) && (rm != NEG);
            if (__any(up || down)) {
                const float dl = (up || down) ? rm : 0.f; m_run[g] += dl; shifted[g] = true;
                const float f = __builtin_amdgcn_exp2f(-dl); l_run[g] *= f;
#pragma unroll
                for (int r = 0; r < 16; ++r) { p0[r] -= dl; p1[r] -= dl; o0[g][r] *= f; o1[g][r] *= f; }
                mx_run[g] = __builtin_fmaxf(mx_run[g], rm);
            } else mx_run[g] = __builtin_fmaxf(mx_run[g], rm);
            float ls0 = 0.f, ls1 = 0.f;
#pragma unroll
            for (int r = 0; r < 16; ++r) { p0[r] = __builtin_amdgcn_exp2f(p0[r]); p1[r] = __builtin_amdgcn_exp2f(p1[r]); }
            asm volatile("" : "+v"(p0), "+v"(p1));
#pragma unroll
            for (int r = 0; r < 16; ++r) { ls0 = fadd_s(ls0, p0[r]); ls1 = fadd_s(ls1, p1[r]); }
            l_run[g] = fadd_s(l_run[g], fadd_s(ls0, ls1));
            u32x4 pw[4];
            pw[0] = (u32x4){cvtpk(p0[0], p0[1]), cvtpk(p0[2], p0[3]), cvtpk(p0[4], p0[5]), cvtpk(p0[6], p0[7])};
            pw[1] = (u32x4){cvtpk(p0[8], p0[9]), cvtpk(p0[10], p0[11]), cvtpk(p0[12], p0[13]), cvtpk(p0[14], p0[15])};
            pw[2] = (u32x4){cvtpk(p1[0], p1[1]), cvtpk(p1[2], p1[3]), cvtpk(p1[4], p1[5]), cvtpk(p1[6], p1[7])};
            pw[3] = (u32x4){cvtpk(p1[8], p1[9]), cvtpk(p1[10], p1[11]), cvtpk(p1[12], p1[13]), cvtpk(p1[14], p1[15])};
            __builtin_amdgcn_sched_barrier(0);
            { const lds_cptr vp = vp0 + slot + 4096;
              s16x4 vl1[4], vh1[4];
#pragma unroll
              for (int ks = 0; ks < 4; ++ks) { vl1[ks] = vtr(vp + ks * 1024); vh1[ks] = vtr(vp + ks * 1024 + 512); }
#pragma unroll
              for (int ks = 0; ks < 4; ++ks) { const bf16x8 vf = (bf16x8){vl0[ks][0], vl0[ks][1], vl0[ks][2], vl0[ks][3], vh0[ks][0], vh0[ks][1], vh0[ks][2], vh0[ks][3]};
                  o0[g] = __builtin_amdgcn_mfma_f32_32x32x16_bf16(vf, __builtin_bit_cast(bf16x8, pw[ks]), o0[g], 0, 0, 0); }
#pragma unroll
              for (int ks = 0; ks < 4; ++ks) { const bf16x8 vf = (bf16x8){vl1[ks][0], vl1[ks][1], vl1[ks][2], vl1[ks][3], vh1[ks][0], vh1[ks][1], vh1[ks][2], vh1[ks][3]};
                  o1[g] = __builtin_amdgcn_mfma_f32_32x32x16_bf16(vf, __builtin_bit_cast(bf16x8, pw[ks]), o1[g], 0, 0, 0); } }
#pragma unroll
            for (int i = 0; i < 4; ++i) { __builtin_amdgcn_sched_group_barrier(0x100, 2, 0); __builtin_amdgcn_sched_group_barrier(0x008, 1, 0); }
            __builtin_amdgcn_sched_group_barrier(0x008, 4, 0);
            __builtin_amdgcn_sched_barrier(0);
          }
          __builtin_amdgcn_sched_barrier(0);
        }
        const int ahead = NT - 2 - t;
        if (MODE == 1) { if (ahead >= 2) WAITBAR(6); else if (ahead == 1) WAITBAR(3); else WAITBAR(0); }
        else           { if (ahead >= 2) WAITBAR(4); else if (ahead == 1) WAITBAR(2); else WAITBAR(0); }
    }
    __builtin_amdgcn_s_setprio(0);
#pragma unroll
    for (int g = 0; g < 2; ++g) {
        const int head = (MODE == 0) ? hsel : 2 * hsel + g;
        const float inv = 1.f / swap_add(l_run[g]);
        const bf16_t* grow = P + p_off(rowbase + qpos[g], C_GA + ((MODE == 0) ? 0 : 384) + 64 * head);
        const int yr_ = rowbase + qpos[g], yc_ = ((MODE == 0) ? 0 : 512) + 64 * head;
#pragma unroll
        for (int d0 = 0; d0 < 2; ++d0)
#pragma unroll
            for (int g4 = 0; g4 < 4; ++g4) {
                const int dim = 32 * d0 + 8 * g4 + 4 * hi;
                const s16x4 gt = *(const s16x4*)(grow + p_col(dim));
                float v[4];
#pragma unroll
                for (int e = 0; e < 4; ++e) v[e] = (d0 == 0 ? o0[g][4 * g4 + e] : o1[g][4 * g4 + e]) * inv * bf2f(gt[e]);
                *(unsigned*)((unsigned char*)Y + g_off(yr_, yc_ + dim, YP)) = pk4_fp8(v[0] * F8_SY, v[1] * F8_SY, v[2] * F8_SY, v[3] * F8_SY);
            }
        if (head == 5) {
#pragma unroll
            for (int j = 0; j < 4; ++j) *(u32x4*)((unsigned char*)Y + g_off(yr_, yc_ + 64 + 64 * hi + 16 * j, YP)) = (u32x4){0u, 0u, 0u, 0u};
        }
    }
#undef T2_ROW0
#undef ISSUE2
}

__device__ __forceinline__ unsigned f2key(float f) { unsigned u = __float_as_uint(f); if (u == 0x80000000u) u = 0u; return (u & 0x80000000u) ? ~u : (u | 0x80000000u); }
__device__ __forceinline__ float key2f(unsigned k) { const unsigned u = (k & 0x80000000u) ? (k & 0x7fffffffu) : ~k; return __uint_as_float(u); }
__device__ __forceinline__ unsigned wave_sum_dpp(unsigned x) {
    x += (unsigned)__builtin_amdgcn_update_dpp(0, (int)x, 0xB1, 0xf, 0xf, false);
    x += (unsigned)__builtin_amdgcn_update_dpp(0, (int)x, 0x4E, 0xf, 0xf, false);
    x += (unsigned)__builtin_amdgcn_update_dpp(0, (int)x, 0x141, 0xf, 0xf, false);
    x += (unsigned)__builtin_amdgcn_update_dpp(0, (int)x, 0x140, 0xf, 0xf, false);
    x += (unsigned)__builtin_amdgcn_update_dpp(0, (int)x, 0x142, 0xa, 0xf, false);
    x += (unsigned)__builtin_amdgcn_update_dpp(0, (int)x, 0x143, 0xc, 0xf, false);
    return (unsigned)__builtin_amdgcn_readlane((int)x, 63);
}
__device__ __forceinline__ void cnt4(unsigned& na, unsigned& nb, unsigned ka0, unsigned ka1, unsigned kb0, unsigned kb1, unsigned ca, unsigned cb) {
    u64 t1, t2, t3;
    asm("v_cmp_ge_u32_e64 vcc, %[ka0], %[ca]\n\t"
        "v_cmp_ge_u32_e64 %[t1], %[kb0], %[cb]\n\t"
        "v_cmp_ge_u32_e64 %[t2], %[ka1], %[ca]\n\t"
        "v_cmp_ge_u32_e64 %[t3], %[kb1], %[cb]\n\t"
        "v_addc_co_u32_e64 %[na], vcc, 0, %[na], vcc\n\t"
        "v_addc_co_u32_e64 %[nb], %[t1], 0, %[nb], %[t1]\n\t"
        "v_addc_co_u32_e64 %[na], %[t2], 0, %[na], %[t2]\n\t"
        "v_addc_co_u32_e64 %[nb], %[t3], 0, %[nb], %[t3]"
        : [na] "+v"(na), [nb] "+v"(nb), [t1] "=&s"(t1), [t2] "=&s"(t2), [t3] "=&s"(t3)
        : [ka0] "v"(ka0), [ka1] "v"(ka1), [kb0] "v"(kb0), [kb1] "v"(kb1), [ca] "v"(ca), [cb] "v"(cb)
        : "vcc");
}
template <int NREG> __device__ __forceinline__ int count_ge(const unsigned (&key)[32], unsigned cand) {
    unsigned cnt = 0u;
#pragma unroll
    for (int i = 0; i < NREG; ++i) cnt += (key[i] >= cand) ? 1u : 0u;
    int tot = 0;
#pragma unroll
    for (int b = 0; b < 6; ++b) tot += __popcll(__ballot((cnt >> b) & 1u)) << b;
    return tot;
}
template <int NREG> __device__ __forceinline__ void select_unit(LAS unsigned char* lds, const bf16_t* __restrict__ P, const float* __restrict__ IW, u64* __restrict__ bits, int rowbase, int q16, int wave) {
    wave = opaque_wave(wave);
    const int tid = opaque_tid(wave), lane = tid & 63; const int wid = wave;
    const int t0 = 16 * q16, ngroups = q16 + 1;
    const int qi = lane & 15, kq = lane >> 4;
    LAS float* sc = (LAS float*)lds;
    const bool triv = (NREG == 8) && (t0 + 16 <= 256);
    if (!triv) {
        bf16x8 bq[4][2]; float w[4];
        const bf16_t* qp = P + p_off(rowbase + t0 + qi, C_IQ + 8 * kq);
#pragma unroll
        for (int h = 0; h < 4; ++h) { bq[h][0] = *(const bf16x8*)(qp + p_col(64 * h)); bq[h][1] = *(const bf16x8*)(qp + p_col(64 * h + 32)); }
        { const f32x4 wv = *(const f32x4*)(IW + (size_t)(rowbase + t0 + qi) * 4); w[0] = wv[0]; w[1] = wv[1]; w[2] = wv[2]; w[3] = wv[3]; }
        const bf16_t* kbase = (const bf16_t*)((const char*)P - (WS_P - WS_IKC)) + (size_t)(rowbase + qi) * 32 + 8 * kq;
        constexpr int NG = NREG / 2;
        bf16x8 a[NG][2];
#pragma unroll
        for (int u = 0; u < NG; ++u) { int g = wid + 8 * u; g = g < ngroups ? g : ngroups - 1; const bf16_t* kp = kbase + (size_t)(16 * g) * 32; a[u][0] = *(const bf16x8*)kp; a[u][1] = *(const bf16x8*)(kp + (size_t)MC * 32); }
#pragma unroll
        for (int u = 0; u < NG; ++u) {
            const int g = wid + 8 * u;
            f32x4 s = {0.f, 0.f, 0.f, 0.f};
            f32x4 d[4];
#pragma unroll
            for (int h = 0; h < 4; ++h) {
                d[h] = (f32x4){0.f, 0.f, 0.f, 0.f};
                d[h] = __builtin_amdgcn_mfma_f32_16x16x32_bf16(a[u][0], bq[h][0], d[h], 0, 0, 0);
                d[h] = __builtin_amdgcn_mfma_f32_16x16x32_bf16(a[u][1], bq[h][1], d[h], 0, 0, 0);
            }
            asm volatile("s_nop 11" : "+v"(d[0]), "+v"(d[1]), "+v"(d[2]), "+v"(d[3]));
#pragma unroll
            for (int h = 0; h < 4; ++h)
#pragma unroll
                for (int e = 0; e < 4; ++e) { float r_; asm("v_max_f32_e32 %0, 0, %1" : "=v"(r_) : "v"(d[h][e])); float se = s[e]; asm("v_fmac_f32_e32 %0, %1, %2" : "+v"(se) : "v"(r_), "v"(w[h])); s[e] = se; }
            if (g < ngroups) *(LAS f32x4*)(sc + qi * SCORE_PITCH + 16 * g + 4 * kq) = s;
        }
    }
    __syncthreads();
    {
        const int qA = 2 * wid, tA = t0 + qA, tB = tA + 1;
        unsigned kA[32], kB[32];
#pragma unroll
        for (int i = 0; i < NREG; ++i) {
            const int idx = lane + 64 * i;
            const float va = sc[qA * SCORE_PITCH + idx], vb = sc[(qA + 1) * SCORE_PITCH + idx];
            const unsigned ka = triv ? 2u : f2key(va), kb = triv ? 2u : f2key(vb);
            kA[i] = (idx <= tA) ? ka : 0u; kB[i] = (idx <= tB) ? kb : 0u;
        }
        unsigned TA = 1u, TB = 1u; bool dA = (tA + 1 <= 256), dB = (tB + 1 <= 256);
        if (!dB) {
            TA = dA ? 1u : 0u; TB = 0u;
            for (int bit = 31; bit >= 0; --bit) {
                if (dA && dB) break;
                const unsigned cA = TA | (1u << bit), cB = TB | (1u << bit);
                unsigned ca = 0u, cb = 0u;
#pragma unroll
                for (int i = 0; i < NREG; i += 2) cnt4(ca, cb, kA[i], kA[i + 1], kB[i], kB[i + 1], cA, cB);
                const unsigned tot = wave_sum_dpp(ca | (cb << 16));
                const int nA = (int)(tot & 0xffffu), nB = (int)(tot >> 16);
                if (!dA) { if (nA >= 256) TA = cA; if (nA == 256) dA = true; }
                if (!dB) { if (nB >= 256) TB = cB; if (nB == 256) dB = true; }
            }
        }
        const u64 lt_mask = (lane == 0) ? 0ull : (~0ull >> (64 - lane));
#pragma unroll 1
        for (int rr = 0; rr < 2; ++rr) {
            const unsigned T = rr ? TB : TA; const int t = tA + rr;
            unsigned cge = 0u;
#pragma unroll
            for (int i = 0; i < NREG; ++i) { const unsigned kk_ = rr ? kB[i] : kA[i]; cge += (kk_ > T) ? 1u : 0u; cge += (kk_ == T) ? 0x10000u : 0u; }
            const unsigned tote = wave_sum_dpp(cge);
            const int cgt = (int)(tote & 0xffffu), ceq = (int)(tote >> 16);
            const int need = 256 - cgt;
            unsigned mine_lo = 0u, mine_hi = 0u;
            if (need <= 0 || need >= ceq) {
                const unsigned Tc = (need <= 0) ? T + 1u : T;
#define SEL_FAST(i) do { if ((i) < NREG) { const unsigned kk_ = rr ? kB[i] : kA[i]; const u64 wsel = __ballot(kk_ >= Tc); \
            const unsigned wl_ = (unsigned)wsel, wh_ = (unsigned)(wsel >> 32); \
            asm volatile("s_nop 1\n\tv_writelane_b32 %0, %2, " #i "\n\tv_writelane_b32 %1, %3, " #i : "+v"(mine_lo), "+v"(mine_hi) : "s"(wl_), "s"(wh_)); if (((i) & 3) == 3) __builtin_amdgcn_sched_barrier(0); } } while (0)
                SEL_FAST(0); SEL_FAST(1); SEL_FAST(2); SEL_FAST(3); SEL_FAST(4); SEL_FAST(5); SEL_FAST(6); SEL_FAST(7);
                SEL_FAST(8); SEL_FAST(9); SEL_FAST(10); SEL_FAST(11); SEL_FAST(12); SEL_FAST(13); SEL_FAST(14); SEL_FAST(15);
                SEL_FAST(16); SEL_FAST(17); SEL_FAST(18); SEL_FAST(19); SEL_FAST(20); SEL_FAST(21); SEL_FAST(22); SEL_FAST(23);
                SEL_FAST(24); SEL_FAST(25); SEL_FAST(26); SEL_FAST(27); SEL_FAST(28); SEL_FAST(29); SEL_FAST(30); SEL_FAST(31);
#undef SEL_FAST
            } else {
                int run = 0;
#define SEL_EMIT(i) do { if ((i) < NREG) { const unsigned kk_ = rr ? kB[i] : kA[i]; const bool eq = (kk_ == T) && (kk_ != 0u); const u64 beq = __ballot(eq); const int rank = run + __popcll(beq & lt_mask); \
            const bool s_ = (kk_ > T) || (eq && rank < need); const u64 wsel = __ballot(s_); run += __popcll(beq); \
            const unsigned wl_ = (unsigned)wsel, wh_ = (unsigned)(wsel >> 32); \
            asm volatile("s_nop 1\n\tv_writelane_b32 %0, %2, " #i "\n\tv_writelane_b32 %1, %3, " #i : "+v"(mine_lo), "+v"(mine_hi) : "s"(wl_), "s"(wh_)); if (((i) & 3) == 3) __builtin_amdgcn_sched_barrier(0); } } while (0)
                SEL_EMIT(0); SEL_EMIT(1); SEL_EMIT(2); SEL_EMIT(3); SEL_EMIT(4); SEL_EMIT(5); SEL_EMIT(6); SEL_EMIT(7);
                SEL_EMIT(8); SEL_EMIT(9); SEL_EMIT(10); SEL_EMIT(11); SEL_EMIT(12); SEL_EMIT(13); SEL_EMIT(14); SEL_EMIT(15);
                SEL_EMIT(16); SEL_EMIT(17); SEL_EMIT(18); SEL_EMIT(19); SEL_EMIT(20); SEL_EMIT(21); SEL_EMIT(22); SEL_EMIT(23);
                SEL_EMIT(24); SEL_EMIT(25); SEL_EMIT(26); SEL_EMIT(27); SEL_EMIT(28); SEL_EMIT(29); SEL_EMIT(30); SEL_EMIT(31);
#undef SEL_EMIT
            }
            if (lane < 32) bits[((size_t)((rowbase + t) >> 5) * 32 + lane) * 32 + ((rowbase + t) & 31)] = ((u64)mine_hi << 32) | (u64)mine_lo;
        }
    }
    __syncthreads();
}
}

struct Args { const float* x; const float* norm_g; const float* w_in; const float* w_br_a; const float* w_br_b; const float* w_br_c; const float* w_out; const float* final_g;
              float* out; unsigned char* ws; int ph_lo, ph_hi; };

constexpr int WI_IN = (DM / 64) * (C_F8 / 32), WI_IN8 = (DM / 64) * ((NW - C_F8) / 32), WI_BA = (384 / 64) * (DM / 32), WI_BC = (256 / 64) * (DM / 32), WI_O = (DM / 64) * (DM / 32);
constexpr int WPER_L = WI_IN + WI_IN8 + 2 * WI_BA + WI_BC + WI_O;
__device__ __forceinline__ void weight_item(const Args& args, bf16_t* WIN, bf16_t* WBR, bf16_t* WOUT, int l, int r, LAS float* scr, int lane_) {
    if (r < WI_IN) { transpose_item<true>(args.w_in + (size_t)l * DM * INW, INW, C_F8 / 32, WIN + (size_t)l * NW * DM, DM, 0, scr, r, lane_); return; } r -= WI_IN;
    if (r < WI_IN8) { transpose_item<true, true>(args.w_in + (size_t)l * DM * INW, INW, (NW - C_F8) / 32, WIN + (size_t)l * NW * DM + (size_t)C_F8 * DM, DM, 0, scr, r, lane_, C_F8, C_F8); return; } r -= WI_IN8;
    if (r < WI_BA) { transpose_item<false, true>(args.w_br_a + (size_t)l * 384 * DM, DM, DM / 32, WBR + (size_t)l * DM * DM, YP, 0, scr, r, lane_); return; } r -= WI_BA;
    if (r < WI_BA) { transpose_item<false, true>(args.w_br_b + (size_t)l * 384 * DM, DM, DM / 32, WBR + (size_t)l * DM * DM, YP, 512, scr, r, lane_); return; } r -= WI_BA;
    if (r < WI_BC) { transpose_item<false, true>(args.w_br_c + (size_t)l * 256 * DM, DM, DM / 32, WBR + (size_t)l * DM * DM, YP, 1024, scr, r, lane_); return; } r -= WI_BC;
    transpose_item<false, true>(args.w_out + (size_t)l * DM * DM, DM, DM / 32, WOUT + (size_t)l * DM * DM, DM, 0, scr, r, lane_);
}

__device__ __forceinline__ bool attn_work(int idx, int& mode, int& level, int& sub) {
    int r = idx;
#define AW(m_, l_) do { const int cnt = ((m_) == 2) ? 32 : ((m_) == 1) ? 24 : 48; if (r < cnt) { mode = (m_); level = (l_); sub = r; return true; } r -= cnt; } while (0)
    AW(1, 7); AW(0, 3); AW(1, 6); AW(1, 5); AW(0, 2); AW(1, 4); AW(1, 3); AW(0, 1); AW(1, 2); AW(1, 1); AW(0, 0); AW(1, 0);
    AW(2, 7); AW(2, 6); AW(2, 5); AW(2, 4); AW(2, 3); AW(2, 2); AW(2, 1); AW(2, 0);
#undef AW
    return false;
}

__global__ void __launch_bounds__(NWAVES * 64, 2) mega_fwd(Args args) {
    extern __shared__ __attribute__((aligned(16))) unsigned char lds_raw[];
    Frame F;
    F.lds = (LAS unsigned char*)lds_raw;
    F.MISC = (volatile LAS unsigned*)(F.lds + MISC_OFF);
    F.tid = threadIdx.x; F.lane = F.tid & 63; F.wave = __builtin_amdgcn_readfirstlane(F.tid >> 6);
    F.G = gridDim.x;
    unsigned char* ws = args.ws;
    F.ctl = (gu32*)(ws + WS_CTL);
    for (int u = F.tid; u < (LDS_BYTES - LDSCTL_OFF) / 4; u += NWAVES * 64) ((LAS unsigned*)(F.lds + LDSCTL_OFF))[u] = 0u;
    __syncthreads();
    XcdBarrier bar; bar.bar = (unsigned*)(F.ctl + CW_BAR); bar.x = 0; bar.st = nullptr;
    if (MK_N_LAUNCHES == 1) bar = xcd_barrier_post((unsigned*)(F.ctl + CW_BAR), F.MISC + 8);
#define GRID_BAR() do { if (MK_N_LAUNCHES == 1) xcd_barrier<false>(bar, F.wave); } while (0)
#define GRID_BAR_FIRST() do { if (MK_N_LAUNCHES == 1) xcd_barrier<true>(bar, F.wave); } while (0)
    const int lo = args.ph_lo, hi = args.ph_hi;
#define IN(k) (lo <= (k) && (k) < hi)
#define BOTH(k) (IN(k) && IN((k) + 1))

#define WSPTRS() unsigned char* wsl = launder(args.ws); float* cosT = (float*)(wsl + WS_ROPE); float* sinT = cosT + SEQ * 32; float* IWb = (float*)(wsl + WS_IW); unsigned char* H8b = wsl + WS_H8; \
    bf16_t* WIN = (bf16_t*)(wsl + WS_WIN); bf16_t* WBR = (bf16_t*)(wsl + WS_WBR); bf16_t* WOUT = (bf16_t*)(wsl + WS_WOUT); u64* BITS = (u64*)(wsl + WS_BITS); \
    bf16_t* Hb = (bf16_t*)(wsl + WS_H); bf16_t* Hb1 = (bf16_t*)(wsl + WS_H1); float* POb = (float*)(wsl + WS_PO); float* PMLb = (float*)(wsl + WS_PML); bf16_t* Yb = (bf16_t*)(wsl + WS_Y); bf16_t* MGb = (bf16_t*)(wsl + WS_MERGED); bf16_t* Pb = (bf16_t*)(wsl + WS_P); unsigned char* MG8b = wsl + WS_MG8; \
    gu32* ctl = (gu32*)(wsl + WS_CTL); \
    (void)cosT; (void)sinT; (void)IWb; (void)H8b; (void)WIN; (void)WBR; (void)WOUT; (void)BITS; (void)Hb; (void)Hb1; (void)POb; (void)PMLb; (void)Yb; (void)MGb; (void)Pb; (void)MG8b; (void)ctl
    const int NGW = F.G * NWAVES;
#define PHASE_IDS() const int wave_ = opaque_wave(F.wave); const int tid_ = opaque_tid(wave_); const int lane_ = tid_ & 63; const int gw = blockIdx.x * NWAVES + wave_; (void)lane_; (void)gw

    if (EN(0)) {
        WSPTRS(); PHASE_IDS();
        LAS float* scr = (LAS float*)(F.lds + wave_ * 16384);
        for (int it = gw; it < WPER_L; it += NGW) weight_item(args, WIN, WBR, WOUT, 0, it, scr, lane_);
        for (int e = blockIdx.x * (NWAVES * 64) + tid_; e < DEPTH * DM * 16; e += F.G * NWAVES * 64) {
            const int l = e / (DM * 16), n = (e / 16) % DM, j = e % 16;
            *(u32x4*)((unsigned char*)(WBR + (size_t)l * DM * DM) + (size_t)n * YP + (j < 8 ? 384 : 896 - 128) + 16 * j) = (u32x4){0u, 0u, 0u, 0u};
        }
        for (int e = blockIdx.x * (NWAVES * 64) + tid_; e < SEQ * 32; e += F.G * NWAVES * 64) {
            const int t = e >> 5, f = e & 31;
            const float inv_freq = 1.0f / powf(10000.0f, (float)(2 * f) / 64.0f);
            const float ang = (float)t * inv_freq;
            const double rev = (double)ang * 0.15915494309189535;
            const float fr = (float)(rev - __builtin_rint(rev));
            cosT[e] = __builtin_amdgcn_cosf(fr); sinT[e] = __builtin_amdgcn_sinf(fr);
        }
        for (int m = 4 * gw; m < BATCH * SEQ; m += 4 * NGW) rms_rows<true, 4>(args.x + (size_t)m * DM, args.norm_g, (m < MC ? Hb + (size_t)m * DM : Hb1 + (size_t)(m - MC) * DM), H8b + (size_t)m * DM, IWb + (size_t)m * 4, args.w_in + 2752, lane_);
    }
    GRID_BAR_FIRST();

#pragma nounroll
    for (int lcx = -1; lcx < DEPTH * NCH; ++lcx) {
        if (lcx >= 0) {
            const int lc = lcx;
            const int l = lc / NCH, c = lc % NCH;
            const float* xin = ((l == 0) ? args.x : (const float*)args.out) + (size_t)c * MC * DM;
            float* xout = args.out + (size_t)c * MC * DM;
            if (EN(3)) for (int rep = 0; rep < NREP(3); ++rep) {
                WSPTRS();
                gu32* qc = ctl + CW_Q + 64 * (((l * NCH + c) * 2 + 0) * 4 + rep);
                for (int nq = 0;; ++nq) {
                    __syncthreads();
                    if (opaque_tid(F.wave) == 0) F.MISC[0] = (nq == 0) ? (unsigned)blockIdx.x : (unsigned)F.G + __hip_atomic_fetch_add(qc, 1u, RLX_AGENT);
                    __syncthreads();
                    const int idx = (int)F.MISC[0];
                    constexpr int NSEL = BPC * 128, NG2 = 2 * BPC * 4 * 8;
                    if (idx >= NSEL + NG2 + ((rep == 0) ? (lc > 0 ? MC / 64 : WPER_L / 8) : 0)) break;
                    if (idx >= NSEL && idx < NSEL + NG2) { const int j = idx - NSEL;
                        if (j < NG2 / 2) att::attn_unit<4>(F.lds, Pb, Yb, BITS, POb, PMLb, ((j >> 5) & 7) * SEQ, (j >> 3) & 3, 7 - (j & 7), F.wave);
                        else att::attn_unit<3>(F.lds, Pb, Yb, BITS, POb, PMLb, ((j >> 5) & 7) * SEQ, (j >> 3) & 3, j & 7, F.wave);
                        continue; }
                    if (idx >= NSEL + NG2) {
                        PHASE_IDS();
                        if (lc == 0) {
                            static_assert(WPER_L % 8 == 0, "weight items per layer");
                            weight_item(args, WIN, WBR, WOUT, 1, (idx - NSEL - NG2) * 8 + wave_, (LAS float*)(F.lds + wave_ * 16384), lane_);
                            continue;
                        }
                        const int r0 = (idx - NSEL - NG2) * 64 + wave_ * 8;
                        if (lc == 3) { for (int j = 0; j < 8; j += 4) rms_rows<false, 4>(args.out + (size_t)(r0 + j) * DM, args.final_g, args.out + (size_t)(r0 + j) * DM, nullptr, nullptr, nullptr, lane_); }
                        else { const float* src = args.out + (size_t)(lc - 1) * MC * DM; bf16_t* dst = (lc == 1) ? Hb : Hb1;
                            for (int j = 0; j < 8; j += 4) rms_rows<true, 4>(src + (size_t)(r0 + j) * DM, args.norm_g + DM, dst + (size_t)(r0 + j) * DM, H8b + ((size_t)(lc - 1) * MC + r0 + j) * DM, IWb + ((size_t)(lc - 1) * MC + r0 + j) * 4, args.w_in + (size_t)DM * INW + 2752, lane_); }
                        continue;
                    }
                    const int q16 = 127 - (idx >> 3), b = idx & 7;
                    if (q16 < 32) att::select_unit<8>(F.lds, Pb, IWb + (size_t)c * MC * 4, BITS, b * SEQ, q16, F.wave);
                    else if (q16 < 48) att::select_unit<12>(F.lds, Pb, IWb + (size_t)c * MC * 4, BITS, b * SEQ, q16, F.wave);
                    else if (q16 < 64) att::select_unit<16>(F.lds, Pb, IWb + (size_t)c * MC * 4, BITS, b * SEQ, q16, F.wave);
                    else if (q16 < 80) att::select_unit<20>(F.lds, Pb, IWb + (size_t)c * MC * 4, BITS, b * SEQ, q16, F.wave);
                    else if (q16 < 96) att::select_unit<24>(F.lds, Pb, IWb + (size_t)c * MC * 4, BITS, b * SEQ, q16, F.wave);
                    else if (q16 < 112) att::select_unit<28>(F.lds, Pb, IWb + (size_t)c * MC * 4, BITS, b * SEQ, q16, F.wave);
                    else att::select_unit<32>(F.lds, Pb, IWb + (size_t)c * MC * 4, BITS, b * SEQ, q16, F.wave);
                }
                GRID_BAR();
            }
            if (EN(4)) for (int rep = 0; rep < NREP(4); ++rep) {
                WSPTRS();
                gu32* qc = ctl + CW_Q + 64 * (((l * NCH + c) * 2 + 1) * 4 + rep);
                {
                    pg8::Gemm g{(const bf16_t*)(H8b + (size_t)c * MC * DM), WIN + (size_t)l * NW * DM + (size_t)C_F8 * DM}; pg8::TailOrder S; S.init(DM, F.G, (int)blockIdx.x); S.nt = DM / 128;
                    pg8::EpiProj E{Pb, MG8b, cosT, sinT, C_F8, 1.f / (F8_SA * F8_SB)};
                    pg8::gemm_phase<pg8::EpiProj, pg8::TailOrder, true>(F.lds, g, S, E, F.wave);
                }
                for (int nq = 0;; ++nq) {
                    __syncthreads();
                    if (opaque_tid(F.wave) == 0) F.MISC[0] = (nq == 0) ? (unsigned)((blockIdx.x + F.G - 64) % F.G) : (unsigned)F.G + __hip_atomic_fetch_add(qc, 1u, RLX_AGENT);
                    __syncthreads();
                    const int idx = (int)F.MISC[0];
                    int mode, level, sub;
                    if (!attn_work(idx, mode, level, sub)) break;
                    if (mode == 0) att::attn_unit2<0>(F.lds, Pb, Yb, BITS, (sub / 6) * SEQ, sub % 6, level, F.wave);
                    else if (mode == 1) att::attn_unit2<1>(F.lds, Pb, Yb, BITS, (sub / 3) * SEQ, sub % 3, level, F.wave);
                    else att::attn_unit<2>(F.lds, Pb, Yb, BITS, POb, PMLb, (sub >> 2) * SEQ, sub & 3, level, F.wave);
                }
                GRID_BAR();
            }
            if (EN(5)) for (int rep = 0; rep < NREP(5); ++rep) {
                WSPTRS();
                pg8::Gemm g{Yb, WBR + (size_t)l * DM * DM}; pg8::BranchOrder S; S.so.init(MC, DM, DM, F.G, (int)blockIdx.x);
                pg8::EpiMerge E{MG8b, MGb, 1.f / (F8_SY * F8_SB)};
                pg8::gemm_phase<pg8::EpiMerge, pg8::BranchOrder, true, YP, true>(F.lds, g, S, E, F.wave);
                GRID_BAR();
            }
            if (EN(6)) {
                WSPTRS();
                pg8::Gemm g{MGb, WOUT + (size_t)l * DM * DM}; pg8::StaticOrder S; S.init(MC, DM, DM, F.G, (int)blockIdx.x); S.nt = DM / 128;
                pg8::EpiResid E{xin, xout, 1.f / (F8_SM * F8_SB)};
                pg8::gemm_phase<pg8::EpiResid, pg8::StaticOrder, true, pg8::LD, true>(F.lds, g, S, E, F.wave);
            }
        }
        if (lcx + 1 < DEPTH * NCH) {
            const int lc = lcx + 1;
            const int l = lc / NCH, c = lc % NCH;
            if (EN(2)) for (int rep = 0; rep < NREP(2); ++rep) {
                WSPTRS();
                {
                    pg8::Gemm g{c ? Hb1 : Hb, WIN + (size_t)l * NW * DM}; pg8::StaticOrder S; S.init(MC, C_F8, DM, F.G, (int)blockIdx.x);
                    pg8::EpiProj E{Pb, MG8b, cosT, sinT, 0, 1.f};
                    pg8::gemm_phase<pg8::EpiProj, pg8::StaticOrder, false>(F.lds, g, S, E, F.wave);
                }
                {
                    pg8::Gemm g{(const bf16_t*)(H8b + (size_t)c * MC * DM), WIN + (size_t)l * NW * DM + (size_t)C_F8 * DM}; pg8::StaticOrder S; S.init(MC, NW_MAIN - C_F8, DM, F.G, (int)blockIdx.x); S.nt = DM / 128;
                    pg8::EpiProj E{Pb, MG8b, cosT, sinT, C_F8, 1.f / (F8_SA * F8_SB)};
                    pg8::gemm_phase<pg8::EpiProj, pg8::StaticOrder, true>(F.lds, g, S, E, F.wave);
                }
            }
        }
        GRID_BAR();
    }
    if (EN(7)) {
        PHASE_IDS();
        for (int m = MC + 4 * gw; m < BATCH * SEQ; m += 4 * NGW) rms_rows<false, 4>(args.out + (size_t)m * DM, args.final_g, args.out + (size_t)m * DM, nullptr, nullptr, nullptr, lane_);
    }
#undef IN
#undef BOTH
#undef GRID_BAR
}

extern "C" void kernel_launch(void* const* d_in, const int* in_sizes, int n_in, void* d_out, int out_size, void* d_ws, size_t ws_size, hipStream_t stream) {
    static int grid = 0;
    if (grid == 0) {
        if (n_in != 8 || in_sizes[0] != BATCH * SEQ * DM || out_size != BATCH * SEQ * DM || ws_size < WS_END) {
            fprintf(stderr, "kernel_launch: unexpected shapes / workspace (n_in %d, in0 %d, out %d, ws %zu, need %zu); nothing launched\n", n_in, n_in > 0 ? in_sizes[0] : -1, out_size, ws_size, (size_t)WS_END);
            grid = -1; return; }
        int dev = 0, cus = 0, per_cu = 0;
        if (hipGetDevice(&dev) != hipSuccess || hipDeviceGetAttribute(&cus, hipDeviceAttributeMultiprocessorCount, dev) != hipSuccess) { grid = -1; return; }
        if (hipFuncSetAttribute((const void*)mega_fwd, hipFuncAttributeMaxDynamicSharedMemorySize, LDS_BYTES) != hipSuccess) { fprintf(stderr, "kernel_launch: hipFuncSetAttribute failed\n"); grid = -1; return; }
        if (hipOccupancyMaxActiveBlocksPerMultiprocessor(&per_cu, (const void*)mega_fwd, NWAVES * 64, LDS_BYTES) != hipSuccess || per_cu < 1)
            fprintf(stderr, "kernel_launch: note: occupancy query reports %d workgroups per CU\n", per_cu);
        (void)hipGetLastError();
        grid = cus;
    }
    if (grid < 0) return;
    if (hipMemsetAsync((char*)d_ws + WS_CTL, 0, CTL_ZERO_BYTES, stream) != hipSuccess) return;
    Args a{};
    a.x = (const float*)d_in[0]; a.norm_g = (const float*)d_in[1]; a.w_in = (const float*)d_in[2]; a.w_br_a = (const float*)d_in[3];
    a.w_br_b = (const float*)d_in[4]; a.w_br_c = (const float*)d_in[5]; a.w_out = (const float*)d_in[6]; a.final_g = (const float*)d_in[7];
    a.out = (float*)d_out; a.ws = (unsigned char*)d_ws;
    if (MK_N_LAUNCHES == 1) {
        a.ph_lo = 0; a.ph_hi = NPHASES;
        hipLaunchKernelGGL(mega_fwd, dim3(grid), dim3(NWAVES * 64), LDS_BYTES, stream, a);
    } else {
        for (int p = 0; p < NPHASES; ++p) { a.ph_lo = p; a.ph_hi = p + 1; hipLaunchKernelGGL(mega_fwd, dim3(grid), dim3(NWAVES * 64), LDS_BYTES, stream, a); }
    }
}
```

```cpp
#include <hip/hip_runtime.h>
#include <cstdio>
#include <cstdint>

#ifndef MK_N_LAUNCHES
#define MK_N_LAUNCHES 1
#endif

#ifndef EN_MASK
#define EN_MASK 0xFF
#endif
#define EN(k) (((EN_MASK) >> (k)) & 1)
#ifndef REP_KIND
#define REP_KIND -1
#endif
#ifndef REP_N
#define REP_N 2
#endif
#define NREP(k) (((k) == (REP_KIND)) ? (REP_N) : 1)
#define GAS __attribute__((address_space(1)))
#define LAS __attribute__((address_space(3)))
typedef unsigned short bf16_t;
typedef short bf16x8 __attribute__((ext_vector_type(8)));
typedef short s16x4 __attribute__((ext_vector_type(4)));
typedef float f32x4 __attribute__((ext_vector_type(4)));
typedef float f32x2 __attribute__((ext_vector_type(2)));
typedef float f32x16 __attribute__((ext_vector_type(16)));
typedef unsigned u32x4 __attribute__((ext_vector_type(4)));
typedef unsigned u32x2 __attribute__((ext_vector_type(2)));
typedef GAS unsigned gu32;
typedef unsigned long long u64;

constexpr int BATCH = 16, SEQ = 2048, DM = 1024, DEPTH = 2;
constexpr int NCH = 2, BPC = BATCH / NCH, MC = BPC * SEQ;
constexpr int INW = 8388;
constexpr int NW = 8448;
constexpr int C_AQ = 0, C_IQ = 384, C_IK = 640, C_BK = 704, C_AK = 768, C_BQ = 1152, C_CQ = 1536, C_CK = 2304, C_ROPE_END = 3072;
constexpr int C_AV = 3072, C_BV = 3456, C_CV = 3520, C_PLAIN_END = 4288;
constexpr int C_GA = 4288, C_SILU_END = 5312;
constexpr int C_MG = 5312, C_SIG_END = 8384;
constexpr int NP = 5312;
constexpr int NW_MAIN = 8192;
constexpr int C_F8 = 1024;
constexpr int PBLK = NP / 32;
__host__ __device__ constexpr size_t p_col(int col) { return (size_t)(col >> 5) * 512 + (size_t)(col & 31); }
__host__ __device__ constexpr size_t p_off(int row, int col) { return (size_t)(row >> 4) * PBLK * 512 + (size_t)(row & 15) * 32 + p_col(col); }
__host__ __device__ constexpr size_t g_off(int row, int bc, int pitchB) { return ((size_t)(row >> 4) * (size_t)(pitchB / 64) + (size_t)(bc >> 6)) * 1024 + (size_t)((row & 15) * 64 + (bc & 63)); }
constexpr int YP = 1280;
constexpr float F8_SA = 16.f, F8_SB = 256.f, F8_SM = 16.f, F8_SY = 4.f;
constexpr float RMS_EPS = 1e-6f;
constexpr float QSCALE = 0.125f * 1.4426950408889634f;

constexpr size_t MiB = 1u << 20;
constexpr size_t WS_CTL = 0, CTL_ZERO_BYTES = 128 * 1024;
constexpr size_t WS_ROPE = 1 * MiB;
constexpr size_t WS_IW = 2 * MiB;
constexpr size_t WS_WIN = 4 * MiB;
constexpr size_t WS_WBR = 38 * MiB;
constexpr size_t WS_WOUT = 42 * MiB;
constexpr size_t WS_BITS = 46 * MiB;
constexpr size_t WS_H = 50 * MiB;
constexpr size_t WS_Y = 82 * MiB;
constexpr size_t WS_MERGED = 114 * MiB;
constexpr size_t WS_P = 146 * MiB;
constexpr size_t WS_MG8 = 312 * MiB;
constexpr size_t WS_H1 = 410 * MiB;
constexpr size_t WS_PO = 442 * MiB;
constexpr size_t WS_PML = 474 * MiB;
constexpr size_t WS_H8 = 476 * MiB;
constexpr size_t WS_IKC = 102 * MiB;
constexpr size_t WS_END = 508 * MiB;
static_assert(WS_P + (size_t)MC * NP * 2 <= WS_MG8 && WS_MG8 + (size_t)MC * 3072 <= WS_H1, "ws map");
static_assert(WS_Y + (size_t)MC * YP <= WS_IKC && WS_IKC + (size_t)2 * MC * 64 <= WS_MERGED, "ws map (compact indexer keys)");
static_assert(WS_WIN + (size_t)2 * NW * 1024 * 2 <= WS_WBR, "ws map");

constexpr int CW_TMO = 0;
constexpr int CW_BAR = 4096;
constexpr int CW_Q = 16384;

constexpr int RING_BYTES = 131072;
constexpr int SCORE_PITCH = 2052;
constexpr int LDSCTL_OFF = 135168, MISC_OFF = LDSCTL_OFF + 320;
constexpr int LDS_BYTES = 147456;
static_assert(16 * SCORE_PITCH * 4 <= LDSCTL_OFF, "lds map");

constexpr int NWAVES = 8;
constexpr int NPHASES = 2 + DEPTH * NCH * 5;

#define LDS_WAIT() asm volatile("s_waitcnt lgkmcnt(0)" ::: "memory")
#define VM_WAIT() asm volatile("s_waitcnt vmcnt(0)" ::: "memory")
#define RLX_AGENT __ATOMIC_RELAXED, __HIP_MEMORY_SCOPE_AGENT

__device__ __forceinline__ unsigned f2bf(float f) { unsigned u = __builtin_bit_cast(unsigned, f); return (u + 0x7fffu + ((u >> 16) & 1u)) >> 16; }
__device__ __forceinline__ unsigned pk2(float lo, float hi) { return f2bf(lo) | (f2bf(hi) << 16); }
__device__ __forceinline__ unsigned pk4_fp8(float a, float b, float c, float d) { int w = 0; w = __builtin_amdgcn_cvt_pk_fp8_f32(a, b, w, false); w = __builtin_amdgcn_cvt_pk_fp8_f32(c, d, w, true); return (unsigned)w; }
__device__ __forceinline__ float bf2f(short s) { return __builtin_bit_cast(float, ((unsigned)(unsigned short)s) << 16); }
typedef __bf16 bf16x2_t __attribute__((ext_vector_type(2)));
__device__ __forceinline__ unsigned cvtpk(float lo, float hi) { f32x2 v = {lo, hi}; bf16x2_t b = __builtin_convertvector(v, bf16x2_t); return __builtin_bit_cast(unsigned, b); }

__device__ __forceinline__ int opaque_wave(int wave) { asm volatile("" : "+s"(wave)); return wave; }
__device__ __forceinline__ int opaque_lane() { int l; asm volatile("v_mbcnt_lo_u32_b32 %0, -1, 0\n\tv_mbcnt_hi_u32_b32 %0, -1, %0" : "=v"(l)); return l; }
__device__ __forceinline__ int opaque_tid(int wave) { int l; asm volatile("v_mbcnt_lo_u32_b32 %0, -1, 0\n\tv_mbcnt_hi_u32_b32 %0, -1, %0" : "=v"(l)); return (wave << 6) | l; }
namespace pg8 {
constexpr int BM = 256, BK = 64, HALF = 128, HTB = HALF * BK * 2, STAGE_BYTES = 8 * HTB, NXCD = 8, WGM = 8;
__host__ __device__ __forceinline__ int lds_byte(int r, int c) { const int st = (r >> 4) * 2 + (c >> 5), rr = r & 15, cc = c & 31, ob = rr * 64 + cc * 2; return st * 1024 + (ob ^ (((ob >> 9) & 1) << 5)); }
__host__ __device__ __forceinline__ void stage_rc(int b, int& R, int& C) { const int st = b / 1024, sb = b % 1024, swz = sb ^ (((sb >> 9) & 1) << 5); R = (st >> 1) * 16 + swz / 64; C = (st & 1) * 32 + (swz % 64) / 2; }
__host__ __device__ __forceinline__ int perm32(int rho) { const int n = rho >> 4, i = rho & 15; return 8 * (i >> 2) + 4 * n + (i & 3); }

struct Unit { int pm, pn, kofs, nt, tag; };
constexpr int LD = 1024;
struct Gemm { const bf16_t* A; const bf16_t* Bt; };

struct StaticOrder {
    int nM, nN, nwg, G, c, nt;
    __device__ __forceinline__ void init(int M, int N, int K, int G_, int c_) { nM = M / BM; nN = N / BM; nwg = nM * nN; G = G_; c = c_; nt = K / BK; }
    __device__ __forceinline__ bool tile(int j, Unit& u) const {
        const long L = (long)j * G + c; if (L >= nwg) return false;
        int wgid = (int)L; { const int q = nwg / NXCD, r = nwg % NXCD, xcd = wgid % NXCD, off = wgid / NXCD; wgid = (xcd < r ? xcd * (q + 1) : r * (q + 1) + (xcd - r) * q) + off; }
        const int nig = WGM * nN, gid = wgid / nig, fm = gid * WGM, gsz = (nM - fm) < WGM ? (nM - fm) : WGM;
        u.pm = fm + ((wgid % nig) % gsz); u.pn = (wgid % nig) / gsz; return true;
    }
    __device__ __forceinline__ bool next(int i, Unit& u) const { if (!tile(i, u)) return false; u.kofs = 0; u.nt = nt; u.tag = 0; return true; }
};
struct TailOrder {
    int first, step, nt;
    __device__ __forceinline__ void init(int K, int G, int b) { const int stride = (G >= 64 && G % 64 == 0) ? G / 64 : 1; first = (b % stride == 0) ? b / stride : 64; step = G / stride; nt = K / BK; }
    __device__ __forceinline__ bool next(int i, Unit& u) const { const int j = first + i * step; if (j >= 64) return false; u.pm = j; u.pn = (NW_MAIN - C_F8) / BM; u.kofs = 0; u.nt = nt; u.tag = 0; return true; }
};
struct BranchOrder {
    StaticOrder so;
    __device__ __forceinline__ bool next(int i, Unit& u) const {
        const int j = i / 3, br = i - 3 * j; if (!so.tile(j, u)) return false;
        u.kofs = br * 512; u.nt = (br == 2) ? 2 : 4; u.tag = br; return true;
    }
};

typedef int i32x8 __attribute__((ext_vector_type(8)));
typedef int i32x4_t __attribute__((ext_vector_type(4)));
template <class Epi, class Sched, bool F8 = false, int F8PITCH = LD, bool ABLK = false>
__device__ __forceinline__ void gemm_phase(LAS unsigned char* lds, const Gemm g, const Sched& S, const Epi& E, int wave) {
    wave = opaque_wave(wave);
    const int tid = opaque_tid(wave), wid = wave, lane = tid & 63, wr = wid >> 2, wc = wid & 3, fr = lane & 15, fq = lane >> 4;
    unsigned voffA[2], voffB[2];
#pragma unroll
    for (int i = 0; i < 2; ++i) { int R, C; stage_rc(tid * 16 + i * 8192, R, C); const int Rb = Epi::PERM ? ((R & ~31) + perm32(R & 31)) : R;
        voffA[i] = ABLK ? (unsigned)g_off(R, C * 2, F8 ? F8PITCH : LD * 2) : (unsigned)(R * (F8 ? F8PITCH / 2 : LD) + C) * 2u; voffB[i] = (unsigned)(Rb * (F8 ? F8PITCH / 2 : LD) + C) * 2u; }
    constexpr size_t kstep = (size_t)(BK * 2);
    constexpr size_t kstepA = ABLK ? 2048 : kstep, kofA = ABLK ? 16 : 1;
    constexpr size_t ESZ = F8 ? 1 : 2;
    constexpr size_t hsA = F8 ? (size_t)HALF * F8PITCH : (size_t)HALF * LD * 2, hsB = hsA;
    constexpr size_t tsA = 2 * hsA, tsB = 2 * hsB;
    const unsigned ldsw = (unsigned)wid * 1024u;
    const int aoff = lds_byte(wr * 64 + fr, fq * 8), boff = lds_byte(wc * 32 + fr, fq * 8);
#define PG8_SA(b, h) (((b) * 2 + (h)) * HTB)
#define PG8_SB(b, h) ((4 + (b) * 2 + (h)) * HTB)
#define PG8_STAGE(bufoff, gbase, voff) do { _Pragma("unroll") for (int _i = 0; _i < 2; ++_i) { unsigned vo_ = (voff)[_i]; if (F8) asm volatile("" : "+v"(vo_));     \
        __builtin_amdgcn_global_load_lds((const unsigned*)((const char*)(gbase) + vo_), (LAS unsigned*)(lds + (bufoff) + ldsw + _i * 8192), 16, 0, 0); } } while (0)
#define PG8_LDA(dst, b, h) do { _Pragma("unroll") for (int m = 0; m < 4; ++m) { if (F8) { const i32x4_t lo_ = *(const LAS i32x4_t*)(lds + PG8_SA(b, h) + aoff + m * 2048), hi_ = *(const LAS i32x4_t*)(lds + PG8_SA(b, h) + aoff + m * 2048 + 1024); \
        dst##8[m] = __builtin_shufflevector(lo_, hi_, 0, 1, 2, 3, 4, 5, 6, 7); } else { _Pragma("unroll") for (int k = 0; k < 2; ++k) dst[m][k] = *(const LAS bf16x8*)(lds + PG8_SA(b, h) + aoff + m * 2048 + k * 1024); } } } while (0)
#define PG8_LDB(dst, b, h) do { _Pragma("unroll") for (int n = 0; n < 2; ++n) { if (F8) { const i32x4_t lo_ = *(const LAS i32x4_t*)(lds + PG8_SB(b, h) + boff + n * 2048), hi_ = *(const LAS i32x4_t*)(lds + PG8_SB(b, h) + boff + n * 2048 + 1024); \
        dst##8[n] = __builtin_shufflevector(lo_, hi_, 0, 1, 2, 3, 4, 5, 6, 7); } else { _Pragma("unroll") for (int k = 0; k < 2; ++k) dst[n][k] = *(const LAS bf16x8*)(lds + PG8_SB(b, h) + boff + n * 2048 + k * 1024); } } } while (0)
#define PG8_MMA(ai, bj, At, Bt) do { __builtin_amdgcn_s_setprio(1); _Pragma("unroll") for (int m = 0; m < 4; ++m) _Pragma("unroll") for (int n = 0; n < 2; ++n) { \
        if (F8) acc[ai][bj][m][n] = __builtin_amdgcn_mfma_scale_f32_16x16x128_f8f6f4(Bt##8[n], At##8[m], acc[ai][bj][m][n], 0, 0, 0, 0x7f7f7f7f, 0, 0x7f7f7f7f); \
        else { _Pragma("unroll") for (int k = 0; k < 2; ++k) acc[ai][bj][m][n] = __builtin_amdgcn_mfma_f32_16x16x32_bf16(Bt[n][k], At[m][k], acc[ai][bj][m][n], 0, 0, 0); } } \
        __builtin_amdgcn_s_setprio(0); } while (0)
#define PG8_WAIT_V(n) asm volatile("s_waitcnt vmcnt(" #n ")" ::: "memory")
#define PG8_WAIT_L(n) asm volatile("s_waitcnt lgkmcnt(" #n ")" ::: "memory")
#define PG8_BAR __builtin_amdgcn_s_barrier()
#define PG8_SCHED __builtin_amdgcn_sched_barrier(0)
    Unit cur, nxt; int ui = 0;
    if (!S.next(0, cur)) return;
    f32x4 acc[2][2][4][2];
#pragma unroll
    for (int a = 0; a < 2; ++a)
#pragma unroll
        for (int b = 0; b < 2; ++b)
#pragma unroll
            for (int m = 0; m < 4; ++m)
#pragma unroll
                for (int n = 0; n < 2; ++n) acc[a][b][m][n] = (f32x4){0.f, 0.f, 0.f, 0.f};
    bf16x8 At[4][2], B0[2][2], B1[2][2];
    i32x8 At8[4], B08[2], B18[2];
    const char* cA = (const char*)g.A + (size_t)cur.pm * tsA + (size_t)cur.kofs * ESZ * kofA; const char* cB = (const char*)g.Bt + (size_t)cur.pn * tsB + (size_t)cur.kofs * ESZ;
    PG8_STAGE(PG8_SB(0, 0), cB, voffB); PG8_STAGE(PG8_SB(0, 1), cB + hsB, voffB); PG8_STAGE(PG8_SA(0, 0), cA, voffA); PG8_STAGE(PG8_SA(0, 1), cA + hsA, voffA);
    if (wr == 1) PG8_BAR;
    PG8_WAIT_V(2); PG8_BAR;
    PG8_STAGE(PG8_SB(1, 0), cB + kstep, voffB); PG8_STAGE(PG8_SA(1, 0), cA + kstepA, voffA); PG8_STAGE(PG8_SB(1, 1), cB + hsB + kstep, voffB);
    PG8_WAIT_V(6); PG8_BAR;
    for (;;) {
        const bool has_next = S.next(ui + 1, nxt);
        const char* nA = has_next ? (const char*)g.A + (size_t)nxt.pm * tsA + (size_t)nxt.kofs * ESZ * kofA : cA; const char* nB = has_next ? (const char*)g.Bt + (size_t)nxt.pn * tsB + (size_t)nxt.kofs * ESZ : cB;
        const int nt = cur.nt;
        for (int t = 0; t < nt; t += 2) {
            const bool last = (t == nt - 2);
            const char* a1 = cA + (size_t)(t + 1) * kstepA;
            const char* a2 = last ? nA : cA + (size_t)(t + 2) * kstepA; const char* b2 = last ? nB : cB + (size_t)(t + 2) * kstep;
            const char* a3 = a2 + kstepA; const char* b3 = b2 + kstep;
            PG8_LDB(B0, 0, 0); PG8_LDB(B1, 0, 1); PG8_SCHED; PG8_LDA(At, 0, 0); PG8_STAGE(PG8_SA(1, 1), a1 + hsA, voffA);
            PG8_WAIT_V(8); PG8_WAIT_L(0); PG8_BAR; PG8_MMA(0, 0, At, B0); PG8_MMA(0, 1, At, B1); PG8_BAR; PG8_SCHED;
            PG8_LDA(At, 0, 1); PG8_STAGE(PG8_SB(0, 0), b2, voffB); PG8_STAGE(PG8_SB(0, 1), b2 + hsB, voffB); PG8_STAGE(PG8_SA(0, 0), a2, voffA);
            PG8_WAIT_V(8); PG8_WAIT_L(0); PG8_BAR; PG8_MMA(1, 0, At, B0); PG8_MMA(1, 1, At, B1); PG8_BAR; PG8_SCHED;
            PG8_LDB(B0, 1, 0); PG8_LDB(B1, 1, 1); PG8_SCHED; PG8_LDA(At, 1, 0); PG8_STAGE(PG8_SA(0, 1), a2 + hsA, voffA);
            PG8_WAIT_V(8); PG8_WAIT_L(0); PG8_BAR; PG8_MMA(0, 0, At, B0); PG8_MMA(0, 1, At, B1); PG8_BAR; PG8_SCHED;
            PG8_LDA(At, 1, 1); PG8_STAGE(PG8_SB(1, 0), b3, voffB); PG8_STAGE(PG8_SB(1, 1), b3 + hsB, voffB); PG8_STAGE(PG8_SA(1, 0), a3, voffA);
            PG8_WAIT_V(8); PG8_WAIT_L(0); PG8_BAR; PG8_MMA(1, 0, At, B0); PG8_MMA(1, 1, At, B1); PG8_BAR; PG8_SCHED;
        }
        if (wr == 0) PG8_BAR;
        E(acc, cur, wr, wc, fr, fq);
        if (!has_next) break;
        if (!(Epi::KEEP_ACC && cur.tag < 2))
#pragma unroll
        for (int a = 0; a < 2; ++a)
#pragma unroll
            for (int b = 0; b < 2; ++b)
#pragma unroll
                for (int m = 0; m < 4; ++m)
#pragma unroll
                    for (int n = 0; n < 2; ++n) acc[a][b][m][n] = (f32x4){0.f, 0.f, 0.f, 0.f};
        cur = nxt; cA = nA; cB = nB; ++ui;
        if (wr == 1) PG8_BAR;
    }
    PG8_WAIT_V(0);
    PG8_BAR;
#undef PG8_SA
#undef PG8_SB
#undef PG8_STAGE
#undef PG8_LDA
#undef PG8_LDB
#undef PG8_MMA
#undef PG8_WAIT_V
#undef PG8_WAIT_L
#undef PG8_BAR
#undef PG8_SCHED
}

__device__ __forceinline__ float sigmoidf_(float x) { return __builtin_amdgcn_rcpf(1.f + __expf(-x)); }

__device__ __forceinline__ size_t mg8_off(int row, int col) { return ((size_t)(row >> 4) * 96 + (size_t)(col >> 5)) * 512 + (size_t)((row & 15) * 32 + (col & 31)); }
struct EpiProj {
    static constexpr bool PERM = true, KEEP_ACC = false;
    bf16_t* P; unsigned char* MG8; const float* cosT; const float* sinT; int coloff; float ascale;
    __device__ __forceinline__ void operator()(const f32x4 (&acc)[2][2][4][2], const Unit& u, int wr, int wc, int fr, int fq) const {
        { const int l_ = opaque_lane(); fr = l_ & 15; fq = l_ >> 4; }
        const int row0 = u.pm * BM + wr * 64 + fr;
#pragma unroll
        for (int bj = 0; bj < 2; ++bj) {
            const int colg = coloff + u.pn * BM + bj * HALF + wc * 32;
            const int col = colg + 8 * fq;
            const bool cik = (colg >= C_IK && colg < C_IK + 64);
            bf16_t* dbase = cik ? (bf16_t*)((char*)P - (WS_P - WS_IKC)) + (size_t)((col - C_IK) >> 5) * MC * 32 + ((col - C_IK) & 31) : P + p_col(col);
            #define DROW(row_) (cik ? (size_t)(row_) * 32 : p_off((row_), 0))
            if (colg < C_ROPE_END) {
                const int f4 = ((col & 63) >> 3) * 4;
                const float sc = ((colg < C_IQ || (colg >= C_BQ && colg < C_CK)) ? QSCALE : 1.f) * ascale;
#pragma unroll
                for (int ai = 0; ai < 2; ++ai) {
                    f32x4 cc[4], ss[4];
#pragma unroll
                    for (int m = 0; m < 4; ++m) { const int t = (row0 + ai * HALF + m * 16) & (SEQ - 1); cc[m] = *(const f32x4*)(cosT + t * 32 + f4); ss[m] = *(const f32x4*)(sinT + t * 32 + f4); }
#pragma unroll
                    for (int m = 0; m < 4; ++m) {
                        const int row = row0 + ai * HALF + m * 16;
                        const f32x4 c = cc[m], s = ss[m];
                        const f32x4 v0 = acc[ai][bj][m][0], v1 = acc[ai][bj][m][1];
                        const f32x4 o0 = (v0 * c - v1 * s) * sc, o1 = (v0 * s + v1 * c) * sc;
                        u32x4 w; w.x = cvtpk(o0[0], o0[1]); w.y = cvtpk(o0[2], o0[3]); w.z = cvtpk(o1[0], o1[1]); w.w = cvtpk(o1[2], o1[3]);
                        *(u32x4*)(dbase + DROW(row)) = w;
                    }
                    asm volatile("" ::: "memory");
                }
                asm volatile("" ::: "memory");
            } else if (colg < C_SIG_END) {
                const int mode = (colg < C_PLAIN_END) ? 0 : (colg < C_SILU_END ? 1 : 2);
#pragma unroll
                for (int ai = 0; ai < 2; ++ai)
#pragma unroll
                    for (int m = 0; m < 4; ++m) {
                        const int row = row0 + ai * HALF + m * 16;
                        f32x4 v0 = acc[ai][bj][m][0] * ascale, v1 = acc[ai][bj][m][1] * ascale;
                        if (mode != 0) {
#pragma unroll
                            for (int e = 0; e < 4; ++e) { const float s0 = sigmoidf_(v0[e]), s1 = sigmoidf_(v1[e]); v0[e] = (mode == 1) ? v0[e] * s0 : s0; v1[e] = (mode == 1) ? v1[e] * s1 : s1; }
                        }
                        if (mode == 2) { u32x2 w; w.x = pk4_fp8(v0[0], v0[1], v0[2], v0[3]); w.y = pk4_fp8(v1[0], v1[1], v1[2], v1[3]);
                            *(u32x2*)(MG8 + mg8_off(row, col - C_MG)) = w; }
                        else { u32x4 w; w.x = cvtpk(v0[0], v0[1]); w.y = cvtpk(v0[2], v0[3]); w.z = cvtpk(v1[0], v1[1]); w.w = cvtpk(v1[2], v1[3]);
                            *(u32x4*)(P + p_off(row, col)) = w; }
                    }
            }
        }
    }
};

struct EpiMerge {
    static constexpr bool PERM = true, KEEP_ACC = true;
    const unsigned char* MG8; bf16_t* Mg; float ascale;
    __device__ __forceinline__ void operator()(f32x4 (&acc)[2][2][4][2], const Unit& u, int wr, int wc, int fr, int fq) const {
        { const int l_ = opaque_lane(); fr = l_ & 15; fq = l_ >> 4; }
        const int row0 = u.pm * BM + wr * 64 + fr; const int br = u.tag;
        const int colb = u.pn * BM + wc * 32 + 8 * fq;
        const float GMIN = 1e-18f;
#pragma unroll
        for (int ai = 0; ai < 2; ++ai) {
            u32x2 gt[4][2], gn[4][2];
#pragma unroll
            for (int m = 0; m < 4; ++m)
#pragma unroll
                for (int bj = 0; bj < 2; ++bj) gt[m][bj] = *(const u32x2*)(MG8 + mg8_off(row0 + ai * HALF + m * 16, br * 1024 + colb + bj * HALF));
            if (br != 2) {
#pragma unroll
                for (int m = 0; m < 4; ++m)
#pragma unroll
                    for (int bj = 0; bj < 2; ++bj) gn[m][bj] = *(const u32x2*)(MG8 + mg8_off(row0 + ai * HALF + m * 16, (br + 1) * 1024 + colb + bj * HALF));
            }
#pragma unroll
            for (int m = 0; m < 4; ++m)
#pragma unroll
                for (int bj = 0; bj < 2; ++bj) {
                    f32x4 v0 = acc[ai][bj][m][0], v1 = acc[ai][bj][m][1];
                    { const f32x2 a = __builtin_amdgcn_cvt_pk_f32_fp8((int)gt[m][bj].x, false), b = __builtin_amdgcn_cvt_pk_f32_fp8((int)gt[m][bj].x, true), c = __builtin_amdgcn_cvt_pk_f32_fp8((int)gt[m][bj].y, false), d = __builtin_amdgcn_cvt_pk_f32_fp8((int)gt[m][bj].y, true);
                      v0[0] *= __builtin_fmaxf(a.x, GMIN); v0[1] *= __builtin_fmaxf(a.y, GMIN); v0[2] *= __builtin_fmaxf(b.x, GMIN); v0[3] *= __builtin_fmaxf(b.y, GMIN);
                      v1[0] *= __builtin_fmaxf(c.x, GMIN); v1[1] *= __builtin_fmaxf(c.y, GMIN); v1[2] *= __builtin_fmaxf(d.x, GMIN); v1[3] *= __builtin_fmaxf(d.y, GMIN); }
                    if (br != 2) {
                        { const f32x2 a = __builtin_amdgcn_cvt_pk_f32_fp8((int)gn[m][bj].x, false), b = __builtin_amdgcn_cvt_pk_f32_fp8((int)gn[m][bj].x, true), c = __builtin_amdgcn_cvt_pk_f32_fp8((int)gn[m][bj].y, false), d = __builtin_amdgcn_cvt_pk_f32_fp8((int)gn[m][bj].y, true);
                          v0[0] *= __builtin_amdgcn_rcpf(__builtin_fmaxf(a.x, GMIN)); v0[1] *= __builtin_amdgcn_rcpf(__builtin_fmaxf(a.y, GMIN)); v0[2] *= __builtin_amdgcn_rcpf(__builtin_fmaxf(b.x, GMIN)); v0[3] *= __builtin_amdgcn_rcpf(__builtin_fmaxf(b.y, GMIN));
                          v1[0] *= __builtin_amdgcn_rcpf(__builtin_fmaxf(c.x, GMIN)); v1[1] *= __builtin_amdgcn_rcpf(__builtin_fmaxf(c.y, GMIN)); v1[2] *= __builtin_amdgcn_rcpf(__builtin_fmaxf(d.x, GMIN)); v1[3] *= __builtin_amdgcn_rcpf(__builtin_fmaxf(d.y, GMIN)); }
                        acc[ai][bj][m][0] = v0; acc[ai][bj][m][1] = v1;
                    } else {
                        const float sm_ = F8_SM * ascale;
                        u32x2 w; w.x = pk4_fp8(v0[0] * sm_, v0[1] * sm_, v0[2] * sm_, v0[3] * sm_); w.y = pk4_fp8(v1[0] * sm_, v1[1] * sm_, v1[2] * sm_, v1[3] * sm_);
                        *(u32x2*)((unsigned char*)Mg + g_off(row0 + ai * HALF + m * 16, colb + bj * HALF, DM)) = w;
                    }
                }
            asm volatile("" ::: "memory");
        }
    }
};

struct EpiResid {
    static constexpr bool PERM = false, KEEP_ACC = false;
    const float* xin; float* out; float ascale;
    __device__ __forceinline__ void operator()(const f32x4 (&acc)[2][2][4][2], const Unit& u, int wr, int wc, int fr, int fq) const {
        { const int l_ = opaque_lane(); fr = l_ & 15; fq = l_ >> 4; }
        const int row0 = u.pm * BM + wr * 64 + fr; const int col0 = u.pn * BM + wc * 32 + 4 * fq;
#pragma unroll
        for (int ai = 0; ai < 2; ++ai)
#pragma unroll
            for (int mp = 0; mp < 4; mp += 4) {
                f32x4 bs[4][2][2];
#pragma unroll
                for (int m = 0; m < 4; ++m)
#pragma unroll
                    for (int bj = 0; bj < 2; ++bj)
#pragma unroll
                        for (int n = 0; n < 2; ++n) bs[m][bj][n] = *(const f32x4*)(xin + (size_t)(row0 + ai * HALF + (mp + m) * 16) * DM + col0 + bj * HALF + n * 16);
#pragma unroll
                for (int m = 0; m < 4; ++m)
#pragma unroll
                    for (int bj = 0; bj < 2; ++bj)
#pragma unroll
                        for (int n = 0; n < 2; ++n) *(f32x4*)(out + (size_t)(row0 + ai * HALF + (mp + m) * 16) * DM + col0 + bj * HALF + n * 16) = bs[m][bj][n] + acc[ai][bj][mp + m][n] * ascale;
                asm volatile("" ::: "memory");
            }
    }
};
}

template <class T> __device__ __forceinline__ T* launder(T* p) { asm volatile("" : "+s"(p)); return p; }
#define XB_TMO      128
#define XB_XCNT(j)  (256  + 64 * (j))
#define XB_XSUB(j)  (1280 + 64 * (j))
#define XB_XGEN(j)  (2304 + 64 * (j))
#define XB_TOP      3328
#define XB_TOPGEN   3392
#define XCD_BAR_WORDS 3456
#define XB_SPIN_CAP (1u << 18)
__device__ __forceinline__ unsigned xb_ld(unsigned* p)              { return __hip_atomic_load(p, __ATOMIC_RELAXED, __HIP_MEMORY_SCOPE_AGENT); }
__device__ __forceinline__ unsigned xb_add(unsigned* p, unsigned v) { return __hip_atomic_fetch_add(p, v, __ATOMIC_RELAXED, __HIP_MEMORY_SCOPE_AGENT); }
__device__ __forceinline__ unsigned xb_xcc_id() { return (unsigned)__builtin_amdgcn_s_getreg((3 << 11) | 20) & 0xFu; }
#define XB_SPIN(cond, bar) do { unsigned _sp = 0; while (cond) { __builtin_amdgcn_s_sleep(1); \
    if ((++_sp & 255u) == 0u) { if (xb_ld(&(bar)[XB_TMO])) break; if (_sp > XB_SPIN_CAP) { atomicAdd(&(bar)[XB_TMO], 1u); break; } } } } while (0)
struct XcdBarrier { unsigned* bar; unsigned x; volatile LAS unsigned* st; };
__device__ __forceinline__ XcdBarrier xcd_barrier_post(unsigned* bar, volatile LAS unsigned* st) {
    XcdBarrier b; b.bar = bar; b.x = xb_xcc_id(); b.st = st;
    if (threadIdx.x == 0) (void)xb_add(&bar[XB_XCNT(b.x)], 1u);
    return b;
}
__device__ __forceinline__ void xcd_barrier_complete(unsigned* bar, unsigned x, unsigned& nloc, unsigned& nx) {
    const unsigned G = gridDim.x * gridDim.y * gridDim.z;
    unsigned sum, cnt, mine, sp = 0u;
    for (;;) {
        sum = 0u; cnt = 0u; mine = 0u;
#pragma unroll
        for (unsigned j = 0; j < 16; ++j) { const unsigned c = xb_ld(&bar[XB_XCNT(j)]); sum += c; cnt += (c > 0u) ? 1u : 0u; mine = (j == x) ? c : mine; }
        if (sum == G) break;
        __builtin_amdgcn_s_sleep(1);
        if ((++sp & 255u) == 0u) { if (xb_ld(&bar[XB_TMO])) break; if (sp > XB_SPIN_CAP) { atomicAdd(&bar[XB_TMO], 1u); break; } }
    }
    nloc = mine > 0u ? mine : 1u; nx = cnt > 0u ? cnt : 1u;
}
template <bool FIRST> __device__ __forceinline__ void xcd_barrier(const XcdBarrier& b, int wave) {
    asm volatile("s_waitcnt vmcnt(0)" ::: "memory");
    __syncthreads();
    if (opaque_tid(wave) == 0) {
        unsigned* bar = launder(b.bar);
        unsigned bx = b.x; asm volatile("" : "+s"(bx));
        __builtin_amdgcn_s_waitcnt(0);
        unsigned nloc = b.st[0], nx = b.st[1];
        if (FIRST) { xcd_barrier_complete(bar, bx, nloc, nx); b.st[0] = nloc; b.st[1] = nx; }
        const unsigned old = xb_add(&bar[XB_XSUB(bx)], 1u);
        const unsigned gen = old / nloc;
        if (old + 1u == (gen + 1u) * nloc) {
            __builtin_amdgcn_fence(__ATOMIC_RELEASE, "agent");
            asm volatile("s_waitcnt vmcnt(0)" ::: "memory");
            const unsigned og = xb_add(&bar[XB_TOP], 1u);
            const unsigned tg = og / nx;
            if (og + 1u == (tg + 1u) * nx) xb_add(&bar[XB_TOPGEN], 1u);
            else XB_SPIN(xb_ld(&bar[XB_TOPGEN]) == tg, bar);
            __builtin_amdgcn_fence(__ATOMIC_ACQUIRE, "agent");
            xb_add(&bar[XB_XGEN(bx)], 1u);
            asm volatile("s_waitcnt vmcnt(0)" ::: "memory");
        } else {
            XB_SPIN(xb_ld(&bar[XB_XGEN(bx)]) == gen, bar);
            __builtin_amdgcn_fence(__ATOMIC_ACQUIRE, "agent");
            asm volatile("s_waitcnt vmcnt(0)" ::: "memory");
        }
    }
    __syncthreads();
}

struct Frame {
    LAS unsigned char* lds;
    volatile LAS unsigned* MISC;
    gu32* ctl;
    int tid, lane, wave, G;
};

__device__ __forceinline__ float wave_sum(float v) {
    v += __int_as_float(__builtin_amdgcn_update_dpp(0, __float_as_int(v), 0xB1, 0xf, 0xf, false));
    v += __int_as_float(__builtin_amdgcn_update_dpp(0, __float_as_int(v), 0x4E, 0xf, 0xf, false));
    v += __int_as_float(__builtin_amdgcn_update_dpp(0, __float_as_int(v), 0x141, 0xf, 0xf, false));
    v += __int_as_float(__builtin_amdgcn_update_dpp(0, __float_as_int(v), 0x140, 0xf, 0xf, false));
    v += __int_as_float(__builtin_amdgcn_update_dpp(0, __float_as_int(v), 0x142, 0xa, 0xf, false));
    v += __int_as_float(__builtin_amdgcn_update_dpp(0, __float_as_int(v), 0x143, 0xc, 0xf, false));
    return __int_as_float(__builtin_amdgcn_readlane(__float_as_int(v), 63));
}
__device__ __forceinline__ float shfl_xor_l(float v, int mask, int lane) { return __int_as_float(__builtin_amdgcn_ds_bpermute((lane ^ mask) << 2, __float_as_int(v))); }

__device__ __forceinline__ int src_col(int n) {
    if (n < C_ROPE_END) {
        int bn, bo;
        if (n < 384) { bn = 0; bo = 0; } else if (n < 640) { bn = 384; bo = 2432; } else if (n < 704) { bn = 640; bo = 2688; }
        else if (n < 768) { bn = 704; bo = 1920; } else if (n < 1152) { bn = 768; bo = 384; } else if (n < 1536) { bn = 1152; bo = 1536; }
        else if (n < 2304) { bn = 1536; bo = 2756; } else { bn = 2304; bo = 3524; }
        const int r = n - bn, head = r >> 6, p = r & 63, i = p >> 3, e = p & 7;
        const int dim = (e < 4) ? 4 * i + e : 32 + 4 * i + (e - 4);
        return bo + head * 64 + dim;
    }
    if (n < 3456) return 768 + (n - 3072);
    if (n < 3520) return 1984 + (n - 3456);
    if (n < 4288) return 4292 + (n - 3520);
    if (n < 4672) return 1152 + (n - 4288);
    if (n < 5056) return 2048 + (n - 4672);
    if (n < 5312) return 5060 + (n - 5056);
    if (n < 8384) return 5316 + (n - 5312);
    return -1;
}

template <bool PERMUTE, bool F8OUT = false>
__device__ __forceinline__ void transpose_item(const float* W, int ldw, int nblk, bf16_t* WT, int ldt, int koff, LAS float* scr, int item, int lane, int nbase = 0, int nrow0 = 0) {
    const int kb = item / nblk, nb = item % nblk, k0 = 64 * kb, n0 = nbase + 32 * nb;
    const int sc = PERMUTE ? src_col(n0 + (lane & 31)) : (n0 + (lane & 31));
    float wv[32];
    const float* wp = W + (size_t)(k0 + (lane >> 5)) * ldw + (sc >= 0 ? sc : 0);
#pragma unroll
    for (int i = 0; i < 32; ++i) wv[i] = wp[(size_t)(2 * i) * ldw];
#pragma unroll
    for (int i = 0; i < 32; ++i) { const int kk = 2 * i + (lane >> 5); scr[kk * 33 + (lane & 31)] = (sc >= 0) ? wv[i] : 0.f; }
    LDS_WAIT(); asm volatile("" ::: "memory");
    const int c = lane & 7;
#pragma unroll
    for (int j = 0; j < 4; ++j) { const int n = (lane >> 3) + 8 * j; const LAS float* s = scr + (8 * c) * 33 + n;
        if (F8OUT) { u32x2 o; o.x = pk4_fp8(s[0 * 33] * F8_SB, s[1 * 33] * F8_SB, s[2 * 33] * F8_SB, s[3 * 33] * F8_SB); o.y = pk4_fp8(s[4 * 33] * F8_SB, s[5 * 33] * F8_SB, s[6 * 33] * F8_SB, s[7 * 33] * F8_SB);
            *(u32x2*)((unsigned char*)WT + (size_t)(n0 - nrow0 + n) * ldt + koff + k0 + 8 * c) = o; }
        else { u32x4 o; o.x = pk2(s[0 * 33], s[1 * 33]); o.y = pk2(s[2 * 33], s[3 * 33]); o.z = pk2(s[4 * 33], s[5 * 33]); o.w = pk2(s[6 * 33], s[7 * 33]);
            *(u32x4*)(WT + (size_t)(n0 + n) * ldt + koff + k0 + 8 * c) = o; } }
    LDS_WAIT(); asm volatile("" ::: "memory");
}

template <bool TO_BF16, int NB>
__device__ __forceinline__ void rms_rows(const float* xrow, const float* g, void* orow, unsigned char* o8row, float* iwrow, const float* wiw, int lane) {
    f32x4 v[NB][4];
#pragma unroll
    for (int r = 0; r < NB; ++r) { const f32x4* xr = (const f32x4*)(xrow + (size_t)r * DM) + lane;
#pragma unroll
        for (int j = 0; j < 4; ++j) v[r][j] = xr[64 * j]; }
    const f32x4* gr = (const f32x4*)g + lane;
    f32x4 gv[4];
#pragma unroll
    for (int j = 0; j < 4; ++j) gv[j] = gr[64 * j];
#pragma unroll
    for (int r = 0; r < NB; ++r) {
        float s = 0.f;
#pragma unroll
        for (int j = 0; j < 4; ++j) s += (v[r][j].x * v[r][j].x + v[r][j].y * v[r][j].y) + (v[r][j].z * v[r][j].z + v[r][j].w * v[r][j].w);
        const float rs = 1.f / sqrtf(wave_sum(s) * (1.f / DM) + RMS_EPS);
#pragma unroll
        for (int j = 0; j < 4; ++j) v[r][j] = v[r][j] * rs * gv[j];
        if (TO_BF16) {
            u64* o8 = (u64*)((bf16_t*)orow + (size_t)r * DM) + lane;
            unsigned* o4 = (unsigned*)(o8row + (size_t)r * DM) + lane;
#pragma unroll
            for (int j = 0; j < 4; ++j) { const f32x4 w = v[r][j]; o8[64 * j] = (u64)pk2(w.x, w.y) | ((u64)pk2(w.z, w.w) << 32);
                o4[64 * j] = pk4_fp8(w.x * F8_SA, w.y * F8_SA, w.z * F8_SA, w.w * F8_SA); }
        } else {
            f32x4* o = (f32x4*)((float*)orow + (size_t)r * DM) + lane;
#pragma unroll
            for (int j = 0; j < 4; ++j) o[64 * j] = v[r][j];
        }
    }
    if (TO_BF16) {
        f32x4 acc[NB];
#pragma unroll
        for (int r = 0; r < NB; ++r) acc[r] = (f32x4){0.f, 0.f, 0.f, 0.f};
#pragma unroll
        for (int j = 0; j < 4; ++j) {
            f32x4 wk[4];
#pragma unroll
            for (int e = 0; e < 4; ++e) wk[e] = *(const f32x4*)(wiw + (size_t)(256 * j + 4 * lane + e) * INW);
#pragma unroll
            for (int r = 0; r < NB; ++r) acc[r] += wk[0] * v[r][j].x + wk[1] * v[r][j].y + wk[2] * v[r][j].z + wk[3] * v[r][j].w;
        }
#pragma unroll
        for (int r = 0; r < NB; ++r) { f32x4 t; t.x = wave_sum(acc[r].x); t.y = wave_sum(acc[r].y); t.z = wave_sum(acc[r].z); t.w = wave_sum(acc[r].w);
            if (lane == 0) *(f32x4*)(iwrow + (size_t)r * 4) = t * 0.0625f; }
    }
}

namespace att {
constexpr int SLOTB = 8192, NSLOT = 4;
constexpr size_t PO_STRIDE = (size_t)MC * 4 * 64, PML_STRIDE = (size_t)MC * 4 * 2;
constexpr int L_K = 0, L_V = NSLOT * SLOTB, L_M = 2 * NSLOT * SLOTB, L_KM = L_M + NSLOT * 2048, L_LUT = L_KM + 2048;
typedef LAS const char* lds_cptr;
typedef short v4i16_t __attribute__((ext_vector_type(4)));
__device__ __forceinline__ s16x4 vtr(lds_cptr p) { return __builtin_bit_cast(s16x4, __builtin_amdgcn_ds_read_tr16_b64_v4i16((LAS v4i16_t*)p)); }
__device__ __forceinline__ float swap_add(float v) { auto rr = __builtin_amdgcn_permlane32_swap(__float_as_uint(v), __float_as_uint(v), false, false); return __uint_as_float(rr[0]) + __uint_as_float(rr[1]); }
__device__ __forceinline__ float swap_max(float v) { auto rr = __builtin_amdgcn_permlane32_swap(__float_as_uint(v), __float_as_uint(v), false, false); return __builtin_fmaxf(__uint_as_float(rr[0]), __uint_as_float(rr[1])); }
__device__ __forceinline__ float fadd_s(float a, float b) { float r; asm("v_add_f32_e32 %0, %1, %2" : "=v"(r) : "v"(a), "v"(b)); return r; }
__device__ __forceinline__ float fmax_s(float a, float b) { float r; asm("v_max_f32_e32 %0, %1, %2" : "=v"(r) : "v"(a), "v"(b)); return r; }
__device__ __forceinline__ float fmax3_s(float a, float b, float c) { float r; asm("v_max3_f32 %0, %1, %2, %3" : "=v"(r) : "v"(a), "v"(b), "v"(c)); return r; }
__device__ __forceinline__ void glds16(const void* gsrc, unsigned lds_dst) { unsigned keep;
    asm volatile("s_mov_b32 %0, m0\n\ts_mov_b32 m0, %2\n\ts_nop 0\n\tglobal_load_lds_dwordx4 %1, off\n\ts_mov_b32 m0, %0" : "=&s"(keep) : "v"(gsrc), "s"(lds_dst) : "memory"); }
__device__ __forceinline__ void glds4(const void* gsrc, unsigned lds_dst) { unsigned keep;
    asm volatile("s_mov_b32 %0, m0\n\ts_mov_b32 m0, %2\n\ts_nop 0\n\tglobal_load_lds_dword %1, off\n\ts_mov_b32 m0, %0" : "=&s"(keep) : "v"(gsrc), "s"(lds_dst) : "memory"); }
#define WAITBAR(N) asm volatile("s_waitcnt vmcnt(" #N ") lgkmcnt(0)\n\ts_barrier" ::: "memory")

template <int MODE>
__device__ __forceinline__ void attn_unit(LAS unsigned char* lds, const bf16_t* __restrict__ P, bf16_t* __restrict__ Y, const u64* __restrict__ bits, float* __restrict__ PO, float* __restrict__ PML, int rowbase, int hsel, int blk, int wave) {
    wave = opaque_wave(wave);
    const int tid = opaque_tid(wave), lane = tid & 63, r32 = lane & 31, hi = lane >> 5; const int wid = wave;
    constexpr int RS = (MODE == 3) ? 8 : (MODE == 4) ? 4 : 1;
    const int roff = (MODE == 3) ? blk : (MODE == 4) ? (blk & 3) : 0;
    const int T0 = (MODE == 3) ? 0 : (MODE == 4) ? 256 * (blk >> 2) : blk * 256, qw0 = T0 + wid * 32, qpos = qw0 + r32;
    const int qtok = roff + RS * qpos;
    const float NEG = -INFINITY;
    constexpr int NDMA = (MODE == 1) ? 3 : 2;
    int n0 = 0, n1 = 0, s0 = 0, s1 = 0, NT;
    if (MODE == 0) NT = 4 + 4 * blk;
    else if (MODE == 1) NT = 4 * (blk + 1);
    else if (MODE == 3) NT = 4;
    else { s0 = T0 >= 128 ? T0 - 128 : 0; n0 = (T0 + 256 - s0) >> 6; NT = n0; }
    const int ycol = (MODE == 0) ? 64 * hsel : (MODE == 1) ? 384 + 64 * hsel : 768 + 64 * hsel;
    const int ycol8 = (MODE == 0) ? 64 * hsel : (MODE == 1) ? 512 + 64 * hsel : 1024 + 64 * hsel;
#define TILE_INFO(t, row0, seg) do { if (MODE == 0) { if ((t) < 4) { seg = 0; row0 = T0 + 64 * (t); } else { seg = 1; row0 = 64 * ((t) - 4); } } \
        else if (MODE == 1 || MODE == 3) { seg = (MODE == 3) ? 2 : 0; row0 = 64 * (t); } \
        else { seg = (MODE == 4) ? 1 : 0; row0 = s0 + 64 * (t); } } while (0)
#define KCOL(seg) ((MODE == 0) ? (C_AK + 64 * hsel) : (MODE == 1) ? C_BK : (C_CK + 64 * (4 * (seg) + hsel)))
#define VCOL(seg) ((MODE == 0) ? (C_AV + 64 * hsel) : (MODE == 1) ? C_BV : (C_CV + 64 * (4 * (seg) + hsel)))
#define QCOL(seg) ((MODE == 0) ? (C_AQ + 64 * hsel) : (MODE == 1) ? (C_BQ + 64 * hsel) : (C_CQ + 64 * (4 * (seg) + hsel)))
    const unsigned lds0 = (unsigned)(uintptr_t)lds;
    const u64* brow_dma = bits + (size_t)(rowbase + T0 + 32 * wid + (lane >> 1)) * 32;
    const char* kbase_l = (const char*)(P + p_off(rowbase + roff + RS * lane, wid * 8));
    const char* vbase_l = (const char*)(P + p_off(rowbase + roff + RS * (16 * (wid & 3) + (lane >> 2)), (wid >> 2) * 32 + (lane & 3) * 8));
#define ISSUE(t) do { int row0_, seg_; TILE_INFO((t), row0_, seg_); const int slot_ = (t) & (NSLOT - 1); \
        const size_t ko_ = (p_off(row0_ * RS, 0) + p_col(KCOL(seg_))) * 2, vo_ = (p_off(row0_ * RS, 0) + p_col(VCOL(seg_))) * 2;     \
        glds16(kbase_l + ko_, (unsigned)__builtin_amdgcn_readfirstlane(lds0 + L_K + slot_ * SLOTB + wid * 1024)); \
        glds16(vbase_l + vo_, (unsigned)__builtin_amdgcn_readfirstlane(lds0 + L_V + slot_ * SLOTB + wid * 1024)); \
        if (MODE == 1) glds4((const unsigned*)(brow_dma + (t)) + (lane & 1), (unsigned)__builtin_amdgcn_readfirstlane(lds0 + L_M + slot_ * 2048 + wid * 256)); } while (0)

    const bf16_t* qrow = P + p_off(rowbase + qtok, 0);
    asm volatile("s_waitcnt vmcnt(0)" ::: "memory");
    ISSUE(0);
    if (NT > 1) ISSUE(1);
    if (NT > 2) ISSUE(2);
    constexpr int NQ = 1;
    constexpr int QS0 = (MODE == 3) ? 2 : (MODE == 4) ? 1 : 0;
    bf16x8 qr[NQ][4];
#pragma unroll
    for (int sg = 0; sg < NQ; ++sg)
#pragma unroll
        for (int d0 = 0; d0 < 4; ++d0) qr[sg][d0] = *(const bf16x8*)(qrow + p_col(QCOL(QS0 + sg) + d0 * 16 + hi * 8));
    unsigned sel = 0u;
    if (MODE == 0) {
        LAS float* km = (LAS float*)(lds + L_KM);
        if (wid < blk) {
            const int c = lane & 7, rg = lane >> 3; float a[8];
#pragma unroll
            for (int e = 0; e < 8; ++e) a[e] = 0.f;
            const bf16_t* kp = P + p_off(rowbase + 256 * wid + rg, C_AK + 64 * hsel + 8 * c);
#pragma unroll 8
            for (int i = 0; i < 32; ++i) { const bf16x8 v = *(const bf16x8*)(kp + (size_t)(i >> 1) * PBLK * 512 + (size_t)(i & 1) * 256);
#pragma unroll
                for (int e = 0; e < 8; ++e) a[e] += bf2f(v[e]); }
#pragma unroll
            for (int e = 0; e < 8; ++e) { a[e] += shfl_xor_l(a[e], 8, lane); a[e] += shfl_xor_l(a[e], 16, lane); a[e] += shfl_xor_l(a[e], 32, lane); }
            if (rg == 0) {
#pragma unroll
                for (int e = 0; e < 8; ++e) km[wid * 64 + 8 * c + e] = a[e] * (1.f / 256.f);
            }
        }
        __syncthreads();
        float g[7];
#pragma unroll
        for (int j = 0; j < 7; ++j) {
            float part = 0.f;
            if (j < blk) {
#pragma unroll
                for (int d0 = 0; d0 < 4; ++d0) { const f32x4 k0 = *(const LAS f32x4*)(km + j * 64 + 16 * d0 + 8 * hi), k1 = *(const LAS f32x4*)(km + j * 64 + 16 * d0 + 8 * hi + 4);
#pragma unroll
                    for (int e = 0; e < 4; ++e) part += bf2f(qr[0][d0][e]) * k0[e] + bf2f(qr[0][d0][4 + e]) * k1[e]; }
                part = swap_add(part);
            }
            g[j] = (j < blk) ? part : NEG;
        }
#pragma unroll
        for (int rep = 0; rep < 3; ++rep) { float bv = NEG; int best = -1;
#pragma unroll
            for (int j = 0; j < 7; ++j) { const bool ok = (j < blk) && !((sel >> j) & 1u) && (g[j] > bv); if (ok) { bv = g[j]; best = j; } }
            if (best >= 0) sel |= 1u << best; }
    }
    f32x16 o0 = {}, o1 = {}; float m_run = 0.f, l_run = 0.f; f32x16 negm = {}; asm volatile("" : "+v"(negm));
    constexpr float DEFER_THR = 8.f;
    bool fresh = true;
    const lds_cptr lds3 = (lds_cptr)lds;
    const lds_cptr kp0 = lds3 + L_K + hi * 1024 + r32 * 16;
    const lds_cptr vp0 = lds3 + L_V + ((lane >> 4) & 1) * 32 + (lane & 3) * 8 + (4 * hi + ((lane & 15) >> 2)) * 64;
    const lds_cptr mp0 = lds3 + L_M + (32 * wid + r32) * 8;
#pragma unroll
    for (int sg = 0; sg < NQ; ++sg)
#pragma unroll
        for (int d0 = 0; d0 < 4; ++d0) asm volatile("" : "+v"(qr[sg][d0]));
    WAITBAR(0);
    for (int t = 0; t < NT; ++t) {
        int row0, seg; TILE_INFO(t, row0, seg);
        bool active;
        if (MODE == 0) active = (seg == 0) ? (row0 <= qw0 + 31) : (__any((sel >> (row0 >> 8)) & 1u) != 0);
        else if (MODE == 1 || MODE == 3) active = (row0 <= qw0 + 31);
        else active = (row0 <= qw0 + 31) && (row0 + 63 + 128 >= qw0);
        if (!active) { if (t + 3 < NT) ISSUE(t + 3); }
        if (active) {
            const int slot = (t & (NSLOT - 1)) * SLOTB;
            u32x2 mw = {0u, 0u}; if (MODE == 1) mw = *(const LAS u32x2*)(mp0 + (t & (NSLOT - 1)) * 2048);
            bf16x8 kf[8];
            { const lds_cptr kp = kp0 + slot;
#pragma unroll
              for (int j = 0; j < 4; ++j) { kf[2 * j] = *(const LAS bf16x8*)(kp + j * 2048); kf[2 * j + 1] = *(const LAS bf16x8*)(kp + j * 2048 + 512); } }
            if (t + 3 < NT) ISSUE(t + 3);
            s16x4 vlo[2][4], vhi[2][4];
            { const lds_cptr vp = vp0 + slot;
#pragma unroll
              for (int d0 = 0; d0 < 2; ++d0)
#pragma unroll
                  for (int ks = 0; ks < 4; ++ks) { vlo[d0][ks] = vtr(vp + d0 * 4096 + ks * 1024); vhi[d0][ks] = vtr(vp + d0 * 4096 + ks * 1024 + 512); } }
            f32x16 p0 = __builtin_amdgcn_mfma_f32_32x32x16_bf16(kf[0], qr[0][0], negm, 0, 0, 0), p1 = __builtin_amdgcn_mfma_f32_32x32x16_bf16(kf[1], qr[0][0], negm, 0, 0, 0);
#pragma unroll
            for (int d0 = 1; d0 < 4; ++d0) { p0 = __builtin_amdgcn_mfma_f32_32x32x16_bf16(kf[2 * d0], qr[0][d0], p0, 0, 0, 0); p1 = __builtin_amdgcn_mfma_f32_32x32x16_bf16(kf[2 * d0 + 1], qr[0][d0], p1, 0, 0, 0); }
            if (MODE == 0) {
                if (seg == 0) { if (row0 + 63 > qw0) { const int kb = row0 + 4 * hi;
#pragma unroll
                    for (int r = 0; r < 16; ++r) { const int kv = kb + (r & 3) + 8 * (r >> 2); if (kv > qpos) p0[r] = NEG; if (kv + 32 > qpos) p1[r] = NEG; } } }
                else { if (!((sel >> (row0 >> 8)) & 1u)) {
#pragma unroll
                    for (int r = 0; r < 16; ++r) { p0[r] = NEG; p1[r] = NEG; } } }
            } else if (MODE == 1) {
                const int lo = (int)(mw.x >> (4 * hi)), hw = (int)(mw.y >> (4 * hi));
#pragma unroll
                for (int r = 0; r < 16; ++r) { const unsigned m0_ = (unsigned)__builtin_amdgcn_sbfe(lo, (r & 3) + 8 * (r >> 2), 1), m1_ = (unsigned)__builtin_amdgcn_sbfe(hw, (r & 3) + 8 * (r >> 2), 1);
                    p0[r] = __uint_as_float((__float_as_uint(p0[r]) & m0_) | (0xff800000u & ~m0_)); p1[r] = __uint_as_float((__float_as_uint(p1[r]) & m1_) | (0xff800000u & ~m1_)); }
            } else {
                const int lg = (MODE == 3) ? 1 : 0; const int base = qpos - row0 - 4 * hi;
#pragma unroll
                for (int r = 0; r < 16; ++r) { const unsigned d0_ = (unsigned)(base - ((r & 3) + 8 * (r >> 2))), d1_ = d0_ - 32u;
                    if (__builtin_rotateright32(d0_, (unsigned)lg) > 128u) p0[r] = NEG; if (__builtin_rotateright32(d1_, (unsigned)lg) > 128u) p1[r] = NEG; }
            }
            asm volatile("s_nop 11" : "+v"(p0), "+v"(p1));
            float ma = fmax3_s(p0[0], p0[1], p1[0]), mb = fmax3_s(p0[2], p0[3], p1[1]);
            ma = fmax3_s(ma, p1[2], p1[3]);
#pragma unroll
            for (int r = 4; r < 16; r += 4) { ma = fmax3_s(ma, p0[r], p0[r + 1]); mb = fmax3_s(mb, p0[r + 2], p0[r + 3]);
                ma = fmax3_s(ma, p1[r], p1[r + 1]); mb = fmax3_s(mb, p1[r + 2], p1[r + 3]); }
            const float rm = swap_max(__builtin_fmaxf(ma, mb));
            if (fresh || __any(rm > DEFER_THR)) {
                const float dl = fresh ? ((rm == NEG) ? 0.f : rm) : __builtin_fmaxf(rm, 0.f); m_run += dl; fresh = false;
                const float f = __builtin_amdgcn_exp2f(-dl); l_run *= f;
#pragma unroll
                for (int r = 0; r < 16; ++r) { p0[r] -= dl; p1[r] -= dl; o0[r] *= f; o1[r] *= f; negm[r] = -m_run; }
                asm volatile("" : "+v"(negm));
            }
            float ls0 = 0.f, ls1 = 0.f;
#pragma unroll
            for (int r = 0; r < 16; ++r) { p0[r] = __builtin_amdgcn_exp2f(p0[r]); p1[r] = __builtin_amdgcn_exp2f(p1[r]); }
            asm volatile("" : "+v"(p0), "+v"(p1));
#pragma unroll
            for (int r = 0; r < 16; ++r) { ls0 = fadd_s(ls0, p0[r]); ls1 = fadd_s(ls1, p1[r]); }
            l_run = fadd_s(l_run, fadd_s(ls0, ls1));
            u32x4 pw[4];
            pw[0] = (u32x4){cvtpk(p0[0], p0[1]), cvtpk(p0[2], p0[3]), cvtpk(p0[4], p0[5]), cvtpk(p0[6], p0[7])};
            pw[1] = (u32x4){cvtpk(p0[8], p0[9]), cvtpk(p0[10], p0[11]), cvtpk(p0[12], p0[13]), cvtpk(p0[14], p0[15])};
            pw[2] = (u32x4){cvtpk(p1[0], p1[1]), cvtpk(p1[2], p1[3]), cvtpk(p1[4], p1[5]), cvtpk(p1[6], p1[7])};
            pw[3] = (u32x4){cvtpk(p1[8], p1[9]), cvtpk(p1[10], p1[11]), cvtpk(p1[12], p1[13]), cvtpk(p1[14], p1[15])};
#pragma unroll
            for (int d0 = 0; d0 < 2; ++d0)
#pragma unroll
                for (int ks = 0; ks < 4; ++ks) {
                    const bf16x8 vf = (bf16x8){vlo[d0][ks][0], vlo[d0][ks][1], vlo[d0][ks][2], vlo[d0][ks][3], vhi[d0][ks][0], vhi[d0][ks][1], vhi[d0][ks][2], vhi[d0][ks][3]};
                    if (d0 == 0) o0 = __builtin_amdgcn_mfma_f32_32x32x16_bf16(vf, __builtin_bit_cast(bf16x8, pw[ks]), o0, 0, 0, 0);
                    else         o1 = __builtin_amdgcn_mfma_f32_32x32x16_bf16(vf, __builtin_bit_cast(bf16x8, pw[ks]), o1, 0, 0, 0);
                }
        }
        const int ahead = NT - 2 - t;
        if (MODE == 1) { if (ahead >= 2) WAITBAR(6); else if (ahead == 1) WAITBAR(3); else WAITBAR(0); }
        else           { if (ahead >= 2) WAITBAR(4); else if (ahead == 1) WAITBAR(2); else WAITBAR(0); }
    }
    const float l_tot = swap_add(l_run);
    if (MODE == 3 || MODE == 4) {
        constexpr size_t PSEL = (MODE == 4) ? 1 : 0;
        float* po = PO + PSEL * PO_STRIDE + ((size_t)(rowbase + qtok) * 4 + hsel) * 64;
#pragma unroll
        for (int d0 = 0; d0 < 2; ++d0)
#pragma unroll
            for (int g4 = 0; g4 < 4; ++g4) { const int dim = 32 * d0 + 8 * g4 + 4 * hi;
                *(f32x4*)(po + dim) = (d0 == 0) ? (f32x4){o0[4 * g4], o0[4 * g4 + 1], o0[4 * g4 + 2], o0[4 * g4 + 3]} : (f32x4){o1[4 * g4], o1[4 * g4 + 1], o1[4 * g4 + 2], o1[4 * g4 + 3]}; }
        if (hi == 0) *(f32x2*)(PML + PSEL * PML_STRIDE + ((size_t)(rowbase + qtok) * 4 + hsel) * 2) = (f32x2){m_run, l_tot};
    } else {
        float sc_o = 1.f, sc_p = 0.f, sc_q = 0.f, L = l_tot;
        const float* po = PO + ((size_t)(rowbase + qtok) * 4 + hsel) * 64;
        if (MODE == 2) {
            const f32x2 ml = *(const f32x2*)(PML + ((size_t)(rowbase + qtok) * 4 + hsel) * 2), ml1 = *(const f32x2*)(PML + PML_STRIDE + ((size_t)(rowbase + qtok) * 4 + hsel) * 2);
            const float M = __builtin_fmaxf(__builtin_fmaxf(m_run, ml.x), ml1.x);
            sc_o = __builtin_amdgcn_exp2f(m_run - M); sc_p = __builtin_amdgcn_exp2f(ml.x - M); sc_q = __builtin_amdgcn_exp2f(ml1.x - M);
            L = l_tot * sc_o + ml.y * sc_p + ml1.y * sc_q;
        }
        const float inv = 1.f / L;
        const bf16_t* grow = qrow + p_col(C_GA + ycol); const int yr_ = rowbase + qtok;
#pragma unroll
        for (int d0 = 0; d0 < 2; ++d0)
#pragma unroll
            for (int g4 = 0; g4 < 4; ++g4) {
                const int dim = 32 * d0 + 8 * g4 + 4 * hi;
                const s16x4 gt = *(const s16x4*)(grow + p_col(dim));
                f32x4 pp = {0.f, 0.f, 0.f, 0.f}, pq = {0.f, 0.f, 0.f, 0.f}; if (MODE == 2) { pp = *(const f32x4*)(po + dim); pq = *(const f32x4*)(po + PO_STRIDE + dim); }
                float v[4];
#pragma unroll
                for (int e = 0; e < 4; ++e) v[e] = ((d0 == 0 ? o0[4 * g4 + e] : o1[4 * g4 + e]) * sc_o + pp[e] * sc_p + pq[e] * sc_q) * inv * bf2f(gt[e]);
                *(unsigned*)((unsigned char*)Y + g_off(yr_, ycol8 + dim, YP)) = pk4_fp8(v[0] * F8_SY, v[1] * F8_SY, v[2] * F8_SY, v[3] * F8_SY);
            }
        if ((MODE == 0 || MODE == 1) && hsel == 5) {
#pragma unroll
            for (int j = 0; j < 4; ++j) *(u32x4*)((unsigned char*)Y + g_off(yr_, ycol8 + 64 + 64 * hi + 16 * j, YP)) = (u32x4){0u, 0u, 0u, 0u};
        }
    }
#undef TILE_INFO
#undef KCOL
#undef VCOL
#undef QCOL
#undef ISSUE
}

template <int MODE>
__device__ __forceinline__ void attn_unit2(LAS unsigned char* lds, const bf16_t* __restrict__ P, bf16_t* __restrict__ Y, const u64* __restrict__ bits, int rowbase, int hsel, int blk, int wave) {
    wave = opaque_wave(wave);
    const int tid = opaque_tid(wave), lane = tid & 63, r32 = lane & 31, hi = lane >> 5; const int wid = wave;
    const float NEG = -INFINITY;
    const int T0a = (MODE == 0) ? 512 * blk : 256 * blk, T0b = (MODE == 0) ? T0a + 256 : T0a;
    const int NT = (MODE == 0) ? 8 * (blk + 1) : 4 * (blk + 1);
    const int kcol = (MODE == 0) ? (C_AK + 64 * hsel) : C_BK, vcol = (MODE == 0) ? (C_AV + 64 * hsel) : C_BV;
#define T2_ROW0(t) ((MODE == 1) ? 64 * (t) : ((t) < 4) ? (T0b + 64 * (t)) : ((t) < 8) ? (T0a + 64 * ((t) - 4)) : 64 * ((t) - 8))
    int qw0[2], qpos[2]; qw0[0] = T0a + wid * 32; qw0[1] = T0b + wid * 32; qpos[0] = qw0[0] + r32; qpos[1] = qw0[1] + r32;
    const unsigned lds0 = (unsigned)(uintptr_t)lds;
    const u64* brow_dma = bits + ((size_t)((rowbase + T0a) >> 5) + wid) * 1024 + (lane >> 1);
    const char* kbase_l = (const char*)(P + p_off(rowbase + lane, wid * 8));
    const char* vbase_l = (const char*)(P + p_off(rowbase + 16 * (wid & 3) + (lane >> 2), (wid >> 2) * 32 + (lane & 3) * 8));
#define ISSUE2(t) do { const int row0_ = T2_ROW0(t); const int slot_ = (t) & (NSLOT - 1); \
        const size_t ko_ = (p_off(row0_, 0) + p_col(kcol)) * 2, vo_ = (p_off(row0_, 0) + p_col(vcol)) * 2;     \
        glds16(kbase_l + ko_, (unsigned)__builtin_amdgcn_readfirstlane(lds0 + L_K + slot_ * SLOTB + wid * 1024)); \
        glds16(vbase_l + vo_, (unsigned)__builtin_amdgcn_readfirstlane(lds0 + L_V + slot_ * SLOTB + wid * 1024)); \
        if (MODE == 1) glds4((const unsigned*)(brow_dma + (t) * 32) + (lane & 1), (unsigned)__builtin_amdgcn_readfirstlane(lds0 + L_M + slot_ * 2048 + wid * 256)); } while (0)
    asm volatile("s_waitcnt vmcnt(0)" ::: "memory");
    ISSUE2(0); ISSUE2(1); ISSUE2(2);
    bf16x8 qr[2][4];
#pragma unroll
    for (int g = 0; g < 2; ++g) { const bf16_t* qrow = P + p_off(rowbase + qpos[g], (MODE == 0) ? (C_AQ + 64 * hsel) : (C_BQ + 64 * (2 * hsel + g)));
#pragma unroll
        for (int d0 = 0; d0 < 4; ++d0) qr[g][d0] = *(const bf16x8*)(qrow + p_col(d0 * 16 + hi * 8)); }
    unsigned sel[2] = {0u, 0u};
    if (MODE == 0) {
        LAS float* km = (LAS float*)(lds + L_KM);
        if (wid < 2 * blk + 1) {
            const int c = lane & 7, rg = lane >> 3; float a[8];
#pragma unroll
            for (int e = 0; e < 8; ++e) a[e] = 0.f;
            const bf16_t* kp = P + p_off(rowbase + 256 * wid + rg, C_AK + 64 * hsel + 8 * c);
#pragma unroll 8
            for (int i = 0; i < 32; ++i) { const bf16x8 v = *(const bf16x8*)(kp + (size_t)(i >> 1) * PBLK * 512 + (size_t)(i & 1) * 256);
#pragma unroll
                for (int e = 0; e < 8; ++e) a[e] += bf2f(v[e]); }
#pragma unroll
            for (int e = 0; e < 8; ++e) { a[e] += shfl_xor_l(a[e], 8, lane); a[e] += shfl_xor_l(a[e], 16, lane); a[e] += shfl_xor_l(a[e], 32, lane); }
            if (rg == 0) {
#pragma unroll
                for (int e = 0; e < 8; ++e) km[wid * 64 + 8 * c + e] = a[e] * (1.f / 256.f);
            }
        }
        __syncthreads();
#pragma unroll
        for (int g = 0; g < 2; ++g) {
            const int nb = 2 * blk + g;
            float gt[7];
#pragma unroll
            for (int j = 0; j < 7; ++j) {
                float part = 0.f;
                if (j < nb) {
#pragma unroll
                    for (int d0 = 0; d0 < 4; ++d0) { const f32x4 k0 = *(const LAS f32x4*)(km + j * 64 + 16 * d0 + 8 * hi), k1 = *(const LAS f32x4*)(km + j * 64 + 16 * d0 + 8 * hi + 4);
#pragma unroll
                        for (int e = 0; e < 4; ++e) part += bf2f(qr[g][d0][e]) * k0[e] + bf2f(qr[g][d0][4 + e]) * k1[e]; }
                    part = swap_add(part);
                }
                gt[j] = (j < nb) ? part : NEG;
            }
            unsigned s_ = 0u;
#pragma unroll
            for (int rep = 0; rep < 3; ++rep) { float bv = NEG; int best = -1;
#pragma unroll
                for (int j = 0; j < 7; ++j) { const bool ok = (j < nb) && !((s_ >> j) & 1u) && (gt[j] > bv); if (ok) { bv = gt[j]; best = j; } }
                if (best >= 0) s_ |= 1u << best; }
            sel[g] = s_;
        }
    }
    f32x16 o0[2], o1[2]; float m_run[2], l_run[2], mx_run[2]; bool shifted[2];
#pragma unroll
    for (int g = 0; g < 2; ++g) { o0[g] = (f32x16){}; o1[g] = (f32x16){}; m_run[g] = 0.f; l_run[g] = 0.f; mx_run[g] = NEG; shifted[g] = false; }
    constexpr float SHIFT_THR = 64.f;
    const lds_cptr lds3 = (lds_cptr)lds;
    const lds_cptr kp0 = lds3 + L_K + hi * 1024 + r32 * 16;
    const lds_cptr vp0 = lds3 + L_V + ((lane >> 4) & 1) * 32 + (lane & 3) * 8 + (4 * hi + ((lane & 15) >> 2)) * 64;
    const lds_cptr mp0 = lds3 + L_M + (32 * wid + r32) * 8;
#pragma unroll
    for (int g = 0; g < 2; ++g)
#pragma unroll
        for (int d0 = 0; d0 < 4; ++d0) asm volatile("" : "+v"(qr[g][d0]));
    if (MODE == 1 && tid < 16) {
        f32x4 e; e[0] = (tid & 1) ? 0.f : NEG; e[1] = (tid & 2) ? 0.f : NEG; e[2] = (tid & 4) ? 0.f : NEG; e[3] = (tid & 8) ? 0.f : NEG;
        *(LAS f32x4*)(lds + L_LUT + 16 * tid) = e;
    }
    WAITBAR(0);
    if (wid < 4) __builtin_amdgcn_s_setprio(2); else __builtin_amdgcn_s_setprio(0);
    for (int t = 0; t < NT; ++t) {
        const int row0 = T2_ROW0(t);
        bool act[2];
        if (MODE == 0) {
            const int b = row0 >> 8;
#pragma unroll
            for (int g = 0; g < 2; ++g) { const int own = 2 * blk + g; act[g] = (b == own) ? (row0 <= qw0[g] + 31) : (b < own) ? (__any((sel[g] >> b) & 1u) != 0) : false; }
        } else { act[0] = act[1] = (row0 <= qw0[0] + 31); }
        const int slot = (t & (NSLOT - 1)) * SLOTB;
        u32x2 mw = {0u, 0u}; if (MODE == 1 && act[0]) mw = *(const LAS u32x2*)(mp0 + (t & (NSLOT - 1)) * 2048);
        if (t + 3 < NT) ISSUE2(t + 3);
#pragma unroll
        for (int g = 0; g < 2; ++g) {
          if (act[g]) {
            f32x16 p0 = {}, p1 = {};
            if (MODE == 1) {
                const unsigned lo = mw.x >> (4 * hi), hw = mw.y >> (4 * hi);
                const lds_cptr lut = lds3 + L_LUT;
#pragma unroll
                for (int k = 0; k < 4; ++k) {
                    const f32x4 b0 = *(const LAS f32x4*)(lut + (((lo >> (8 * k)) & 15u) << 4)), b1 = *(const LAS f32x4*)(lut + (((hw >> (8 * k)) & 15u) << 4));
#pragma unroll
                    for (int j = 0; j < 4; ++j) { p0[4 * k + j] = b0[j]; p1[4 * k + j] = b1[j]; }
                }
            }
            __builtin_amdgcn_sched_barrier(0);
            { const lds_cptr kp = kp0 + slot;
              bf16x8 ka[4], kb[4];
#pragma unroll
              for (int j = 0; j < 4; ++j) { ka[j] = *(const LAS bf16x8*)(kp + j * 2048); kb[j] = *(const LAS bf16x8*)(kp + j * 2048 + 512); }
              p0 = __builtin_amdgcn_mfma_f32_32x32x16_bf16(ka[0], qr[g][0], p0, 0, 0, 0);
              p1 = __builtin_amdgcn_mfma_f32_32x32x16_bf16(kb[0], qr[g][0], p1, 0, 0, 0);
#pragma unroll
              for (int d0 = 1; d0 < 4; ++d0) { p0 = __builtin_amdgcn_mfma_f32_32x32x16_bf16(ka[d0], qr[g][d0], p0, 0, 0, 0); p1 = __builtin_amdgcn_mfma_f32_32x32x16_bf16(kb[d0], qr[g][d0], p1, 0, 0, 0); } }
            __builtin_amdgcn_sched_group_barrier(0x100, 4, 0);
#pragma unroll
            for (int i = 0; i < 4; ++i) { __builtin_amdgcn_sched_group_barrier(0x008, 1, 0); __builtin_amdgcn_sched_group_barrier(0x100, 1, 0); }
            __builtin_amdgcn_sched_group_barrier(0x008, 4, 0);
            __builtin_amdgcn_sched_barrier(0);
            s16x4 vl0[4], vh0[4];
            { const lds_cptr vp = vp0 + slot;
#pragma unroll
              for (int ks = 0; ks < 4; ++ks) { vl0[ks] = vtr(vp + ks * 1024); vh0[ks] = vtr(vp + ks * 1024 + 512); } }
            __builtin_amdgcn_sched_barrier(0);
            if (shifted[g]) {
#pragma unroll
                for (int r = 0; r < 16; ++r) { p0[r] -= m_run[g]; p1[r] -= m_run[g]; } }
            if (MODE == 0) {
                if ((row0 >> 8) == 2 * blk + g) { if (row0 + 63 > qw0[g]) { const int kb_ = row0 + 4 * hi;
#pragma unroll
                    for (int r = 0; r < 16; ++r) { const int kv = kb_ + (r & 3) + 8 * (r >> 2); if (kv > qpos[g]) p0[r] = NEG; if (kv + 32 > qpos[g]) p1[r] = NEG; } } }
                else { if (!((sel[g] >> (row0 >> 8)) & 1u)) { float ng = NEG; asm volatile("" : "+v"(ng));
#pragma unroll
                    for (int r = 0; r < 16; ++r) { p0[r] = ng; p1[r] = ng; } } }
            }
            asm volatile("s_nop 11" : "+v"(p0), "+v"(p1));
            float ma = fmax3_s(p0[0], p0[1], p1[0]), mb = fmax3_s(p0[2], p0[3], p1[1]);
            ma = fmax3_s(ma, p1[2], p1[3]);
#pragma unroll
            for (int r = 4; r < 16; r += 4) { ma = fmax3_s(ma, p0[r], p0[r + 1]); mb = fmax3_s(mb, p0[r + 2], p0[r + 3]);
                ma = fmax3_s(ma, p1[r], p1[r + 1]); mb = fmax3_s(mb, p1[r + 2], p1[r + 3]); }
            const float rm = swap_max(__builtin_fmaxf(ma, mb));
            const bool up = rm > SHIFT_THR, down = (mx_run[g] == NEG) && (rm < -SHIFT_THR) && (rm != NEG);
            if (__any(up || down)) {
                const float dl = (up || down) ? rm : 0.f; m_run[g] += dl; shifted[g] = true;
                const float f = __builtin_amdgcn_exp2f(-dl); l_run[g] *= f;
#pragma unroll
                for (int r = 0; r < 16; ++r) { p0[r] -= dl; p1[r] -= dl; o0[g][r] *= f; o1[g][r] *= f; }
                mx_run[g] = __builtin_fmaxf(mx_run[g], rm);
            } else mx_run[g] = __builtin_fmaxf(mx_run[g], rm);
            float ls0 = 0.f, ls1 = 0.f;
#pragma unroll
            for (int r = 0; r < 16; ++r) { p0[r] = __builtin_amdgcn_exp2f(p0[r]); p1[r] = __builtin_amdgcn_exp2f(p1[r]); }
            asm volatile("" : "+v"(p0), "+v"(p1));
#pragma unroll
            for (int r = 0; r < 16; ++r) { ls0 = fadd_s(ls0, p0[r]); ls1 = fadd_s(ls1, p1[r]); }
            l_run[g] = fadd_s(l_run[g], fadd_s(ls0, ls1));
            u32x4 pw[4];
            pw[0] = (u32x4){cvtpk(p0[0], p0[1]), cvtpk(p0[2], p0[3]), cvtpk(p0[4], p0[5]), cvtpk(p0[6], p0[7])};
            pw[1] = (u32x4){cvtpk(p0[8], p0[9]), cvtpk(p0[10], p0[11]), cvtpk(p0[12], p0[13]), cvtpk(p0[14], p0[15])};
            pw[2] = (u32x4){cvtpk(p1[0], p1[1]), cvtpk(p1[2], p1[3]), cvtpk(p1[4], p1[5]), cvtpk(p1[6], p1[7])};
            pw[3] = (u32x4){cvtpk(p1[8], p1[9]), cvtpk(p1[10], p1[11]), cvtpk(p1[12], p1[13]), cvtpk(p1[14], p1[15])};
            __builtin_amdgcn_sched_barrier(0);
            { const lds_cptr vp = vp0 + slot + 4096;
              s16x4 vl1[4], vh1[4];
#pragma unroll
              for (int ks = 0; ks < 4; ++ks) { vl1[ks] = vtr(vp + ks * 1024); vh1[ks] = vtr(vp + ks * 1024 + 512); }
#pragma unroll
              for (int ks = 0; ks < 4; ++ks) { const bf16x8 vf = (bf16x8){vl0[ks][0], vl0[ks][1], vl0[ks][2], vl0[ks][3], vh0[ks][0], vh0[ks][1], vh0[ks][2], vh0[ks][3]};
                  o0[g] = __builtin_amdgcn_mfma_f32_32x32x16_bf16(vf, __builtin_bit_cast(bf16x8, pw[ks]), o0[g], 0, 0, 0); }
#pragma unroll
              for (int ks = 0; ks < 4; ++ks) { const bf16x8 vf = (bf16x8){vl1[ks][0], vl1[ks][1], vl1[ks][2], vl1[ks][3], vh1[ks][0], vh1[ks][1], vh1[ks][2], vh1[ks][3]};
                  o1[g] = __builtin_amdgcn_mfma_f32_32x32x16_bf16(vf, __builtin_bit_cast(bf16x8, pw[ks]), o1[g], 0, 0, 0); } }
#pragma unroll
            for (int i = 0; i < 4; ++i) { __builtin_amdgcn_sched_group_barrier(0x100, 2, 0); __builtin_amdgcn_sched_group_barrier(0x008, 1, 0); }
            __builtin_amdgcn_sched_group_barrier(0x008, 4, 0);
            __builtin_amdgcn_sched_barrier(0);
          }
          __builtin_amdgcn_sched_barrier(0);
        }
        const int ahead = NT - 2 - t;
        if (MODE == 1) { if (ahead >= 2) WAITBAR(6); else if (ahead == 1) WAITBAR(3); else WAITBAR(0); }
        else           { if (ahead >= 2) WAITBAR(4); else if (ahead == 1) WAITBAR(2); else WAITBAR(0); }
    }
    __builtin_amdgcn_s_setprio(0);
#pragma unroll
    for (int g = 0; g < 2; ++g) {
        const int head = (MODE == 0) ? hsel : 2 * hsel + g;
        const float inv = 1.f / swap_add(l_run[g]);
        const bf16_t* grow = P + p_off(rowbase + qpos[g], C_GA + ((MODE == 0) ? 0 : 384) + 64 * head);
        const int yr_ = rowbase + qpos[g], yc_ = ((MODE == 0) ? 0 : 512) + 64 * head;
#pragma unroll
        for (int d0 = 0; d0 < 2; ++d0)
#pragma unroll
            for (int g4 = 0; g4 < 4; ++g4) {
                const int dim = 32 * d0 + 8 * g4 + 4 * hi;
                const s16x4 gt = *(const s16x4*)(grow + p_col(dim));
                float v[4];
#pragma unroll
                for (int e = 0; e < 4; ++e) v[e] = (d0 == 0 ? o0[g][4 * g4 + e] : o1[g][4 * g4 + e]) * inv * bf2f(gt[e]);
                *(unsigned*)((unsigned char*)Y + g_off(yr_, yc_ + dim, YP)) = pk4_fp8(v[0] * F8_SY, v[1] * F8_SY, v[2] * F8_SY, v[3] * F8_SY);
            }
        if (head == 5) {
#pragma unroll
            for (int j = 0; j < 4; ++j) *(u32x4*)((unsigned char*)Y + g_off(yr_, yc_ + 64 + 64 * hi + 16 * j, YP)) = (u32x4){0u, 0u, 0u, 0u};
        }
    }
#undef T2_ROW0
#undef ISSUE2
}

__device__ __forceinline__ unsigned f2key(float f) { unsigned u = __float_as_uint(f); if (u == 0x80000000u) u = 0u; return (u & 0x80000000u) ? ~u : (u | 0x80000000u); }
__device__ __forceinline__ float key2f(unsigned k) { const unsigned u = (k & 0x80000000u) ? (k & 0x7fffffffu) : ~k; return __uint_as_float(u); }
__device__ __forceinline__ unsigned wave_sum_dpp(unsigned x) {
    x += (unsigned)__builtin_amdgcn_update_dpp(0, (int)x, 0xB1, 0xf, 0xf, false);
    x += (unsigned)__builtin_amdgcn_update_dpp(0, (int)x, 0x4E, 0xf, 0xf, false);
    x += (unsigned)__builtin_amdgcn_update_dpp(0, (int)x, 0x141, 0xf, 0xf, false);
    x += (unsigned)__builtin_amdgcn_update_dpp(0, (int)x, 0x140, 0xf, 0xf, false);
    x += (unsigned)__builtin_amdgcn_update_dpp(0, (int)x, 0x142, 0xa, 0xf, false);
    x += (unsigned)__builtin_amdgcn_update_dpp(0, (int)x, 0x143, 0xc, 0xf, false);
    return (unsigned)__builtin_amdgcn_readlane((int)x, 63);
}
__device__ __forceinline__ void cnt4(unsigned& na, unsigned& nb, unsigned ka0, unsigned ka1, unsigned kb0, unsigned kb1, unsigned ca, unsigned cb) {
    u64 t1, t2, t3;
    asm("v_cmp_ge_u32_e64 vcc, %[ka0], %[ca]\n\t"
        "v_cmp_ge_u32_e64 %[t1], %[kb0], %[cb]\n\t"
        "v_cmp_ge_u32_e64 %[t2], %[ka1], %[ca]\n\t"
        "v_cmp_ge_u32_e64 %[t3], %[kb1], %[cb]\n\t"
        "v_addc_co_u32_e64 %[na], vcc, 0, %[na], vcc\n\t"
        "v_addc_co_u32_e64 %[nb], %[t1], 0, %[nb], %[t1]\n\t"
        "v_addc_co_u32_e64 %[na], %[t2], 0, %[na], %[t2]\n\t"
        "v_addc_co_u32_e64 %[nb], %[t3], 0, %[nb], %[t3]"
        : [na] "+v"(na), [nb] "+v"(nb), [t1] "=&s"(t1), [t2] "=&s"(t2), [t3] "=&s"(t3)
        : [ka0] "v"(ka0), [ka1] "v"(ka1), [kb0] "v"(kb0), [kb1] "v"(kb1), [ca] "v"(ca), [cb] "v"(cb)
        : "vcc");
}
template <int NREG> __device__ __forceinline__ int count_ge(const unsigned (&key)[32], unsigned cand) {
    unsigned cnt = 0u;
#pragma unroll
    for (int i = 0; i < NREG; ++i) cnt += (key[i] >= cand) ? 1u : 0u;
    int tot = 0;
#pragma unroll
    for (int b = 0; b < 6; ++b) tot += __popcll(__ballot((cnt >> b) & 1u)) << b;
    return tot;
}
template <int NREG> __device__ __forceinline__ void select_unit(LAS unsigned char* lds, const bf16_t* __restrict__ P, const float* __restrict__ IW, u64* __restrict__ bits, int rowbase, int q16, int wave) {
    wave = opaque_wave(wave);
    const int tid = opaque_tid(wave), lane = tid & 63; const int wid = wave;
    const int t0 = 16 * q16, ngroups = q16 + 1;
    const int qi = lane & 15, kq = lane >> 4;
    LAS float* sc = (LAS float*)lds;
    const bool triv = (NREG == 8) && (t0 + 16 <= 256);
    if (!triv) {
        bf16x8 bq[4][2]; float w[4];
        const bf16_t* qp = P + p_off(rowbase + t0 + qi, C_IQ + 8 * kq);
#pragma unroll
        for (int h = 0; h < 4; ++h) { bq[h][0] = *(const bf16x8*)(qp + p_col(64 * h)); bq[h][1] = *(const bf16x8*)(qp + p_col(64 * h + 32)); }
        { const f32x4 wv = *(const f32x4*)(IW + (size_t)(rowbase + t0 + qi) * 4); w[0] = wv[0]; w[1] = wv[1]; w[2] = wv[2]; w[3] = wv[3]; }
        const bf16_t* kbase = (const bf16_t*)((const char*)P - (WS_P - WS_IKC)) + (size_t)(rowbase + qi) * 32 + 8 * kq;
        constexpr int NG = NREG / 2;
        bf16x8 a[NG][2];
#pragma unroll
        for (int u = 0; u < NG; ++u) { int g = wid + 8 * u; g = g < ngroups ? g : ngroups - 1; const bf16_t* kp = kbase + (size_t)(16 * g) * 32; a[u][0] = *(const bf16x8*)kp; a[u][1] = *(const bf16x8*)(kp + (size_t)MC * 32); }
#pragma unroll
        for (int u = 0; u < NG; ++u) {
            const int g = wid + 8 * u;
            f32x4 s = {0.f, 0.f, 0.f, 0.f};
            f32x4 d[4];
#pragma unroll
            for (int h = 0; h < 4; ++h) {
                d[h] = (f32x4){0.f, 0.f, 0.f, 0.f};
                d[h] = __builtin_amdgcn_mfma_f32_16x16x32_bf16(a[u][0], bq[h][0], d[h], 0, 0, 0);
                d[h] = __builtin_amdgcn_mfma_f32_16x16x32_bf16(a[u][1], bq[h][1], d[h], 0, 0, 0);
            }
            asm volatile("s_nop 11" : "+v"(d[0]), "+v"(d[1]), "+v"(d[2]), "+v"(d[3]));
#pragma unroll
            for (int h = 0; h < 4; ++h)
#pragma unroll
                for (int e = 0; e < 4; ++e) { float r_; asm("v_max_f32_e32 %0, 0, %1" : "=v"(r_) : "v"(d[h][e])); float se = s[e]; asm("v_fmac_f32_e32 %0, %1, %2" : "+v"(se) : "v"(r_), "v"(w[h])); s[e] = se; }
            if (g < ngroups) *(LAS f32x4*)(sc + qi * SCORE_PITCH + 16 * g + 4 * kq) = s;
        }
    }
    __syncthreads();
    {
        const int qA = 2 * wid, tA = t0 + qA, tB = tA + 1;
        unsigned kA[32], kB[32];
#pragma unroll
        for (int i = 0; i < NREG; ++i) {
            const int idx = lane + 64 * i;
            const float va = sc[qA * SCORE_PITCH + idx], vb = sc[(qA + 1) * SCORE_PITCH + idx];
            const unsigned ka = triv ? 2u : f2key(va), kb = triv ? 2u : f2key(vb);
            kA[i] = (idx <= tA) ? ka : 0u; kB[i] = (idx <= tB) ? kb : 0u;
        }
        unsigned TA = 1u, TB = 1u; bool dA = (tA + 1 <= 256), dB = (tB + 1 <= 256);
        if (!dB) {
            TA = dA ? 1u : 0u; TB = 0u;
            for (int bit = 31; bit >= 0; --bit) {
                if (dA && dB) break;
                const unsigned cA = TA | (1u << bit), cB = TB | (1u << bit);
                unsigned ca = 0u, cb = 0u;
#pragma unroll
                for (int i = 0; i < NREG; i += 2) cnt4(ca, cb, kA[i], kA[i + 1], kB[i], kB[i + 1], cA, cB);
                const unsigned tot = wave_sum_dpp(ca | (cb << 16));
                const int nA = (int)(tot & 0xffffu), nB = (int)(tot >> 16);
                if (!dA) { if (nA >= 256) TA = cA; if (nA == 256) dA = true; }
                if (!dB) { if (nB >= 256) TB = cB; if (nB == 256) dB = true; }
            }
        }
        const u64 lt_mask = (lane == 0) ? 0ull : (~0ull >> (64 - lane));
#pragma unroll 1
        for (int rr = 0; rr < 2; ++rr) {
            const unsigned T = rr ? TB : TA; const int t = tA + rr;
            unsigned cge = 0u;
#pragma unroll
            for (int i = 0; i < NREG; ++i) { const unsigned kk_ = rr ? kB[i] : kA[i]; cge += (kk_ > T) ? 1u : 0u; cge += (kk_ == T) ? 0x10000u : 0u; }
            const unsigned tote = wave_sum_dpp(cge);
            const int cgt = (int)(tote & 0xffffu), ceq = (int)(tote >> 16);
            const int need = 256 - cgt;
            unsigned mine_lo = 0u, mine_hi = 0u;
            if (need <= 0 || need >= ceq) {
                const unsigned Tc = (need <= 0) ? T + 1u : T;
#define SEL_FAST(i) do { if ((i) < NREG) { const unsigned kk_ = rr ? kB[i] : kA[i]; const u64 wsel = __ballot(kk_ >= Tc); \
            const unsigned wl_ = (unsigned)wsel, wh_ = (unsigned)(wsel >> 32); \
            asm volatile("s_nop 1\n\tv_writelane_b32 %0, %2, " #i "\n\tv_writelane_b32 %1, %3, " #i : "+v"(mine_lo), "+v"(mine_hi) : "s"(wl_), "s"(wh_)); if (((i) & 3) == 3) __builtin_amdgcn_sched_barrier(0); } } while (0)
                SEL_FAST(0); SEL_FAST(1); SEL_FAST(2); SEL_FAST(3); SEL_FAST(4); SEL_FAST(5); SEL_FAST(6); SEL_FAST(7);
                SEL_FAST(8); SEL_FAST(9); SEL_FAST(10); SEL_FAST(11); SEL_FAST(12); SEL_FAST(13); SEL_FAST(14); SEL_FAST(15);
                SEL_FAST(16); SEL_FAST(17); SEL_FAST(18); SEL_FAST(19); SEL_FAST(20); SEL_FAST(21); SEL_FAST(22); SEL_FAST(23);
                SEL_FAST(24); SEL_FAST(25); SEL_FAST(26); SEL_FAST(27); SEL_FAST(28); SEL_FAST(29); SEL_FAST(30); SEL_FAST(31);
#undef SEL_FAST
            } else {
                int run = 0;
#define SEL_EMIT(i) do { if ((i) < NREG) { const unsigned kk_ = rr ? kB[i] : kA[i]; const bool eq = (kk_ == T) && (kk_ != 0u); const u64 beq = __ballot(eq); const int rank = run + __popcll(beq & lt_mask); \
            const bool s_ = (kk_ > T) || (eq && rank < need); const u64 wsel = __ballot(s_); run += __popcll(beq); \
            const unsigned wl_ = (unsigned)wsel, wh_ = (unsigned)(wsel >> 32); \
            asm volatile("s_nop 1\n\tv_writelane_b32 %0, %2, " #i "\n\tv_writelane_b32 %1, %3, " #i : "+v"(mine_lo), "+v"(mine_hi) : "s"(wl_), "s"(wh_)); if (((i) & 3) == 3) __builtin_amdgcn_sched_barrier(0); } } while (0)
                SEL_EMIT(0); SEL_EMIT(1); SEL_EMIT(2); SEL_EMIT(3); SEL_EMIT(4); SEL_EMIT(5); SEL_EMIT(6); SEL_EMIT(7);
                SEL_EMIT(8); SEL_EMIT(9); SEL_EMIT(10); SEL_EMIT(11); SEL_EMIT(12); SEL_EMIT(13); SEL_EMIT(14); SEL_EMIT(15);
                SEL_EMIT(16); SEL_EMIT(17); SEL_EMIT(18); SEL_EMIT(19); SEL_EMIT(20); SEL_EMIT(21); SEL_EMIT(22); SEL_EMIT(23);
                SEL_EMIT(24); SEL_EMIT(25); SEL_EMIT(26); SEL_EMIT(27); SEL_EMIT(28); SEL_EMIT(29); SEL_EMIT(30); SEL_EMIT(31);
#undef SEL_EMIT
            }
            if (lane < 32) bits[((size_t)((rowbase + t) >> 5) * 32 + lane) * 32 + ((rowbase + t) & 31)] = ((u64)mine_hi << 32) | (u64)mine_lo;
        }
    }
    __syncthreads();
}
}

struct Args { const float* x; const float* norm_g; const float* w_in; const float* w_br_a; const float* w_br_b; const float* w_br_c; const float* w_out; const float* final_g;
              float* out; unsigned char* ws; int ph_lo, ph_hi; };

constexpr int WI_IN = (DM / 64) * (C_F8 / 32), WI_IN8 = (DM / 64) * ((NW - C_F8) / 32), WI_BA = (384 / 64) * (DM / 32), WI_BC = (256 / 64) * (DM / 32), WI_O = (DM / 64) * (DM / 32);
constexpr int WPER_L = WI_IN + WI_IN8 + 2 * WI_BA + WI_BC + WI_O;
__device__ __forceinline__ void weight_item(const Args& args, bf16_t* WIN, bf16_t* WBR, bf16_t* WOUT, int l, int r, LAS float* scr, int lane_) {
    if (r < WI_IN) { transpose_item<true>(args.w_in + (size_t)l * DM * INW, INW, C_F8 / 32, WIN + (size_t)l * NW * DM, DM, 0, scr, r, lane_); return; } r -= WI_IN;
    if (r < WI_IN8) { transpose_item<true, true>(args.w_in + (size_t)l * DM * INW, INW, (NW - C_F8) / 32, WIN + (size_t)l * NW * DM + (size_t)C_F8 * DM, DM, 0, scr, r, lane_, C_F8, C_F8); return; } r -= WI_IN8;
    if (r < WI_BA) { transpose_item<false, true>(args.w_br_a + (size_t)l * 384 * DM, DM, DM / 32, WBR + (size_t)l * DM * DM, YP, 0, scr, r, lane_); return; } r -= WI_BA;
    if (r < WI_BA) { transpose_item<false, true>(args.w_br_b + (size_t)l * 384 * DM, DM, DM / 32, WBR + (size_t)l * DM * DM, YP, 512, scr, r, lane_); return; } r -= WI_BA;
    if (r < WI_BC) { transpose_item<false, true>(args.w_br_c + (size_t)l * 256 * DM, DM, DM / 32, WBR + (size_t)l * DM * DM, YP, 1024, scr, r, lane_); return; } r -= WI_BC;
    transpose_item<false, true>(args.w_out + (size_t)l * DM * DM, DM, DM / 32, WOUT + (size_t)l * DM * DM, DM, 0, scr, r, lane_);
}

__device__ __forceinline__ bool attn_work(int idx, int& mode, int& level, int& sub) {
    int r = idx;
#define AW(m_, l_) do { const int cnt = ((m_) == 2) ? 32 : ((m_) == 1) ? 24 : 48; if (r < cnt) { mode = (m_); level = (l_); sub = r; return true; } r -= cnt; } while (0)
    AW(1, 7); AW(0, 3); AW(1, 6); AW(1, 5); AW(0, 2); AW(1, 4); AW(1, 3); AW(0, 1); AW(1, 2); AW(1, 1); AW(0, 0); AW(1, 0);
    AW(2, 7); AW(2, 6); AW(2, 5); AW(2, 4); AW(2, 3); AW(2, 2); AW(2, 1); AW(2, 0);
#undef AW
    return false;
}

__global__ void __launch_bounds__(NWAVES * 64, 2) mega_fwd(Args args) {
    extern __shared__ __attribute__((aligned(16))) unsigned char lds_raw[];
    Frame F;
    F.lds = (LAS unsigned char*)lds_raw;
    F.MISC = (volatile LAS unsigned*)(F.lds + MISC_OFF);
    F.tid = threadIdx.x; F.lane = F.tid & 63; F.wave = __builtin_amdgcn_readfirstlane(F.tid >> 6);
    F.G = gridDim.x;
    unsigned char* ws = args.ws;
    F.ctl = (gu32*)(ws + WS_CTL);
    for (int u = F.tid; u < (LDS_BYTES - LDSCTL_OFF) / 4; u += NWAVES * 64) ((LAS unsigned*)(F.lds + LDSCTL_OFF))[u] = 0u;
    __syncthreads();
    XcdBarrier bar; bar.bar = (unsigned*)(F.ctl + CW_BAR); bar.x = 0; bar.st = nullptr;
    if (MK_N_LAUNCHES == 1) bar = xcd_barrier_post((unsigned*)(F.ctl + CW_BAR), F.MISC + 8);
#define GRID_BAR() do { if (MK_N_LAUNCHES == 1) xcd_barrier<false>(bar, F.wave); } while (0)
#define GRID_BAR_FIRST() do { if (MK_N_LAUNCHES == 1) xcd_barrier<true>(bar, F.wave); } while (0)
    const int lo = args.ph_lo, hi = args.ph_hi;
#define IN(k) (lo <= (k) && (k) < hi)
#define BOTH(k) (IN(k) && IN((k) + 1))

#define WSPTRS() unsigned char* wsl = launder(args.ws); float* cosT = (float*)(wsl + WS_ROPE); float* sinT = cosT + SEQ * 32; float* IWb = (float*)(wsl + WS_IW); unsigned char* H8b = wsl + WS_H8; \
    bf16_t* WIN = (bf16_t*)(wsl + WS_WIN); bf16_t* WBR = (bf16_t*)(wsl + WS_WBR); bf16_t* WOUT = (bf16_t*)(wsl + WS_WOUT); u64* BITS = (u64*)(wsl + WS_BITS); \
    bf16_t* Hb = (bf16_t*)(wsl + WS_H); bf16_t* Hb1 = (bf16_t*)(wsl + WS_H1); float* POb = (float*)(wsl + WS_PO); float* PMLb = (float*)(wsl + WS_PML); bf16_t* Yb = (bf16_t*)(wsl + WS_Y); bf16_t* MGb = (bf16_t*)(wsl + WS_MERGED); bf16_t* Pb = (bf16_t*)(wsl + WS_P); unsigned char* MG8b = wsl + WS_MG8; \
    gu32* ctl = (gu32*)(wsl + WS_CTL); \
    (void)cosT; (void)sinT; (void)IWb; (void)H8b; (void)WIN; (void)WBR; (void)WOUT; (void)BITS; (void)Hb; (void)Hb1; (void)POb; (void)PMLb; (void)Yb; (void)MGb; (void)Pb; (void)MG8b; (void)ctl
    const int NGW = F.G * NWAVES;
#define PHASE_IDS() const int wave_ = opaque_wave(F.wave); const int tid_ = opaque_tid(wave_); const int lane_ = tid_ & 63; const int gw = blockIdx.x * NWAVES + wave_; (void)lane_; (void)gw

    if (EN(0)) {
        WSPTRS(); PHASE_IDS();
        LAS float* scr = (LAS float*)(F.lds + wave_ * 16384);
        for (int it = gw; it < WPER_L; it += NGW) weight_item(args, WIN, WBR, WOUT, 0, it, scr, lane_);
        for (int e = blockIdx.x * (NWAVES * 64) + tid_; e < DEPTH * DM * 16; e += F.G * NWAVES * 64) {
            const int l = e / (DM * 16), n = (e / 16) % DM, j = e % 16;
            *(u32x4*)((unsigned char*)(WBR + (size_t)l * DM * DM) + (size_t)n * YP + (j < 8 ? 384 : 896 - 128) + 16 * j) = (u32x4){0u, 0u, 0u, 0u};
        }
        for (int e = blockIdx.x * (NWAVES * 64) + tid_; e < SEQ * 32; e += F.G * NWAVES * 64) {
            const int t = e >> 5, f = e & 31;
            const float inv_freq = 1.0f / powf(10000.0f, (float)(2 * f) / 64.0f);
            const float ang = (float)t * inv_freq;
            const double rev = (double)ang * 0.15915494309189535;
            const float fr = (float)(rev - __builtin_rint(rev));
            cosT[e] = __builtin_amdgcn_cosf(fr); sinT[e] = __builtin_amdgcn_sinf(fr);
        }
        for (int m = 4 * gw; m < BATCH * SEQ; m += 4 * NGW) rms_rows<true, 4>(args.x + (size_t)m * DM, args.norm_g, (m < MC ? Hb + (size_t)m * DM : Hb1 + (size_t)(m - MC) * DM), H8b + (size_t)m * DM, IWb + (size_t)m * 4, args.w_in + 2752, lane_);
    }
    GRID_BAR_FIRST();

#pragma nounroll
    for (int lcx = -1; lcx < DEPTH * NCH; ++lcx) {
        if (lcx >= 0) {
            const int lc = lcx;
            const int l = lc / NCH, c = lc % NCH;
            const float* xin = ((l == 0) ? args.x : (const float*)args.out) + (size_t)c * MC * DM;
            float* xout = args.out + (size_t)c * MC * DM;
            if (EN(3)) for (int rep = 0; rep < NREP(3); ++rep) {
                WSPTRS();
                gu32* qc = ctl + CW_Q + 64 * (((l * NCH + c) * 2 + 0) * 4 + rep);
                for (int nq = 0;; ++nq) {
                    __syncthreads();
                    if (opaque_tid(F.wave) == 0) F.MISC[0] = (nq == 0) ? (unsigned)blockIdx.x : (unsigned)F.G + __hip_atomic_fetch_add(qc, 1u, RLX_AGENT);
                    __syncthreads();
                    const int idx = (int)F.MISC[0];
                    constexpr int NSEL = BPC * 128, NG2 = 2 * BPC * 4 * 8;
                    if (idx >= NSEL + NG2 + ((rep == 0) ? (lc > 0 ? MC / 64 : WPER_L / 8) : 0)) break;
                    if (idx >= NSEL && idx < NSEL + NG2) { const int j = idx - NSEL;
                        if (j < NG2 / 2) att::attn_unit<4>(F.lds, Pb, Yb, BITS, POb, PMLb, ((j >> 5) & 7) * SEQ, (j >> 3) & 3, 7 - (j & 7), F.wave);
                        else att::attn_unit<3>(F.lds, Pb, Yb, BITS, POb, PMLb, ((j >> 5) & 7) * SEQ, (j >> 3) & 3, j & 7, F.wave);
                        continue; }
                    if (idx >= NSEL + NG2) {
                        PHASE_IDS();
                        if (lc == 0) {
                            static_assert(WPER_L % 8 == 0, "weight items per layer");
                            weight_item(args, WIN, WBR, WOUT, 1, (idx - NSEL - NG2) * 8 + wave_, (LAS float*)(F.lds + wave_ * 16384), lane_);
                            continue;
                        }
                        const int r0 = (idx - NSEL - NG2) * 64 + wave_ * 8;
                        if (lc == 3) { for (int j = 0; j < 8; j += 4) rms_rows<false, 4>(args.out + (size_t)(r0 + j) * DM, args.final_g, args.out + (size_t)(r0 + j) * DM, nullptr, nullptr, nullptr, lane_); }
                        else { const float* src = args.out + (size_t)(lc - 1) * MC * DM; bf16_t* dst = (lc == 1) ? Hb : Hb1;
                            for (int j = 0; j < 8; j += 4) rms_rows<true, 4>(src + (size_t)(r0 + j) * DM, args.norm_g + DM, dst + (size_t)(r0 + j) * DM, H8b + ((size_t)(lc - 1) * MC + r0 + j) * DM, IWb + ((size_t)(lc - 1) * MC + r0 + j) * 4, args.w_in + (size_t)DM * INW + 2752, lane_); }
                        continue;
                    }
                    const int q16 = 127 - (idx >> 3), b = idx & 7;
                    if (q16 < 32) att::select_unit<8>(F.lds, Pb, IWb + (size_t)c * MC * 4, BITS, b * SEQ, q16, F.wave);
                    else if (q16 < 48) att::select_unit<12>(F.lds, Pb, IWb + (size_t)c * MC * 4, BITS, b * SEQ, q16, F.wave);
                    else if (q16 < 64) att::select_unit<16>(F.lds, Pb, IWb + (size_t)c * MC * 4, BITS, b * SEQ, q16, F.wave);
                    else if (q16 < 80) att::select_unit<20>(F.lds, Pb, IWb + (size_t)c * MC * 4, BITS, b * SEQ, q16, F.wave);
                    else if (q16 < 96) att::select_unit<24>(F.lds, Pb, IWb + (size_t)c * MC * 4, BITS, b * SEQ, q16, F.wave);
                    else if (q16 < 112) att::select_unit<28>(F.lds, Pb, IWb + (size_t)c * MC * 4, BITS, b * SEQ, q16, F.wave);
                    else att::select_unit<32>(F.lds, Pb, IWb + (size_t)c * MC * 4, BITS, b * SEQ, q16, F.wave);
                }
                GRID_BAR();
            }
            if (EN(4)) for (int rep = 0; rep < NREP(4); ++rep) {
                WSPTRS();
                gu32* qc = ctl + CW_Q + 64 * (((l * NCH + c) * 2 + 1) * 4 + rep);
                {
                    pg8::Gemm g{(const bf16_t*)(H8b + (size_t)c * MC * DM), WIN + (size_t)l * NW * DM + (size_t)C_F8 * DM}; pg8::TailOrder S; S.init(DM, F.G, (int)blockIdx.x); S.nt = DM / 128;
                    pg8::EpiProj E{Pb, MG8b, cosT, sinT, C_F8, 1.f / (F8_SA * F8_SB)};
                    pg8::gemm_phase<pg8::EpiProj, pg8::TailOrder, true>(F.lds, g, S, E, F.wave);
                }
                for (int nq = 0;; ++nq) {
                    __syncthreads();
                    if (opaque_tid(F.wave) == 0) F.MISC[0] = (nq == 0) ? (unsigned)((blockIdx.x + F.G - 64) % F.G) : (unsigned)F.G + __hip_atomic_fetch_add(qc, 1u, RLX_AGENT);
                    __syncthreads();
                    const int idx = (int)F.MISC[0];
                    int mode, level, sub;
                    if (!attn_work(idx, mode, level, sub)) break;
                    if (mode == 0) att::attn_unit2<0>(F.lds, Pb, Yb, BITS, (sub / 6) * SEQ, sub % 6, level, F.wave);
                    else if (mode == 1) att::attn_unit2<1>(F.lds, Pb, Yb, BITS, (sub / 3) * SEQ, sub % 3, level, F.wave);
                    else att::attn_unit<2>(F.lds, Pb, Yb, BITS, POb, PMLb, (sub >> 2) * SEQ, sub & 3, level, F.wave);
                }
                GRID_BAR();
            }
            if (EN(5)) for (int rep = 0; rep < NREP(5); ++rep) {
                WSPTRS();
                pg8::Gemm g{Yb, WBR + (size_t)l * DM * DM}; pg8::BranchOrder S; S.so.init(MC, DM, DM, F.G, (int)blockIdx.x);
                pg8::EpiMerge E{MG8b, MGb, 1.f / (F8_SY * F8_SB)};
                pg8::gemm_phase<pg8::EpiMerge, pg8::BranchOrder, true, YP, true>(F.lds, g, S, E, F.wave);
                GRID_BAR();
            }
            if (EN(6)) {
                WSPTRS();
                pg8::Gemm g{MGb, WOUT + (size_t)l * DM * DM}; pg8::StaticOrder S; S.init(MC, DM, DM, F.G, (int)blockIdx.x); S.nt = DM / 128;
                pg8::EpiResid E{xin, xout, 1.f / (F8_SM * F8_SB)};
                pg8::gemm_phase<pg8::EpiResid, pg8::StaticOrder, true, pg8::LD, true>(F.lds, g, S, E, F.wave);
            }
        }
        if (lcx + 1 < DEPTH * NCH) {
            const int lc = lcx + 1;
            const int l = lc / NCH, c = lc % NCH;
            if (EN(2)) for (int rep = 0; rep < NREP(2); ++rep) {
                WSPTRS();
                {
                    pg8::Gemm g{c ? Hb1 : Hb, WIN + (size_t)l * NW * DM}; pg8::StaticOrder S; S.init(MC, C_F8, DM, F.G, (int)blockIdx.x);
                    pg8::EpiProj E{Pb, MG8b, cosT, sinT, 0, 1.f};
                    pg8::gemm_phase<pg8::EpiProj, pg8::StaticOrder, false>(F.lds, g, S, E, F.wave);
                }
                {
                    pg8::Gemm g{(const bf16_t*)(H8b + (size_t)c * MC * DM), WIN + (size_t)l * NW * DM + (size_t)C_F8 * DM}; pg8::StaticOrder S; S.init(MC, NW_MAIN - C_F8, DM, F.G, (int)blockIdx.x); S.nt = DM / 128;
                    pg8::EpiProj E{Pb, MG8b, cosT, sinT, C_F8, 1.f / (F8_SA * F8_SB)};
                    pg8::gemm_phase<pg8::EpiProj, pg8::StaticOrder, true>(F.lds, g, S, E, F.wave);
                }
            }
        }
        GRID_BAR();
    }
    if (EN(7)) {
        PHASE_IDS();
        for (int m = MC + 4 * gw; m < BATCH * SEQ; m += 4 * NGW) rms_rows<false, 4>(args.out + (size_t)m * DM, args.final_g, args.out + (size_t)m * DM, nullptr, nullptr, nullptr, lane_);
    }
#undef IN
#undef BOTH
#undef GRID_BAR
}

extern "C" void kernel_launch(void* const* d_in, const int* in_sizes, int n_in, void* d_out, int out_size, void* d_ws, size_t ws_size, hipStream_t stream) {
    static int grid = 0;
    if (grid == 0) {
        if (n_in != 8 || in_sizes[0] != BATCH * SEQ * DM || out_size != BATCH * SEQ * DM || ws_size < WS_END) {
            fprintf(stderr, "kernel_launch: unexpected shapes / workspace (n_in %d, in0 %d, out %d, ws %zu, need %zu); nothing launched\n", n_in, n_in > 0 ? in_sizes[0] : -1, out_size, ws_size, (size_t)WS_END);
            grid = -1; return; }
        int dev = 0, cus = 0, per_cu = 0;
        if (hipGetDevice(&dev) != hipSuccess || hipDeviceGetAttribute(&cus, hipDeviceAttributeMultiprocessorCount, dev) != hipSuccess) { grid = -1; return; }
        if (hipFuncSetAttribute((const void*)mega_fwd, hipFuncAttributeMaxDynamicSharedMemorySize, LDS_BYTES) != hipSuccess) { fprintf(stderr, "kernel_launch: hipFuncSetAttribute failed\n"); grid = -1; return; }
        if (hipOccupancyMaxActiveBlocksPerMultiprocessor(&per_cu, (const void*)mega_fwd, NWAVES * 64, LDS_BYTES) != hipSuccess || per_cu < 1)
            fprintf(stderr, "kernel_launch: note: occupancy query reports %d workgroups per CU\n", per_cu);
        (void)hipGetLastError();
        grid = cus;
    }
    if (grid < 0) return;
    if (hipMemsetAsync((char*)d_ws + WS_CTL, 0, CTL_ZERO_BYTES, stream) != hipSuccess) return;
    Args a{};
    a.x = (const float*)d_in[0]; a.norm_g = (const float*)d_in[1]; a.w_in = (const float*)d_in[2]; a.w_br_a = (const float*)d_in[3];
    a.w_br_b = (const float*)d_in[4]; a.w_br_c = (const float*)d_in[5]; a.w_out = (const float*)d_in[6]; a.final_g = (const float*)d_in[7];
    a.out = (float*)d_out; a.ws = (unsigned char*)d_ws;
    if (MK_N_LAUNCHES == 1) {
        a.ph_lo = 0; a.ph_hi = NPHASES;
        hipLaunchKernelGGL(mega_fwd, dim3(grid), dim3(NWAVES * 64), LDS_BYTES, stream, a);
    } else {
        for (int p = 0; p < NPHASES; ++p) { a.ph_lo = p; a.ph_hi = p + 1; hipLaunchKernelGGL(mega_fwd, dim3(grid), dim3(NWAVES * 64), LDS_BYTES, stream, a); }
    }
}
```

```cpp
#include <hip/hip_runtime.h>
#include <cstdio>
#include <cstdint>

#ifndef MK_N_LAUNCHES
#define MK_N_LAUNCHES 1
#endif

#ifndef EN_MASK
#define EN_MASK 0xFF
#endif
#define EN(k) (((EN_MASK) >> (k)) & 1)
#ifndef REP_KIND
#define REP_KIND -1
#endif
#ifndef REP_N
#define REP_N 2
#endif
#define NREP(k) (((k) == (REP_KIND)) ? (REP_N) : 1)
#define GAS __attribute__((address_space(1)))
#define LAS __attribute__((address_space(3)))
typedef unsigned short bf16_t;
typedef short bf16x8 __attribute__((ext_vector_type(8)));
typedef short s16x4 __attribute__((ext_vector_type(4)));
typedef float f32x4 __attribute__((ext_vector_type(4)));
typedef float f32x2 __attribute__((ext_vector_type(2)));
typedef float f32x16 __attribute__((ext_vector_type(16)));
typedef unsigned u32x4 __attribute__((ext_vector_type(4)));
typedef unsigned u32x2 __attribute__((ext_vector_type(2)));
typedef GAS unsigned gu32;
typedef unsigned long long u64;

constexpr int BATCH = 16, SEQ = 2048, DM = 1024, DEPTH = 2;
constexpr int NCH = 2, BPC = BATCH / NCH, MC = BPC * SEQ;
constexpr int INW = 8388;
constexpr int NW = 8448;
constexpr int C_AQ = 0, C_IQ = 384, C_IK = 640, C_BK = 704, C_AK = 768, C_BQ = 1152, C_CQ = 1536, C_CK = 2304, C_ROPE_END = 3072;
constexpr int C_AV = 3072, C_BV = 3456, C_CV = 3520, C_PLAIN_END = 4288;
constexpr int C_GA = 4288, C_SILU_END = 5312;
constexpr int C_MG = 5312, C_SIG_END = 8384;
constexpr int NP = 5312;
constexpr int NW_MAIN = 8192;
constexpr int C_F8 = 1024;
constexpr int PBLK = NP / 32;
__host__ __device__ constexpr size_t p_col(int col) { return (size_t)(col >> 5) * 512 + (size_t)(col & 31); }
__host__ __device__ constexpr size_t p_off(int row, int col) { return (size_t)(row >> 4) * PBLK * 512 + (size_t)(row & 15) * 32 + p_col(col); }
__host__ __device__ constexpr size_t g_off(int row, int bc, int pitchB) { return ((size_t)(row >> 4) * (size_t)(pitchB / 64) + (size_t)(bc >> 6)) * 1024 + (size_t)((row & 15) * 64 + (bc & 63)); }
constexpr int YP = 1280;
constexpr float F8_SA = 16.f, F8_SB = 256.f, F8_SM = 16.f, F8_SY = 4.f;
constexpr float RMS_EPS = 1e-6f;
constexpr float QSCALE = 0.125f * 1.4426950408889634f;

constexpr size_t MiB = 1u << 20;
constexpr size_t WS_CTL = 0, CTL_ZERO_BYTES = 128 * 1024;
constexpr size_t WS_ROPE = 1 * MiB;
constexpr size_t WS_IW = 2 * MiB;
constexpr size_t WS_WIN = 4 * MiB;
constexpr size_t WS_WBR = 38 * MiB;
constexpr size_t WS_WOUT = 42 * MiB;
constexpr size_t WS_BITS = 46 * MiB;
constexpr size_t WS_H = 50 * MiB;
constexpr size_t WS_Y = 82 * MiB;
constexpr size_t WS_MERGED = 114 * MiB;
constexpr size_t WS_P = 146 * MiB;
constexpr size_t WS_MG8 = 312 * MiB;
constexpr size_t WS_H1 = 410 * MiB;
constexpr size_t WS_PO = 442 * MiB;
constexpr size_t WS_PML = 474 * MiB;
constexpr size_t WS_H8 = 476 * MiB;
constexpr size_t WS_IKC = 102 * MiB;
constexpr size_t WS_END = 508 * MiB;
static_assert(WS_P + (size_t)MC * NP * 2 <= WS_MG8 && WS_MG8 + (size_t)MC * 3072 <= WS_H1, "ws map");
static_assert(WS_Y + (size_t)MC * YP <= WS_IKC && WS_IKC + (size_t)2 * MC * 64 <= WS_MERGED, "ws map (compact indexer keys)");
static_assert(WS_WIN + (size_t)2 * NW * 1024 * 2 <= WS_WBR, "ws map");

constexpr int CW_TMO = 0;
constexpr int CW_BAR = 4096;
constexpr int CW_FIN = 24576;
constexpr size_t FIN_PART_OFF = 474 * MiB, FIN_CNT_OFF = (size_t)CW_FIN * 4, FIN_TMO_OFF = (size_t)(4096 + 128) * 4;
constexpr int CW_Q = 16384;

constexpr int RING_BYTES = 131072;
constexpr int SCORE_PITCH = 2052;
constexpr int LDSCTL_OFF = 135168, MISC_OFF = LDSCTL_OFF + 320;
constexpr int LDS_BYTES = 147456;
static_assert(16 * SCORE_PITCH * 4 <= LDSCTL_OFF, "lds map");

constexpr int NWAVES = 8;
constexpr int NPHASES = 2 + DEPTH * NCH * 5;

#define LDS_WAIT() asm volatile("s_waitcnt lgkmcnt(0)" ::: "memory")
#define VM_WAIT() asm volatile("s_waitcnt vmcnt(0)" ::: "memory")
#define RLX_AGENT __ATOMIC_RELAXED, __HIP_MEMORY_SCOPE_AGENT

__device__ __forceinline__ unsigned f2bf(float f) { unsigned u = __builtin_bit_cast(unsigned, f); return (u + 0x7fffu + ((u >> 16) & 1u)) >> 16; }
__device__ __forceinline__ unsigned pk2(float lo, float hi) { return f2bf(lo) | (f2bf(hi) << 16); }
__device__ __forceinline__ unsigned pk4_fp8(float a, float b, float c, float d) { int w = 0; w = __builtin_amdgcn_cvt_pk_fp8_f32(a, b, w, false); w = __builtin_amdgcn_cvt_pk_fp8_f32(c, d, w, true); return (unsigned)w; }
__device__ __forceinline__ float bf2f(short s) { return __builtin_bit_cast(float, ((unsigned)(unsigned short)s) << 16); }
typedef __bf16 bf16x2_t __attribute__((ext_vector_type(2)));
__device__ __forceinline__ unsigned cvtpk(float lo, float hi) { f32x2 v = {lo, hi}; bf16x2_t b = __builtin_convertvector(v, bf16x2_t); return __builtin_bit_cast(unsigned, b); }

__device__ __forceinline__ int opaque_wave(int wave) { asm volatile("" : "+s"(wave)); return wave; }
__device__ __forceinline__ int opaque_lane() { int l; asm volatile("v_mbcnt_lo_u32_b32 %0, -1, 0\n\tv_mbcnt_hi_u32_b32 %0, -1, %0" : "=v"(l)); return l; }
__device__ __forceinline__ int opaque_tid(int wave) { int l; asm volatile("v_mbcnt_lo_u32_b32 %0, -1, 0\n\tv_mbcnt_hi_u32_b32 %0, -1, %0" : "=v"(l)); return (wave << 6) | l; }
namespace pg8 {
constexpr int BM = 256, BK = 64, HALF = 128, HTB = HALF * BK * 2, STAGE_BYTES = 8 * HTB, NXCD = 8, WGM = 8;
__host__ __device__ __forceinline__ int lds_byte(int r, int c) { const int st = (r >> 4) * 2 + (c >> 5), rr = r & 15, cc = c & 31, ob = rr * 64 + cc * 2; return st * 1024 + (ob ^ (((ob >> 9) & 1) << 5)); }
__host__ __device__ __forceinline__ void stage_rc(int b, int& R, int& C) { const int st = b / 1024, sb = b % 1024, swz = sb ^ (((sb >> 9) & 1) << 5); R = (st >> 1) * 16 + swz / 64; C = (st & 1) * 32 + (swz % 64) / 2; }
__host__ __device__ __forceinline__ int perm32(int rho) { const int n = rho >> 4, i = rho & 15; return 8 * (i >> 2) + 4 * n + (i & 3); }

struct Unit { int pm, pn, kofs, nt, tag; };
constexpr int LD = 1024;
struct Gemm { const bf16_t* A; const bf16_t* Bt; };

struct StaticOrder {
    int nM, nN, nwg, G, c, nt;
    __device__ __forceinline__ void init(int M, int N, int K, int G_, int c_) { nM = M / BM; nN = N / BM; nwg = nM * nN; G = G_; c = c_; nt = K / BK; }
    __device__ __forceinline__ bool tile(int j, Unit& u) const {
        const long L = (long)j * G + c; if (L >= nwg) return false;
        int wgid = (int)L; { const int q = nwg / NXCD, r = nwg % NXCD, xcd = wgid % NXCD, off = wgid / NXCD; wgid = (xcd < r ? xcd * (q + 1) : r * (q + 1) + (xcd - r) * q) + off; }
        const int nig = WGM * nN, gid = wgid / nig, fm = gid * WGM, gsz = (nM - fm) < WGM ? (nM - fm) : WGM;
        u.pm = fm + ((wgid % nig) % gsz); u.pn = (wgid % nig) / gsz; return true;
    }
    __device__ __forceinline__ bool next(int i, Unit& u) const { if (!tile(i, u)) return false; u.kofs = 0; u.nt = nt; u.tag = 0; return true; }
};
struct TailOrder {
    int first, step, nt;
    __device__ __forceinline__ void init(int K, int G, int b) { const int stride = (G >= 64 && G % 64 == 0) ? G / 64 : 1; first = (b % stride == 0) ? b / stride : 64; step = G / stride; nt = K / BK; }
    __device__ __forceinline__ bool next(int i, Unit& u) const { const int j = first + i * step; if (j >= 64) return false; u.pm = j; u.pn = (NW_MAIN - C_F8) / BM; u.kofs = 0; u.nt = nt; u.tag = 0; return true; }
};
struct BranchOrder {
    StaticOrder so;
    __device__ __forceinline__ bool next(int i, Unit& u) const {
        const int j = i / 3, br = i - 3 * j; if (!so.tile(j, u)) return false;
        u.kofs = br * 512; u.nt = (br == 2) ? 2 : 4; u.tag = br; return true;
    }
};

typedef int i32x8 __attribute__((ext_vector_type(8)));
typedef int i32x4_t __attribute__((ext_vector_type(4)));
template <class Epi, class Sched, bool F8 = false, int F8PITCH = LD, bool ABLK = false>
__device__ __forceinline__ void gemm_phase(LAS unsigned char* lds, const Gemm g, const Sched& S, const Epi& E, int wave) {
    wave = opaque_wave(wave);
    const int tid = opaque_tid(wave), wid = wave, lane = tid & 63, wr = wid >> 2, wc = wid & 3, fr = lane & 15, fq = lane >> 4;
    unsigned voffA[2], voffB[2];
#pragma unroll
    for (int i = 0; i < 2; ++i) { int R, C; stage_rc(tid * 16 + i * 8192, R, C); const int Rb = Epi::PERM ? ((R & ~31) + perm32(R & 31)) : R;
        voffA[i] = ABLK ? (unsigned)g_off(R, C * 2, F8 ? F8PITCH : LD * 2) : (unsigned)(R * (F8 ? F8PITCH / 2 : LD) + C) * 2u; voffB[i] = (unsigned)(Rb * (F8 ? F8PITCH / 2 : LD) + C) * 2u; }
    constexpr size_t kstep = (size_t)(BK * 2);
    constexpr size_t kstepA = ABLK ? 2048 : kstep, kofA = ABLK ? 16 : 1;
    constexpr size_t ESZ = F8 ? 1 : 2;
    constexpr size_t hsA = F8 ? (size_t)HALF * F8PITCH : (size_t)HALF * LD * 2, hsB = hsA;
    constexpr size_t tsA = 2 * hsA, tsB = 2 * hsB;
    const unsigned ldsw = (unsigned)wid * 1024u;
    const int aoff = lds_byte(wr * 64 + fr, fq * 8), boff = lds_byte(wc * 32 + fr, fq * 8);
#define PG8_SA(b, h) (((b) * 2 + (h)) * HTB)
#define PG8_SB(b, h) ((4 + (b) * 2 + (h)) * HTB)
#define PG8_STAGE(bufoff, gbase, voff) do { _Pragma("unroll") for (int _i = 0; _i < 2; ++_i) { unsigned vo_ = (voff)[_i]; if (F8) asm volatile("" : "+v"(vo_));     \
        __builtin_amdgcn_global_load_lds((const unsigned*)((const char*)(gbase) + vo_), (LAS unsigned*)(lds + (bufoff) + ldsw + _i * 8192), 16, 0, 0); } } while (0)
#define PG8_LDA(dst, b, h) do { _Pragma("unroll") for (int m = 0; m < 4; ++m) { if (F8) { const i32x4_t lo_ = *(const LAS i32x4_t*)(lds + PG8_SA(b, h) + aoff + m * 2048), hi_ = *(const LAS i32x4_t*)(lds + PG8_SA(b, h) + aoff + m * 2048 + 1024); \
        dst##8[m] = __builtin_shufflevector(lo_, hi_, 0, 1, 2, 3, 4, 5, 6, 7); } else { _Pragma("unroll") for (int k = 0; k < 2; ++k) dst[m][k] = *(const LAS bf16x8*)(lds + PG8_SA(b, h) + aoff + m * 2048 + k * 1024); } } } while (0)
#define PG8_LDB(dst, b, h) do { _Pragma("unroll") for (int n = 0; n < 2; ++n) { if (F8) { const i32x4_t lo_ = *(const LAS i32x4_t*)(lds + PG8_SB(b, h) + boff + n * 2048), hi_ = *(const LAS i32x4_t*)(lds + PG8_SB(b, h) + boff + n * 2048 + 1024); \
        dst##8[n] = __builtin_shufflevector(lo_, hi_, 0, 1, 2, 3, 4, 5, 6, 7); } else { _Pragma("unroll") for (int k = 0; k < 2; ++k) dst[n][k] = *(const LAS bf16x8*)(lds + PG8_SB(b, h) + boff + n * 2048 + k * 1024); } } } while (0)
#define PG8_MMA(ai, bj, At, Bt) do { __builtin_amdgcn_s_setprio(1); _Pragma("unroll") for (int m = 0; m < 4; ++m) _Pragma("unroll") for (int n = 0; n < 2; ++n) { \
        if (F8) acc[ai][bj][m][n] = __builtin_amdgcn_mfma_scale_f32_16x16x128_f8f6f4(Bt##8[n], At##8[m], acc[ai][bj][m][n], 0, 0, 0, 0x7f7f7f7f, 0, 0x7f7f7f7f); \
        else { _Pragma("unroll") for (int k = 0; k < 2; ++k) acc[ai][bj][m][n] = __builtin_amdgcn_mfma_f32_16x16x32_bf16(Bt[n][k], At[m][k], acc[ai][bj][m][n], 0, 0, 0); } } \
        __builtin_amdgcn_s_setprio(0); } while (0)
#define PG8_WAIT_V(n) asm volatile("s_waitcnt vmcnt(" #n ")" ::: "memory")
#define PG8_WAIT_L(n) asm volatile("s_waitcnt lgkmcnt(" #n ")" ::: "memory")
#define PG8_BAR __builtin_amdgcn_s_barrier()
#define PG8_SCHED __builtin_amdgcn_sched_barrier(0)
    Unit cur, nxt; int ui = 0;
    if (!S.next(0, cur)) return;
    f32x4 acc[2][2][4][2];
#pragma unroll
    for (int a = 0; a < 2; ++a)
#pragma unroll
        for (int b = 0; b < 2; ++b)
#pragma unroll
            for (int m = 0; m < 4; ++m)
#pragma unroll
                for (int n = 0; n < 2; ++n) acc[a][b][m][n] = (f32x4){0.f, 0.f, 0.f, 0.f};
    bf16x8 At[4][2], B0[2][2], B1[2][2];
    i32x8 At8[4], B08[2], B18[2];
    const char* cA = (const char*)g.A + (size_t)cur.pm * tsA + (size_t)cur.kofs * ESZ * kofA; const char* cB = (const char*)g.Bt + (size_t)cur.pn * tsB + (size_t)cur.kofs * ESZ;
    PG8_STAGE(PG8_SB(0, 0), cB, voffB); PG8_STAGE(PG8_SB(0, 1), cB + hsB, voffB); PG8_STAGE(PG8_SA(0, 0), cA, voffA); PG8_STAGE(PG8_SA(0, 1), cA + hsA, voffA);
    if (wr == 1) PG8_BAR;
    PG8_WAIT_V(2); PG8_BAR;
    PG8_STAGE(PG8_SB(1, 0), cB + kstep, voffB); PG8_STAGE(PG8_SA(1, 0), cA + kstepA, voffA); PG8_STAGE(PG8_SB(1, 1), cB + hsB + kstep, voffB);
    PG8_WAIT_V(6); PG8_BAR;
    for (;;) {
        const bool has_next = S.next(ui + 1, nxt);
        const char* nA = has_next ? (const char*)g.A + (size_t)nxt.pm * tsA + (size_t)nxt.kofs * ESZ * kofA : cA; const char* nB = has_next ? (const char*)g.Bt + (size_t)nxt.pn * tsB + (size_t)nxt.kofs * ESZ : cB;
        const int nt = cur.nt;
        for (int t = 0; t < nt; t += 2) {
            const bool last = (t == nt - 2);
            const char* a1 = cA + (size_t)(t + 1) * kstepA;
            const char* a2 = last ? nA : cA + (size_t)(t + 2) * kstepA; const char* b2 = last ? nB : cB + (size_t)(t + 2) * kstep;
            const char* a3 = a2 + kstepA; const char* b3 = b2 + kstep;
            PG8_LDB(B0, 0, 0); PG8_LDB(B1, 0, 1); PG8_SCHED; PG8_LDA(At, 0, 0); PG8_STAGE(PG8_SA(1, 1), a1 + hsA, voffA);
            PG8_WAIT_V(8); PG8_WAIT_L(0); PG8_BAR; PG8_MMA(0, 0, At, B0); PG8_MMA(0, 1, At, B1); PG8_BAR; PG8_SCHED;
            PG8_LDA(At, 0, 1); PG8_STAGE(PG8_SB(0, 0), b2, voffB); PG8_STAGE(PG8_SB(0, 1), b2 + hsB, voffB); PG8_STAGE(PG8_SA(0, 0), a2, voffA);
            PG8_WAIT_V(8); PG8_WAIT_L(0); PG8_BAR; PG8_MMA(1, 0, At, B0); PG8_MMA(1, 1, At, B1); PG8_BAR; PG8_SCHED;
            PG8_LDB(B0, 1, 0); PG8_LDB(B1, 1, 1); PG8_SCHED; PG8_LDA(At, 1, 0); PG8_STAGE(PG8_SA(0, 1), a2 + hsA, voffA);
            PG8_WAIT_V(8); PG8_WAIT_L(0); PG8_BAR; PG8_MMA(0, 0, At, B0); PG8_MMA(0, 1, At, B1); PG8_BAR; PG8_SCHED;
            PG8_LDA(At, 1, 1); PG8_STAGE(PG8_SB(1, 0), b3, voffB); PG8_STAGE(PG8_SB(1, 1), b3 + hsB, voffB); PG8_STAGE(PG8_SA(1, 0), a3, voffA);
            PG8_WAIT_V(8); PG8_WAIT_L(0); PG8_BAR; PG8_MMA(1, 0, At, B0); PG8_MMA(1, 1, At, B1); PG8_BAR; PG8_SCHED;
        }
        if (wr == 0) PG8_BAR;
        E(acc, cur, wr, wc, fr, fq);
        if (!has_next) break;
        if (!(Epi::KEEP_ACC && cur.tag < 2))
#pragma unroll
        for (int a = 0; a < 2; ++a)
#pragma unroll
            for (int b = 0; b < 2; ++b)
#pragma unroll
                for (int m = 0; m < 4; ++m)
#pragma unroll
                    for (int n = 0; n < 2; ++n) acc[a][b][m][n] = (f32x4){0.f, 0.f, 0.f, 0.f};
        cur = nxt; cA = nA; cB = nB; ++ui;
        if (wr == 1) PG8_BAR;
    }
    PG8_WAIT_V(0);
    PG8_BAR;
#undef PG8_SA
#undef PG8_SB
#undef PG8_STAGE
#undef PG8_LDA
#undef PG8_LDB
#undef PG8_MMA
#undef PG8_WAIT_V
#undef PG8_WAIT_L
#undef PG8_BAR
#undef PG8_SCHED
}

__device__ __forceinline__ float sigmoidf_(float x) { return __builtin_amdgcn_rcpf(1.f + __expf(-x)); }

__device__ __forceinline__ size_t mg8_off(int row, int col) { return ((size_t)(row >> 4) * 96 + (size_t)(col >> 5)) * 512 + (size_t)((row & 15) * 32 + (col & 31)); }
struct EpiProj {
    static constexpr bool PERM = true, KEEP_ACC = false;
    bf16_t* P; unsigned char* MG8; const float* cosT; const float* sinT; int coloff; float ascale;
    __device__ __forceinline__ void operator()(const f32x4 (&acc)[2][2][4][2], const Unit& u, int wr, int wc, int fr, int fq) const {
        { const int l_ = opaque_lane(); fr = l_ & 15; fq = l_ >> 4; }
        const int row0 = u.pm * BM + wr * 64 + fr;
#pragma unroll
        for (int bj = 0; bj < 2; ++bj) {
            const int colg = coloff + u.pn * BM + bj * HALF + wc * 32;
            const int col = colg + 8 * fq;
            const bool cik = (colg >= C_IK && colg < C_IK + 64);
            bf16_t* dbase = cik ? (bf16_t*)((char*)P - (WS_P - WS_IKC)) + (size_t)((col - C_IK) >> 5) * MC * 32 + ((col - C_IK) & 31) : P + p_col(col);
            #define DROW(row_) (cik ? (size_t)(row_) * 32 : p_off((row_), 0))
            if (colg < C_ROPE_END) {
                const int f4 = ((col & 63) >> 3) * 4;
                const float sc = ((colg < C_IQ || (colg >= C_BQ && colg < C_CK)) ? QSCALE : 1.f) * ascale;
#pragma unroll
                for (int ai = 0; ai < 2; ++ai) {
                    f32x4 cc[4], ss[4];
#pragma unroll
                    for (int m = 0; m < 4; ++m) { const int t = (row0 + ai * HALF + m * 16) & (SEQ - 1); cc[m] = *(const f32x4*)(cosT + t * 32 + f4); ss[m] = *(const f32x4*)(sinT + t * 32 + f4); }
#pragma unroll
                    for (int m = 0; m < 4; ++m) {
                        const int row = row0 + ai * HALF + m * 16;
                        const f32x4 c = cc[m], s = ss[m];
                        const f32x4 v0 = acc[ai][bj][m][0], v1 = acc[ai][bj][m][1];
                        const f32x4 o0 = (v0 * c - v1 * s) * sc, o1 = (v0 * s + v1 * c) * sc;
                        u32x4 w; w.x = cvtpk(o0[0], o0[1]); w.y = cvtpk(o0[2], o0[3]); w.z = cvtpk(o1[0], o1[1]); w.w = cvtpk(o1[2], o1[3]);
                        *(u32x4*)(dbase + DROW(row)) = w;
                    }
                    asm volatile("" ::: "memory");
                }
                asm volatile("" ::: "memory");
            } else if (colg < C_SIG_END) {
                const int mode = (colg < C_PLAIN_END) ? 0 : (colg < C_SILU_END ? 1 : 2);
#pragma unroll
                for (int ai = 0; ai < 2; ++ai)
#pragma unroll
                    for (int m = 0; m < 4; ++m) {
                        const int row = row0 + ai * HALF + m * 16;
                        f32x4 v0 = acc[ai][bj][m][0] * ascale, v1 = acc[ai][bj][m][1] * ascale;
                        if (mode != 0) {
#pragma unroll
                            for (int e = 0; e < 4; ++e) { const float s0 = sigmoidf_(v0[e]), s1 = sigmoidf_(v1[e]); v0[e] = (mode == 1) ? v0[e] * s0 : s0; v1[e] = (mode == 1) ? v1[e] * s1 : s1; }
                        }
                        if (mode == 2) { u32x2 w; w.x = pk4_fp8(v0[0], v0[1], v0[2], v0[3]); w.y = pk4_fp8(v1[0], v1[1], v1[2], v1[3]);
                            *(u32x2*)(MG8 + mg8_off(row, col - C_MG)) = w; }
                        else { u32x4 w; w.x = cvtpk(v0[0], v0[1]); w.y = cvtpk(v0[2], v0[3]); w.z = cvtpk(v1[0], v1[1]); w.w = cvtpk(v1[2], v1[3]);
                            *(u32x4*)(P + p_off(row, col)) = w; }
                    }
            }
        }
    }
};

struct EpiMerge {
    static constexpr bool PERM = true, KEEP_ACC = true;
    const unsigned char* MG8; bf16_t* Mg; float ascale;
    __device__ __forceinline__ void operator()(f32x4 (&acc)[2][2][4][2], const Unit& u, int wr, int wc, int fr, int fq) const {
        { const int l_ = opaque_lane(); fr = l_ & 15; fq = l_ >> 4; }
        const int row0 = u.pm * BM + wr * 64 + fr; const int br = u.tag;
        const int colb = u.pn * BM + wc * 32 + 8 * fq;
        const float GMIN = 1e-18f;
#pragma unroll
        for (int ai = 0; ai < 2; ++ai) {
            u32x2 gt[4][2], gn[4][2];
#pragma unroll
            for (int m = 0; m < 4; ++m)
#pragma unroll
                for (int bj = 0; bj < 2; ++bj) gt[m][bj] = *(const u32x2*)(MG8 + mg8_off(row0 + ai * HALF + m * 16, br * 1024 + colb + bj * HALF));
            if (br != 2) {
#pragma unroll
                for (int m = 0; m < 4; ++m)
#pragma unroll
                    for (int bj = 0; bj < 2; ++bj) gn[m][bj] = *(const u32x2*)(MG8 + mg8_off(row0 + ai * HALF + m * 16, (br + 1) * 1024 + colb + bj * HALF));
            }
#pragma unroll
            for (int m = 0; m < 4; ++m)
#pragma unroll
                for (int bj = 0; bj < 2; ++bj) {
                    f32x4 v0 = acc[ai][bj][m][0], v1 = acc[ai][bj][m][1];
                    { const f32x2 a = __builtin_amdgcn_cvt_pk_f32_fp8((int)gt[m][bj].x, false), b = __builtin_amdgcn_cvt_pk_f32_fp8((int)gt[m][bj].x, true), c = __builtin_amdgcn_cvt_pk_f32_fp8((int)gt[m][bj].y, false), d = __builtin_amdgcn_cvt_pk_f32_fp8((int)gt[m][bj].y, true);
                      v0[0] *= __builtin_fmaxf(a.x, GMIN); v0[1] *= __builtin_fmaxf(a.y, GMIN); v0[2] *= __builtin_fmaxf(b.x, GMIN); v0[3] *= __builtin_fmaxf(b.y, GMIN);
                      v1[0] *= __builtin_fmaxf(c.x, GMIN); v1[1] *= __builtin_fmaxf(c.y, GMIN); v1[2] *= __builtin_fmaxf(d.x, GMIN); v1[3] *= __builtin_fmaxf(d.y, GMIN); }
                    if (br != 2) {
                        { const f32x2 a = __builtin_amdgcn_cvt_pk_f32_fp8((int)gn[m][bj].x, false), b = __builtin_amdgcn_cvt_pk_f32_fp8((int)gn[m][bj].x, true), c = __builtin_amdgcn_cvt_pk_f32_fp8((int)gn[m][bj].y, false), d = __builtin_amdgcn_cvt_pk_f32_fp8((int)gn[m][bj].y, true);
                          v0[0] *= __builtin_amdgcn_rcpf(__builtin_fmaxf(a.x, GMIN)); v0[1] *= __builtin_amdgcn_rcpf(__builtin_fmaxf(a.y, GMIN)); v0[2] *= __builtin_amdgcn_rcpf(__builtin_fmaxf(b.x, GMIN)); v0[3] *= __builtin_amdgcn_rcpf(__builtin_fmaxf(b.y, GMIN));
                          v1[0] *= __builtin_amdgcn_rcpf(__builtin_fmaxf(c.x, GMIN)); v1[1] *= __builtin_amdgcn_rcpf(__builtin_fmaxf(c.y, GMIN)); v1[2] *= __builtin_amdgcn_rcpf(__builtin_fmaxf(d.x, GMIN)); v1[3] *= __builtin_amdgcn_rcpf(__builtin_fmaxf(d.y, GMIN)); }
                        acc[ai][bj][m][0] = v0; acc[ai][bj][m][1] = v1;
                    } else {
                        const float sm_ = F8_SM * ascale;
                        u32x2 w; w.x = pk4_fp8(v0[0] * sm_, v0[1] * sm_, v0[2] * sm_, v0[3] * sm_); w.y = pk4_fp8(v1[0] * sm_, v1[1] * sm_, v1[2] * sm_, v1[3] * sm_);
                        *(u32x2*)((unsigned char*)Mg + g_off(row0 + ai * HALF + m * 16, colb + bj * HALF, DM)) = w;
                    }
                }
            asm volatile("" ::: "memory");
        }
    }
};

struct EpiResid {
    static constexpr bool PERM = false, KEEP_ACC = false;
    const float* xin; float* out; float ascale;
    __device__ __forceinline__ void operator()(const f32x4 (&acc)[2][2][4][2], const Unit& u, int wr, int wc, int fr, int fq) const {
        { const int l_ = opaque_lane(); fr = l_ & 15; fq = l_ >> 4; }
        const int row0 = u.pm * BM + wr * 64 + fr; const int col0 = u.pn * BM + wc * 32 + 4 * fq;
#pragma unroll
        for (int ai = 0; ai < 2; ++ai)
#pragma unroll
            for (int mp = 0; mp < 4; mp += 2) {
                f32x4 bs[2][2][2];
#pragma unroll
                for (int m = 0; m < 2; ++m)
#pragma unroll
                    for (int bj = 0; bj < 2; ++bj)
#pragma unroll
                        for (int n = 0; n < 2; ++n) bs[m][bj][n] = *(const f32x4*)(xin + (size_t)(row0 + ai * HALF + (mp + m) * 16) * DM + col0 + bj * HALF + n * 16);
#pragma unroll
                for (int m = 0; m < 2; ++m)
#pragma unroll
                    for (int bj = 0; bj < 2; ++bj)
#pragma unroll
                        for (int n = 0; n < 2; ++n) *(f32x4*)(out + (size_t)(row0 + ai * HALF + (mp + m) * 16) * DM + col0 + bj * HALF + n * 16) = bs[m][bj][n] + acc[ai][bj][mp + m][n] * ascale;
                asm volatile("" ::: "memory");
            }
    }
};
struct EpiResidNorm {
    static constexpr bool PERM = false, KEEP_ACC = false;
    float* out; const float* gfin; unsigned char* ws;
    __device__ __forceinline__ void operator()(const f32x4 (&acc_)[2][2][4][2], const Unit& u, int wr, int wc, int fr, int fq) const {
        f32x4 (&acc)[2][2][4][2] = const_cast<f32x4 (&)[2][2][4][2]>(acc_);
        const int l_ = opaque_lane(); fr = l_ & 15; fq = l_ >> 4;
#define XSH(v_, k_) __int_as_float(__builtin_amdgcn_ds_bpermute((l_ ^ (k_)) << 2, __float_as_int(v_)))
        const float* xin = out; constexpr float ascale = 1.f / (F8_SM * F8_SB);
        float* part = (float*)(ws + FIN_PART_OFF); unsigned* cnt = (unsigned*)(ws + FIN_CNT_OFF); unsigned* tmo = (unsigned*)(ws + FIN_TMO_OFF);
        const int row0 = u.pm * BM + wr * 64 + fr; const int col0 = u.pn * BM + wc * 32 + 4 * fq;
#pragma unroll
        for (int ai = 0; ai < 2; ++ai)
#pragma unroll
            for (int m = 0; m < 4; ++m) {
                f32x4 bs[2][2];
#pragma unroll
                for (int bj = 0; bj < 2; ++bj)
#pragma unroll
                    for (int n = 0; n < 2; ++n) bs[bj][n] = *(const f32x4*)(xin + (size_t)(row0 + ai * HALF + m * 16) * DM + col0 + bj * HALF + n * 16);
                float sq = 0.f;
#pragma unroll
                for (int bj = 0; bj < 2; ++bj)
#pragma unroll
                    for (int n = 0; n < 2; ++n) { const f32x4 o = bs[bj][n] + acc[ai][bj][m][n] * ascale; acc[ai][bj][m][n] = o; sq += o[0] * o[0] + o[1] * o[1] + o[2] * o[2] + o[3] * o[3]; }
                sq += XSH(sq, 16); sq += XSH(sq, 32);
                if (fq == 0) part[(size_t)(row0 + ai * HALF + m * 16) * 16 + u.pn * 4 + wc] = sq;
                asm volatile("" ::: "memory");
            }
        asm volatile("s_waitcnt vmcnt(0)" ::: "memory");
        __builtin_amdgcn_s_barrier();
        if (wr == 0 && wc == 0 && l_ == 0) {
            unsigned* c = cnt + 16 * u.pm;
            __builtin_amdgcn_fence(__ATOMIC_RELEASE, "agent");
            asm volatile("s_waitcnt vmcnt(0)" ::: "memory");
            (void)__hip_atomic_fetch_add(c, 1u, __ATOMIC_RELAXED, __HIP_MEMORY_SCOPE_AGENT);
            unsigned sp = 0;
            while (__hip_atomic_load(c, __ATOMIC_RELAXED, __HIP_MEMORY_SCOPE_AGENT) < 4u) { __builtin_amdgcn_s_sleep(1);
                if ((++sp & 255u) == 0u) { if (__hip_atomic_load(tmo, __ATOMIC_RELAXED, __HIP_MEMORY_SCOPE_AGENT)) break; if (sp > (1u << 18)) { atomicAdd(tmo, 1u); break; } } }
            __builtin_amdgcn_fence(__ATOMIC_ACQUIRE, "agent");
            asm volatile("s_waitcnt vmcnt(0)" ::: "memory");
        }
        __builtin_amdgcn_s_barrier();
        asm volatile("" ::: "memory");
        float rs[2][4];
        {
            f32x4 ps[2][4];
#pragma unroll
            for (int ai = 0; ai < 2; ++ai)
#pragma unroll
                for (int m = 0; m < 4; ++m) ps[ai][m] = *(const f32x4*)(part + (size_t)(row0 + ai * HALF + m * 16) * 16 + 4 * fq);
#pragma unroll
            for (int ai = 0; ai < 2; ++ai)
#pragma unroll
                for (int m = 0; m < 4; ++m) {
                    float ss = (ps[ai][m][0] + ps[ai][m][1]) + (ps[ai][m][2] + ps[ai][m][3]);
                    ss += XSH(ss, 16); ss += XSH(ss, 32);
                    rs[ai][m] = 1.f / sqrtf(ss * (1.f / DM) + RMS_EPS);
                }
        }
        asm volatile("" ::: "memory");
        f32x4 gv[2][2];
#pragma unroll
        for (int bj = 0; bj < 2; ++bj)
#pragma unroll
            for (int n = 0; n < 2; ++n) gv[bj][n] = *(const f32x4*)(gfin + col0 + bj * HALF + n * 16);
#pragma unroll
        for (int ai = 0; ai < 2; ++ai)
#pragma unroll
            for (int m = 0; m < 4; ++m) {
#pragma unroll
                for (int bj = 0; bj < 2; ++bj)
#pragma unroll
                    for (int n = 0; n < 2; ++n) *(f32x4*)(out + (size_t)(row0 + ai * HALF + m * 16) * DM + col0 + bj * HALF + n * 16) = acc[ai][bj][m][n] * rs[ai][m] * gv[bj][n];
                asm volatile("" ::: "memory");
            }
    }
};
#undef XSH
}

template <class T> __device__ __forceinline__ T* launder(T* p) { asm volatile("" : "+s"(p)); return p; }
#define XB_TMO      128
#define XB_XCNT(j)  (256  + 64 * (j))
#define XB_XSUB(j)  (1280 + 64 * (j))
#define XB_XGEN(j)  (2304 + 64 * (j))
#define XB_TOP      3328
#define XB_TOPGEN   3392
#define XCD_BAR_WORDS 3456
#define XB_SPIN_CAP (1u << 18)
__device__ __forceinline__ unsigned xb_ld(unsigned* p)              { return __hip_atomic_load(p, __ATOMIC_RELAXED, __HIP_MEMORY_SCOPE_AGENT); }
__device__ __forceinline__ unsigned xb_add(unsigned* p, unsigned v) { return __hip_atomic_fetch_add(p, v, __ATOMIC_RELAXED, __HIP_MEMORY_SCOPE_AGENT); }
__device__ __forceinline__ unsigned xb_xcc_id() { return (unsigned)__builtin_amdgcn_s_getreg((3 << 11) | 20) & 0xFu; }
#define XB_SPIN(cond, bar) do { unsigned _sp = 0; while (cond) { __builtin_amdgcn_s_sleep(1); \
    if ((++_sp & 255u) == 0u) { if (xb_ld(&(bar)[XB_TMO])) break; if (_sp > XB_SPIN_CAP) { atomicAdd(&(bar)[XB_TMO], 1u); break; } } } } while (0)
struct XcdBarrier { unsigned* bar; unsigned x; volatile LAS unsigned* st; };
__device__ __forceinline__ XcdBarrier xcd_barrier_post(unsigned* bar, volatile LAS unsigned* st) {
    XcdBarrier b; b.bar = bar; b.x = xb_xcc_id(); b.st = st;
    if (threadIdx.x == 0) (void)xb_add(&bar[XB_XCNT(b.x)], 1u);
    return b;
}
__device__ __forceinline__ void xcd_barrier_complete(unsigned* bar, unsigned x, unsigned& nloc, unsigned& nx) {
    const unsigned G = gridDim.x * gridDim.y * gridDim.z;
    unsigned sum, cnt, mine, sp = 0u;
    for (;;) {
        sum = 0u; cnt = 0u; mine = 0u;
#pragma unroll
        for (unsigned j = 0; j < 16; ++j) { const unsigned c = xb_ld(&bar[XB_XCNT(j)]); sum += c; cnt += (c > 0u) ? 1u : 0u; mine = (j == x) ? c : mine; }
        if (sum == G) break;
        __builtin_amdgcn_s_sleep(1);
        if ((++sp & 255u) == 0u) { if (xb_ld(&bar[XB_TMO])) break; if (sp > XB_SPIN_CAP) { atomicAdd(&bar[XB_TMO], 1u); break; } }
    }
    nloc = mine > 0u ? mine : 1u; nx = cnt > 0u ? cnt : 1u;
}
template <bool FIRST> __device__ __forceinline__ void xcd_barrier(const XcdBarrier& b, int wave) {
    asm volatile("s_waitcnt vmcnt(0)" ::: "memory");
    __syncthreads();
    if (opaque_tid(wave) == 0) {
        unsigned* bar = launder(b.bar);
        unsigned bx = b.x; asm volatile("" : "+s"(bx));
        __builtin_amdgcn_s_waitcnt(0);
        unsigned nloc = b.st[0], nx = b.st[1];
        if (FIRST) { xcd_barrier_complete(bar, bx, nloc, nx); b.st[0] = nloc; b.st[1] = nx; }
        const unsigned old = xb_add(&bar[XB_XSUB(bx)], 1u);
        const unsigned gen = old / nloc;
        if (old + 1u == (gen + 1u) * nloc) {
            __builtin_amdgcn_fence(__ATOMIC_RELEASE, "agent");
            asm volatile("s_waitcnt vmcnt(0)" ::: "memory");
            const unsigned og = xb_add(&bar[XB_TOP], 1u);
            const unsigned tg = og / nx;
            if (og + 1u == (tg + 1u) * nx) xb_add(&bar[XB_TOPGEN], 1u);
            else XB_SPIN(xb_ld(&bar[XB_TOPGEN]) == tg, bar);
            __builtin_amdgcn_fence(__ATOMIC_ACQUIRE, "agent");
            xb_add(&bar[XB_XGEN(bx)], 1u);
            asm volatile("s_waitcnt vmcnt(0)" ::: "memory");
        } else {
            XB_SPIN(xb_ld(&bar[XB_XGEN(bx)]) == gen, bar);
            __builtin_amdgcn_fence(__ATOMIC_ACQUIRE, "agent");
            asm volatile("s_waitcnt vmcnt(0)" ::: "memory");
        }
    }
    __syncthreads();
}

struct Frame {
    LAS unsigned char* lds;
    volatile LAS unsigned* MISC;
    gu32* ctl;
    int tid, lane, wave, G;
};

__device__ __forceinline__ float wave_sum(float v) {
    v += __int_as_float(__builtin_amdgcn_update_dpp(0, __float_as_int(v), 0xB1, 0xf, 0xf, false));
    v += __int_as_float(__builtin_amdgcn_update_dpp(0, __float_as_int(v), 0x4E, 0xf, 0xf, false));
    v += __int_as_float(__builtin_amdgcn_update_dpp(0, __float_as_int(v), 0x141, 0xf, 0xf, false));
    v += __int_as_float(__builtin_amdgcn_update_dpp(0, __float_as_int(v), 0x140, 0xf, 0xf, false));
    v += __int_as_float(__builtin_amdgcn_update_dpp(0, __float_as_int(v), 0x142, 0xa, 0xf, false));
    v += __int_as_float(__builtin_amdgcn_update_dpp(0, __float_as_int(v), 0x143, 0xc, 0xf, false));
    return __int_as_float(__builtin_amdgcn_readlane(__float_as_int(v), 63));
}
__device__ __forceinline__ float shfl_xor_l(float v, int mask, int lane) { return __int_as_float(__builtin_amdgcn_ds_bpermute((lane ^ mask) << 2, __float_as_int(v))); }

__device__ __forceinline__ int src_col(int n) {
    if (n < C_ROPE_END) {
        int bn, bo;
        if (n < 384) { bn = 0; bo = 0; } else if (n < 640) { bn = 384; bo = 2432; } else if (n < 704) { bn = 640; bo = 2688; }
        else if (n < 768) { bn = 704; bo = 1920; } else if (n < 1152) { bn = 768; bo = 384; } else if (n < 1536) { bn = 1152; bo = 1536; }
        else if (n < 2304) { bn = 1536; bo = 2756; } else { bn = 2304; bo = 3524; }
        const int r = n - bn, head = r >> 6, p = r & 63, i = p >> 3, e = p & 7;
        const int dim = (e < 4) ? 4 * i + e : 32 + 4 * i + (e - 4);
        return bo + head * 64 + dim;
    }
    if (n < 3456) return 768 + (n - 3072);
    if (n < 3520) return 1984 + (n - 3456);
    if (n < 4288) return 4292 + (n - 3520);
    if (n < 4672) return 1152 + (n - 4288);
    if (n < 5056) return 2048 + (n - 4672);
    if (n < 5312) return 5060 + (n - 5056);
    if (n < 8384) return 5316 + (n - 5312);
    return -1;
}

template <bool PERMUTE, bool F8OUT = false>
__device__ __forceinline__ void transpose_item(const float* W, int ldw, int nblk, bf16_t* WT, int ldt, int koff, LAS float* scr, int item, int lane, int nbase = 0, int nrow0 = 0) {
    const int kb = item / nblk, nb = item % nblk, k0 = 64 * kb, n0 = nbase + 32 * nb;
    const int sc = PERMUTE ? src_col(n0 + (lane & 31)) : (n0 + (lane & 31));
    float wv[32];
    const float* wp = W + (size_t)(k0 + (lane >> 5)) * ldw + (sc >= 0 ? sc : 0);
#pragma unroll
    for (int i = 0; i < 32; ++i) wv[i] = wp[(size_t)(2 * i) * ldw];
#pragma unroll
    for (int i = 0; i < 32; ++i) { const int kk = 2 * i + (lane >> 5); scr[kk * 33 + (lane & 31)] = (sc >= 0) ? wv[i] : 0.f; }
    LDS_WAIT(); asm volatile("" ::: "memory");
    const int c = lane & 7;
#pragma unroll
    for (int j = 0; j < 4; ++j) { const int n = (lane >> 3) + 8 * j; const LAS float* s = scr + (8 * c) * 33 + n;
        if (F8OUT) { u32x2 o; o.x = pk4_fp8(s[0 * 33] * F8_SB, s[1 * 33] * F8_SB, s[2 * 33] * F8_SB, s[3 * 33] * F8_SB); o.y = pk4_fp8(s[4 * 33] * F8_SB, s[5 * 33] * F8_SB, s[6 * 33] * F8_SB, s[7 * 33] * F8_SB);
            *(u32x2*)((unsigned char*)WT + (size_t)(n0 - nrow0 + n) * ldt + koff + k0 + 8 * c) = o; }
        else { u32x4 o; o.x = pk2(s[0 * 33], s[1 * 33]); o.y = pk2(s[2 * 33], s[3 * 33]); o.z = pk2(s[4 * 33], s[5 * 33]); o.w = pk2(s[6 * 33], s[7 * 33]);
            *(u32x4*)(WT + (size_t)(n0 + n) * ldt + koff + k0 + 8 * c) = o; } }
    LDS_WAIT(); asm volatile("" ::: "memory");
}

template <bool TO_BF16, int NB>
__device__ __forceinline__ void rms_rows(const float* xrow, const float* g, void* orow, unsigned char* o8row, float* iwrow, const float* wiw, int lane) {
    f32x4 v[NB][4];
#pragma unroll
    for (int r = 0; r < NB; ++r) { const f32x4* xr = (const f32x4*)(xrow + (size_t)r * DM) + lane;
#pragma unroll
        for (int j = 0; j < 4; ++j) v[r][j] = xr[64 * j]; }
    const f32x4* gr = (const f32x4*)g + lane;
    f32x4 gv[4];
#pragma unroll
    for (int j = 0; j < 4; ++j) gv[j] = gr[64 * j];
#pragma unroll
    for (int r = 0; r < NB; ++r) {
        float s = 0.f;
#pragma unroll
        for (int j = 0; j < 4; ++j) s += (v[r][j].x * v[r][j].x + v[r][j].y * v[r][j].y) + (v[r][j].z * v[r][j].z + v[r][j].w * v[r][j].w);
        const float rs = 1.f / sqrtf(wave_sum(s) * (1.f / DM) + RMS_EPS);
#pragma unroll
        for (int j = 0; j < 4; ++j) v[r][j] = v[r][j] * rs * gv[j];
        if (TO_BF16) {
            u64* o8 = (u64*)((bf16_t*)orow + (size_t)r * DM) + lane;
            unsigned* o4 = (unsigned*)(o8row + (size_t)r * DM) + lane;
#pragma unroll
            for (int j = 0; j < 4; ++j) { const f32x4 w = v[r][j]; o8[64 * j] = (u64)pk2(w.x, w.y) | ((u64)pk2(w.z, w.w) << 32);
                o4[64 * j] = pk4_fp8(w.x * F8_SA, w.y * F8_SA, w.z * F8_SA, w.w * F8_SA); }
        } else {
            f32x4* o = (f32x4*)((float*)orow + (size_t)r * DM) + lane;
#pragma unroll
            for (int j = 0; j < 4; ++j) o[64 * j] = v[r][j];
        }
    }
    if (TO_BF16) {
        f32x4 acc[NB];
#pragma unroll
        for (int r = 0; r < NB; ++r) acc[r] = (f32x4){0.f, 0.f, 0.f, 0.f};
#pragma unroll
        for (int j = 0; j < 4; ++j) {
            f32x4 wk[4];
#pragma unroll
            for (int e = 0; e < 4; ++e) wk[e] = *(const f32x4*)(wiw + (size_t)(256 * j + 4 * lane + e) * INW);
#pragma unroll
            for (int r = 0; r < NB; ++r) acc[r] += wk[0] * v[r][j].x + wk[1] * v[r][j].y + wk[2] * v[r][j].z + wk[3] * v[r][j].w;
        }
#pragma unroll
        for (int r = 0; r < NB; ++r) { f32x4 t; t.x = wave_sum(acc[r].x); t.y = wave_sum(acc[r].y); t.z = wave_sum(acc[r].z); t.w = wave_sum(acc[r].w);
            if (lane == 0) *(f32x4*)(iwrow + (size_t)r * 4) = t * 0.0625f; }
    }
}

namespace att {
constexpr int SLOTB = 8192, NSLOT = 4;
constexpr size_t PO_STRIDE = (size_t)MC * 4 * 64, PML_STRIDE = (size_t)MC * 4 * 2;
constexpr int L_K = 0, L_V = NSLOT * SLOTB, L_M = 2 * NSLOT * SLOTB, L_KM = L_M + NSLOT * 2048, L_LUT = L_KM + 2048;
typedef LAS const char* lds_cptr;
typedef short v4i16_t __attribute__((ext_vector_type(4)));
__device__ __forceinline__ s16x4 vtr(lds_cptr p) { return __builtin_bit_cast(s16x4, __builtin_amdgcn_ds_read_tr16_b64_v4i16((LAS v4i16_t*)p)); }
__device__ __forceinline__ float swap_add(float v) { auto rr = __builtin_amdgcn_permlane32_swap(__float_as_uint(v), __float_as_uint(v), false, false); return __uint_as_float(rr[0]) + __uint_as_float(rr[1]); }
__device__ __forceinline__ float swap_max(float v) { auto rr = __builtin_amdgcn_permlane32_swap(__float_as_uint(v), __float_as_uint(v), false, false); return __builtin_fmaxf(__uint_as_float(rr[0]), __uint_as_float(rr[1])); }
__device__ __forceinline__ float fadd_s(float a, float b) { float r; asm("v_add_f32_e32 %0, %1, %2" : "=v"(r) : "v"(a), "v"(b)); return r; }
__device__ __forceinline__ float fmax_s(float a, float b) { float r; asm("v_max_f32_e32 %0, %1, %2" : "=v"(r) : "v"(a), "v"(b)); return r; }
__device__ __forceinline__ float fmax3_s(float a, float b, float c) { float r; asm("v_max3_f32 %0, %1, %2, %3" : "=v"(r) : "v"(a), "v"(b), "v"(c)); return r; }
__device__ __forceinline__ void glds16(const void* gsrc, unsigned lds_dst) { unsigned keep;
    asm volatile("s_mov_b32 %0, m0\n\ts_mov_b32 m0, %2\n\ts_nop 0\n\tglobal_load_lds_dwordx4 %1, off\n\ts_mov_b32 m0, %0" : "=&s"(keep) : "v"(gsrc), "s"(lds_dst) : "memory"); }
__device__ __forceinline__ void glds4(const void* gsrc, unsigned lds_dst) { unsigned keep;
    asm volatile("s_mov_b32 %0, m0\n\ts_mov_b32 m0, %2\n\ts_nop 0\n\tglobal_load_lds_dword %1, off\n\ts_mov_b32 m0, %0" : "=&s"(keep) : "v"(gsrc), "s"(lds_dst) : "memory"); }
#define WAITBAR(N) asm volatile("s_waitcnt vmcnt(" #N ") lgkmcnt(0)\n\ts_barrier" ::: "memory")

template <int MODE>
__device__ __forceinline__ void attn_unit(LAS unsigned char* lds, const bf16_t* __restrict__ P, bf16_t* __restrict__ Y, const u64* __restrict__ bits, float* __restrict__ PO, float* __restrict__ PML, int rowbase, int hsel, int blk, int wave) {
    wave = opaque_wave(wave);
    const int tid = opaque_tid(wave), lane = tid & 63, r32 = lane & 31, hi = lane >> 5; const int wid = wave;
    constexpr int RS = (MODE == 3) ? 8 : (MODE == 4) ? 4 : 1;
    const int roff = (MODE == 3) ? blk : (MODE == 4) ? (blk & 3) : 0;
    const int T0 = (MODE == 3) ? 0 : (MODE == 4) ? 256 * (blk >> 2) : blk * 256, qw0 = T0 + wid * 32, qpos = qw0 + r32;
    const int qtok = roff + RS * qpos;
    const float NEG = -INFINITY;
    constexpr int NDMA = (MODE == 1) ? 3 : 2;
    int n0 = 0, n1 = 0, s0 = 0, s1 = 0, NT;
    if (MODE == 0) NT = 4 + 4 * blk;
    else if (MODE == 1) NT = 4 * (blk + 1);
    else if (MODE == 3) NT = 4;
    else { s0 = T0 >= 128 ? T0 - 128 : 0; n0 = (T0 + 256 - s0) >> 6; NT = n0; }
    const int ycol = (MODE == 0) ? 64 * hsel : (MODE == 1) ? 384 + 64 * hsel : 768 + 64 * hsel;
    const int ycol8 = (MODE == 0) ? 64 * hsel : (MODE == 1) ? 512 + 64 * hsel : 1024 + 64 * hsel;
#define TILE_INFO(t, row0, seg) do { if (MODE == 0) { if ((t) < 4) { seg = 0; row0 = T0 + 64 * (t); } else { seg = 1; row0 = 64 * ((t) - 4); } } \
        else if (MODE == 1 || MODE == 3) { seg = (MODE == 3) ? 2 : 0; row0 = 64 * (t); } \
        else { seg = (MODE == 4) ? 1 : 0; row0 = s0 + 64 * (t); } } while (0)
#define KCOL(seg) ((MODE == 0) ? (C_AK + 64 * hsel) : (MODE == 1) ? C_BK : (C_CK + 64 * (4 * (seg) + hsel)))
#define VCOL(seg) ((MODE == 0) ? (C_AV + 64 * hsel) : (MODE == 1) ? C_BV : (C_CV + 64 * (4 * (seg) + hsel)))
#define QCOL(seg) ((MODE == 0) ? (C_AQ + 64 * hsel) : (MODE == 1) ? (C_BQ + 64 * hsel) : (C_CQ + 64 * (4 * (seg) + hsel)))
    const unsigned lds0 = (unsigned)(uintptr_t)lds;
    const u64* brow_dma = bits + (size_t)(rowbase + T0 + 32 * wid + (lane >> 1)) * 32;
    const char* kbase_l = (const char*)(P + p_off(rowbase + roff + RS * lane, wid * 8));
    const char* vbase_l = (const char*)(P + p_off(rowbase + roff + RS * (16 * (wid & 3) + (lane >> 2)), (wid >> 2) * 32 + (lane & 3) * 8));
#define ISSUE(t) do { int row0_, seg_; TILE_INFO((t), row0_, seg_); const int slot_ = (t) & (NSLOT - 1); \
        const size_t ko_ = (p_off(row0_ * RS, 0) + p_col(KCOL(seg_))) * 2, vo_ = (p_off(row0_ * RS, 0) + p_col(VCOL(seg_))) * 2;     \
        glds16(kbase_l + ko_, (unsigned)__builtin_amdgcn_readfirstlane(lds0 + L_K + slot_ * SLOTB + wid * 1024)); \
        glds16(vbase_l + vo_, (unsigned)__builtin_amdgcn_readfirstlane(lds0 + L_V + slot_ * SLOTB + wid * 1024)); \
        if (MODE == 1) glds4((const unsigned*)(brow_dma + (t)) + (lane & 1), (unsigned)__builtin_amdgcn_readfirstlane(lds0 + L_M + slot_ * 2048 + wid * 256)); } while (0)

    const bf16_t* qrow = P + p_off(rowbase + qtok, 0);
    asm volatile("s_waitcnt vmcnt(0)" ::: "memory");
    ISSUE(0);
    if (NT > 1) ISSUE(1);
    if (NT > 2) ISSUE(2);
    constexpr int NQ = 1;
    constexpr int QS0 = (MODE == 3) ? 2 : (MODE == 4) ? 1 : 0;
    bf16x8 qr[NQ][4];
#pragma unroll
    for (int sg = 0; sg < NQ; ++sg)
#pragma unroll
        for (int d0 = 0; d0 < 4; ++d0) qr[sg][d0] = *(const bf16x8*)(qrow + p_col(QCOL(QS0 + sg) + d0 * 16 + hi * 8));
    unsigned sel = 0u;
    if (MODE == 0) {
        LAS float* km = (LAS float*)(lds + L_KM);
        if (wid < blk) {
            const int c = lane & 7, rg = lane >> 3; float a[8];
#pragma unroll
            for (int e = 0; e < 8; ++e) a[e] = 0.f;
            const bf16_t* kp = P + p_off(rowbase + 256 * wid + rg, C_AK + 64 * hsel + 8 * c);
#pragma unroll 8
            for (int i = 0; i < 32; ++i) { const bf16x8 v = *(const bf16x8*)(kp + (size_t)(i >> 1) * PBLK * 512 + (size_t)(i & 1) * 256);
#pragma unroll
                for (int e = 0; e < 8; ++e) a[e] += bf2f(v[e]); }
#pragma unroll
            for (int e = 0; e < 8; ++e) { a[e] += shfl_xor_l(a[e], 8, lane); a[e] += shfl_xor_l(a[e], 16, lane); a[e] += shfl_xor_l(a[e], 32, lane); }
            if (rg == 0) {
#pragma unroll
                for (int e = 0; e < 8; ++e) km[wid * 64 + 8 * c + e] = a[e] * (1.f / 256.f);
            }
        }
        __syncthreads();
        float g[7];
#pragma unroll
        for (int j = 0; j < 7; ++j) {
            float part = 0.f;
            if (j < blk) {
#pragma unroll
                for (int d0 = 0; d0 < 4; ++d0) { const f32x4 k0 = *(const LAS f32x4*)(km + j * 64 + 16 * d0 + 8 * hi), k1 = *(const LAS f32x4*)(km + j * 64 + 16 * d0 + 8 * hi + 4);
#pragma unroll
                    for (int e = 0; e < 4; ++e) part += bf2f(qr[0][d0][e]) * k0[e] + bf2f(qr[0][d0][4 + e]) * k1[e]; }
                part = swap_add(part);
            }
            g[j] = (j < blk) ? part : NEG;
        }
#pragma unroll
        for (int rep = 0; rep < 3; ++rep) { float bv = NEG; int best = -1;
#pragma unroll
            for (int j = 0; j < 7; ++j) { const bool ok = (j < blk) && !((sel >> j) & 1u) && (g[j] > bv); if (ok) { bv = g[j]; best = j; } }
            if (best >= 0) sel |= 1u << best; }
    }
    f32x16 o0 = {}, o1 = {}; float m_run = 0.f, l_run = 0.f; f32x16 negm = {}; asm volatile("" : "+v"(negm));
    constexpr float DEFER_THR = 8.f;
    bool fresh = true;
    const lds_cptr lds3 = (lds_cptr)lds;
    const lds_cptr kp0 = lds3 + L_K + hi * 1024 + r32 * 16;
    const lds_cptr vp0 = lds3 + L_V + ((lane >> 4) & 1) * 32 + (lane & 3) * 8 + (4 * hi + ((lane & 15) >> 2)) * 64;
    const lds_cptr mp0 = lds3 + L_M + (32 * wid + r32) * 8;
#pragma unroll
    for (int sg = 0; sg < NQ; ++sg)
#pragma unroll
        for (int d0 = 0; d0 < 4; ++d0) asm volatile("" : "+v"(qr[sg][d0]));
    WAITBAR(0);
    for (int t = 0; t < NT; ++t) {
        int row0, seg; TILE_INFO(t, row0, seg);
        bool active;
        if (MODE == 0) active = (seg == 0) ? (row0 <= qw0 + 31) : (__any((sel >> (row0 >> 8)) & 1u) != 0);
        else if (MODE == 1 || MODE == 3) active = (row0 <= qw0 + 31);
        else active = (row0 <= qw0 + 31) && (row0 + 63 + 128 >= qw0);
        if (!active) { if (t + 3 < NT) ISSUE(t + 3); }
        if (active) {
            const int slot = (t & (NSLOT - 1)) * SLOTB;
            u32x2 mw = {0u, 0u}; if (MODE == 1) mw = *(const LAS u32x2*)(mp0 + (t & (NSLOT - 1)) * 2048);
            bf16x8 kf[8];
            { const lds_cptr kp = kp0 + slot;
#pragma unroll
              for (int j = 0; j < 4; ++j) { kf[2 * j] = *(const LAS bf16x8*)(kp + j * 2048); kf[2 * j + 1] = *(const LAS bf16x8*)(kp + j * 2048 + 512); } }
            if (t + 3 < NT) ISSUE(t + 3);
            s16x4 vlo[2][4], vhi[2][4];
            { const lds_cptr vp = vp0 + slot;
#pragma unroll
              for (int d0 = 0; d0 < 2; ++d0)
#pragma unroll
                  for (int ks = 0; ks < 4; ++ks) { vlo[d0][ks] = vtr(vp + d0 * 4096 + ks * 1024); vhi[d0][ks] = vtr(vp + d0 * 4096 + ks * 1024 + 512); } }
            f32x16 p0 = __builtin_amdgcn_mfma_f32_32x32x16_bf16(kf[0], qr[0][0], negm, 0, 0, 0), p1 = __builtin_amdgcn_mfma_f32_32x32x16_bf16(kf[1], qr[0][0], negm, 0, 0, 0);
#pragma unroll
            for (int d0 = 1; d0 < 4; ++d0) { p0 = __builtin_amdgcn_mfma_f32_32x32x16_bf16(kf[2 * d0], qr[0][d0], p0, 0, 0, 0); p1 = __builtin_amdgcn_mfma_f32_32x32x16_bf16(kf[2 * d0 + 1], qr[0][d0], p1, 0, 0, 0); }
            if (MODE == 0) {
                if (seg == 0) { if (row0 + 63 > qw0) { const int kb = row0 + 4 * hi;
#pragma unroll
                    for (int r = 0; r < 16; ++r) { const int kv = kb + (r & 3) + 8 * (r >> 2); if (kv > qpos) p0[r] = NEG; if (kv + 32 > qpos) p1[r] = NEG; } } }
                else { if (!((sel >> (row0 >> 8)) & 1u)) {
#pragma unroll
                    for (int r = 0; r < 16; ++r) { p0[r] = NEG; p1[r] = NEG; } } }
            } else if (MODE == 1) {
                const int lo = (int)(mw.x >> (4 * hi)), hw = (int)(mw.y >> (4 * hi));
#pragma unroll
                for (int r = 0; r < 16; ++r) { const unsigned m0_ = (unsigned)__builtin_amdgcn_sbfe(lo, (r & 3) + 8 * (r >> 2), 1), m1_ = (unsigned)__builtin_amdgcn_sbfe(hw, (r & 3) + 8 * (r >> 2), 1);
                    p0[r] = __uint_as_float((__float_as_uint(p0[r]) & m0_) | (0xff800000u & ~m0_)); p1[r] = __uint_as_float((__float_as_uint(p1[r]) & m1_) | (0xff800000u & ~m1_)); }
            } else {
                const int lg = (MODE == 3) ? 1 : 0; const int base = qpos - row0 - 4 * hi;
#pragma unroll
                for (int r = 0; r < 16; ++r) { const unsigned d0_ = (unsigned)(base - ((r & 3) + 8 * (r >> 2))), d1_ = d0_ - 32u;
                    if (__builtin_rotateright32(d0_, (unsigned)lg) > 128u) p0[r] = NEG; if (__builtin_rotateright32(d1_, (unsigned)lg) > 128u) p1[r] = NEG; }
            }
            asm volatile("s_nop 11" : "+v"(p0), "+v"(p1));
            float ma = fmax3_s(p0[0], p0[1], p1[0]), mb = fmax3_s(p0[2], p0[3], p1[1]);
            ma = fmax3_s(ma, p1[2], p1[3]);
#pragma unroll
            for (int r = 4; r < 16; r += 4) { ma = fmax3_s(ma, p0[r], p0[r + 1]); mb = fmax3_s(mb, p0[r + 2], p0[r + 3]);
                ma = fmax3_s(ma, p1[r], p1[r + 1]); mb = fmax3_s(mb, p1[r + 2], p1[r + 3]); }
            const float rm = swap_max(__builtin_fmaxf(ma, mb));
            if (fresh || __any(rm > DEFER_THR)) {
                const float dl = fresh ? ((rm == NEG) ? 0.f : rm) : __builtin_fmaxf(rm, 0.f); m_run += dl; fresh = false;
                const float f = __builtin_amdgcn_exp2f(-dl); l_run *= f;
#pragma unroll
                for (int r = 0; r < 16; ++r) { p0[r] -= dl; p1[r] -= dl; o0[r] *= f; o1[r] *= f; negm[r] = -m_run; }
                asm volatile("" : "+v"(negm));
            }
            float ls0 = 0.f, ls1 = 0.f;
#pragma unroll
            for (int r = 0; r < 16; ++r) { p0[r] = __builtin_amdgcn_exp2f(p0[r]); p1[r] = __builtin_amdgcn_exp2f(p1[r]); }
            asm volatile("" : "+v"(p0), "+v"(p1));
#pragma unroll
            for (int r = 0; r < 16; ++r) { ls0 = fadd_s(ls0, p0[r]); ls1 = fadd_s(ls1, p1[r]); }
            l_run = fadd_s(l_run, fadd_s(ls0, ls1));
            u32x4 pw[4];
            pw[0] = (u32x4){cvtpk(p0[0], p0[1]), cvtpk(p0[2], p0[3]), cvtpk(p0[4], p0[5]), cvtpk(p0[6], p0[7])};
            pw[1] = (u32x4){cvtpk(p0[8], p0[9]), cvtpk(p0[10], p0[11]), cvtpk(p0[12], p0[13]), cvtpk(p0[14], p0[15])};
            pw[2] = (u32x4){cvtpk(p1[0], p1[1]), cvtpk(p1[2], p1[3]), cvtpk(p1[4], p1[5]), cvtpk(p1[6], p1[7])};
            pw[3] = (u32x4){cvtpk(p1[8], p1[9]), cvtpk(p1[10], p1[11]), cvtpk(p1[12], p1[13]), cvtpk(p1[14], p1[15])};
#pragma unroll
            for (int d0 = 0; d0 < 2; ++d0)
#pragma unroll
                for (int ks = 0; ks < 4; ++ks) {
                    const bf16x8 vf = (bf16x8){vlo[d0][ks][0], vlo[d0][ks][1], vlo[d0][ks][2], vlo[d0][ks][3], vhi[d0][ks][0], vhi[d0][ks][1], vhi[d0][ks][2], vhi[d0][ks][3]};
                    if (d0 == 0) o0 = __builtin_amdgcn_mfma_f32_32x32x16_bf16(vf, __builtin_bit_cast(bf16x8, pw[ks]), o0, 0, 0, 0);
                    else         o1 = __builtin_amdgcn_mfma_f32_32x32x16_bf16(vf, __builtin_bit_cast(bf16x8, pw[ks]), o1, 0, 0, 0);
                }
        }
        const int ahead = NT - 2 - t;
        if (MODE == 1) { if (ahead >= 2) WAITBAR(6); else if (ahead == 1) WAITBAR(3); else WAITBAR(0); }
        else           { if (ahead >= 2) WAITBAR(4); else if (ahead == 1) WAITBAR(2); else WAITBAR(0); }
    }
    const float l_tot = swap_add(l_run);
    if (MODE == 3 || MODE == 4) {
        constexpr size_t PSEL = (MODE == 4) ? 1 : 0;
        float* po = PO + PSEL * PO_STRIDE + ((size_t)(rowbase + qtok) * 4 + hsel) * 64;
#pragma unroll
        for (int d0 = 0; d0 < 2; ++d0)
#pragma unroll
            for (int g4 = 0; g4 < 4; ++g4) { const int dim = 32 * d0 + 8 * g4 + 4 * hi;
                *(f32x4*)(po + dim) = (d0 == 0) ? (f32x4){o0[4 * g4], o0[4 * g4 + 1], o0[4 * g4 + 2], o0[4 * g4 + 3]} : (f32x4){o1[4 * g4], o1[4 * g4 + 1], o1[4 * g4 + 2], o1[4 * g4 + 3]}; }
        if (hi == 0) *(f32x2*)(PML + PSEL * PML_STRIDE + ((size_t)(rowbase + qtok) * 4 + hsel) * 2) = (f32x2){m_run, l_tot};
    } else {
        float sc_o = 1.f, sc_p = 0.f, sc_q = 0.f, L = l_tot;
        const float* po = PO + ((size_t)(rowbase + qtok) * 4 + hsel) * 64;
        if (MODE == 2) {
            const f32x2 ml = *(const f32x2*)(PML + ((size_t)(rowbase + qtok) * 4 + hsel) * 2), ml1 = *(const f32x2*)(PML + PML_STRIDE + ((size_t)(rowbase + qtok) * 4 + hsel) * 2);
            const float M = __builtin_fmaxf(__builtin_fmaxf(m_run, ml.x), ml1.x);
            sc_o = __builtin_amdgcn_exp2f(m_run - M); sc_p = __builtin_amdgcn_exp2f(ml.x - M); sc_q = __builtin_amdgcn_exp2f(ml1.x - M);
            L = l_tot * sc_o + ml.y * sc_p + ml1.y * sc_q;
        }
        const float inv = 1.f / L;
        const bf16_t* grow = qrow + p_col(C_GA + ycol); const int yr_ = rowbase + qtok;
#pragma unroll
        for (int d0 = 0; d0 < 2; ++d0)
#pragma unroll
            for (int g4 = 0; g4 < 4; ++g4) {
                const int dim = 32 * d0 + 8 * g4 + 4 * hi;
                const s16x4 gt = *(const s16x4*)(grow + p_col(dim));
                f32x4 pp = {0.f, 0.f, 0.f, 0.f}, pq = {0.f, 0.f, 0.f, 0.f}; if (MODE == 2) { pp = *(const f32x4*)(po + dim); pq = *(const f32x4*)(po + PO_STRIDE + dim); }
                float v[4];
#pragma unroll
                for (int e = 0; e < 4; ++e) v[e] = ((d0 == 0 ? o0[4 * g4 + e] : o1[4 * g4 + e]) * sc_o + pp[e] * sc_p + pq[e] * sc_q) * inv * bf2f(gt[e]);
                *(unsigned*)((unsigned char*)Y + g_off(yr_, ycol8 + dim, YP)) = pk4_fp8(v[0] * F8_SY, v[1] * F8_SY, v[2] * F8_SY, v[3] * F8_SY);
            }
        if ((MODE == 0 || MODE == 1) && hsel == 5) {
#pragma unroll
            for (int j = 0; j < 4; ++j) *(u32x4*)((unsigned char*)Y + g_off(yr_, ycol8 + 64 + 64 * hi + 16 * j, YP)) = (u32x4){0u, 0u, 0u, 0u};
        }
    }
#undef TILE_INFO
#undef KCOL
#undef VCOL
#undef QCOL
#undef ISSUE
}

template <int MODE>
__device__ __forceinline__ void attn_unit2(LAS unsigned char* lds, const bf16_t* __restrict__ P, bf16_t* __restrict__ Y, const u64* __restrict__ bits, int rowbase, int hsel, int blk, int wave) {
    wave = opaque_wave(wave);
    const int tid = opaque_tid(wave), lane = tid & 63, r32 = lane & 31, hi = lane >> 5; const int wid = wave;
    const float NEG = -INFINITY;
    const int T0a = (MODE == 0) ? 512 * blk : 256 * blk, T0b = (MODE == 0) ? T0a + 256 : T0a;
    const int NT = (MODE == 0) ? 8 * (blk + 1) : 4 * (blk + 1);
    const int kcol = (MODE == 0) ? (C_AK + 64 * hsel) : C_BK, vcol = (MODE == 0) ? (C_AV + 64 * hsel) : C_BV;
#define T2_ROW0(t) ((MODE == 1) ? 64 * (t) : ((t) < 4) ? (T0b + 64 * (t)) : ((t) < 8) ? (T0a + 64 * ((t) - 4)) : 64 * ((t) - 8))
    int qw0[2], qpos[2]; qw0[0] = T0a + wid * 32; qw0[1] = T0b + wid * 32; qpos[0] = qw0[0] + r32; qpos[1] = qw0[1] + r32;
    const unsigned lds0 = (unsigned)(uintptr_t)lds;
    const u64* brow_dma = bits + ((size_t)((rowbase + T0a) >> 5) + wid) * 1024 + (lane >> 1);
    const char* kbase_l = (const char*)(P + p_off(rowbase + lane, wid * 8));
    const char* vbase_l = (const char*)(P + p_off(rowbase + 16 * (wid & 3) + (lane >> 2), (wid >> 2) * 32 + (lane & 3) * 8));
#define ISSUE2(t) do { const int row0_ = T2_ROW0(t); const int slot_ = (t) & (NSLOT - 1); \
        const size_t ko_ = (p_off(row0_, 0) + p_col(kcol)) * 2, vo_ = (p_off(row0_, 0) + p_col(vcol)) * 2;     \
        glds16(kbase_l + ko_, (unsigned)__builtin_amdgcn_readfirstlane(lds0 + L_K + slot_ * SLOTB + wid * 1024)); \
        glds16(vbase_l + vo_, (unsigned)__builtin_amdgcn_readfirstlane(lds0 + L_V + slot_ * SLOTB + wid * 1024)); \
        if (MODE == 1) glds4((const unsigned*)(brow_dma + (t) * 32) + (lane & 1), (unsigned)__builtin_amdgcn_readfirstlane(lds0 + L_M + slot_ * 2048 + wid * 256)); } while (0)
    asm volatile("s_waitcnt vmcnt(0)" ::: "memory");
    ISSUE2(0); ISSUE2(1); ISSUE2(2);
    bf16x8 qr[2][4];
#pragma unroll
    for (int g = 0; g < 2; ++g) { const bf16_t* qrow = P + p_off(rowbase + qpos[g], (MODE == 0) ? (C_AQ + 64 * hsel) : (C_BQ + 64 * (2 * hsel + g)));
#pragma unroll
        for (int d0 = 0; d0 < 4; ++d0) qr[g][d0] = *(const bf16x8*)(qrow + p_col(d0 * 16 + hi * 8)); }
    unsigned sel[2] = {0u, 0u};
    if (MODE == 0) {
        LAS float* km = (LAS float*)(lds + L_KM);
        if (wid < 2 * blk + 1) {
            const int c = lane & 7, rg = lane >> 3; float a[8];
#pragma unroll
            for (int e = 0; e < 8; ++e) a[e] = 0.f;
            const bf16_t* kp = P + p_off(rowbase + 256 * wid + rg, C_AK + 64 * hsel + 8 * c);
#pragma unroll 8
            for (int i = 0; i < 32; ++i) { const bf16x8 v = *(const bf16x8*)(kp + (size_t)(i >> 1) * PBLK * 512 + (size_t)(i & 1) * 256);
#pragma unroll
                for (int e = 0; e < 8; ++e) a[e] += bf2f(v[e]); }
#pragma unroll
            for (int e = 0; e < 8; ++e) { a[e] += shfl_xor_l(a[e], 8, lane); a[e] += shfl_xor_l(a[e], 16, lane); a[e] += shfl_xor_l(a[e], 32, lane); }
            if (rg == 0) {
#pragma unroll
                for (int e = 0; e < 8; ++e) km[wid * 64 + 8 * c + e] = a[e] * (1.f / 256.f);
            }
        }
        __syncthreads();
#pragma unroll
        for (int g = 0; g < 2; ++g) {
            const int nb = 2 * blk + g;
            float gt[7];
#pragma unroll
            for (int j = 0; j < 7; ++j) {
                float part = 0.f;
                if (j < nb) {
#pragma unroll
                    for (int d0 = 0; d0 < 4; ++d0) { const f32x4 k0 = *(const LAS f32x4*)(km + j * 64 + 16 * d0 + 8 * hi), k1 = *(const LAS f32x4*)(km + j * 64 + 16 * d0 + 8 * hi + 4);
#pragma unroll
                        for (int e = 0; e < 4; ++e) part += bf2f(qr[g][d0][e]) * k0[e] + bf2f(qr[g][d0][4 + e]) * k1[e]; }
                    part = swap_add(part);
                }
                gt[j] = (j < nb) ? part : NEG;
            }
            unsigned s_ = 0u;
#pragma unroll
            for (int rep = 0; rep < 3; ++rep) { float bv = NEG; int best = -1;
#pragma unroll
                for (int j = 0; j < 7; ++j) { const bool ok = (j < nb) && !((s_ >> j) & 1u) && (gt[j] > bv); if (ok) { bv = gt[j]; best = j; } }
                if (best >= 0) s_ |= 1u << best; }
            sel[g] = s_;
        }
    }
    f32x16 o0[2], o1[2]; float m_run[2], l_run[2], mx_run[2]; bool shifted[2];
#pragma unroll
    for (int g = 0; g < 2; ++g) { o0[g] = (f32x16){}; o1[g] = (f32x16){}; m_run[g] = 0.f; l_run[g] = 0.f; mx_run[g] = NEG; shifted[g] = false; }
    constexpr float SHIFT_THR = 64.f;
    const lds_cptr lds3 = (lds_cptr)lds;
    const lds_cptr kp0 = lds3 + L_K + hi * 1024 + r32 * 16;
    const lds_cptr vp0 = lds3 + L_V + ((lane >> 4) & 1) * 32 + (lane & 3) * 8 + (4 * hi + ((lane & 15) >> 2)) * 64;
    const lds_cptr mp0 = lds3 + L_M + (32 * wid + r32) * 8;
#pragma unroll
    for (int g = 0; g < 2; ++g)
#pragma unroll
        for (int d0 = 0; d0 < 4; ++d0) asm volatile("" : "+v"(qr[g][d0]));
    if (MODE == 1 && tid < 16) {
        f32x4 e; e[0] = (tid & 1) ? 0.f : NEG; e[1] = (tid & 2) ? 0.f : NEG; e[2] = (tid & 4) ? 0.f : NEG; e[3] = (tid & 8) ? 0.f : NEG;
        *(LAS f32x4*)(lds + L_LUT + 16 * tid) = e;
    }
    WAITBAR(0);
    if (wid < 4) __builtin_amdgcn_s_setprio(2); else __builtin_amdgcn_s_setprio(0);
    for (int t = 0; t < NT; ++t) {
        const int row0 = T2_ROW0(t);
        bool act[2];
        if (MODE == 0) {
            const int b = row0 >> 8;
#pragma unroll
            for (int g = 0; g < 2; ++g) { const int own = 2 * blk + g; act[g] = (b == own) ? (row0 <= qw0[g] + 31) : (b < own) ? (__any((sel[g] >> b) & 1u) != 0) : false; }
        } else { act[0] = act[1] = (row0 <= qw0[0] + 31); }
        const int slot = (t & (NSLOT - 1)) * SLOTB;
        u32x2 mw = {0u, 0u}; if (MODE == 1 && act[0]) mw = *(const LAS u32x2*)(mp0 + (t & (NSLOT - 1)) * 2048);
        if (t + 3 < NT) ISSUE2(t + 3);
#pragma unroll
        for (int g = 0; g < 2; ++g) {
          if (act[g]) {
            f32x16 p0 = {}, p1 = {};
            if (MODE == 1) {
                const unsigned lo = mw.x >> (4 * hi), hw = mw.y >> (4 * hi);
                const lds_cptr lut = lds3 + L_LUT;
#pragma unroll
                for (int k = 0; k < 4; ++k) {
                    const f32x4 b0 = *(const LAS f32x4*)(lut + (((lo >> (8 * k)) & 15u) << 4)), b1 = *(const LAS f32x4*)(lut + (((hw >> (8 * k)) & 15u) << 4));
#pragma unroll
                    for (int j = 0; j < 4; ++j) { p0[4 * k + j] = b0[j]; p1[4 * k + j] = b1[j]; }
                }
            }
            __builtin_amdgcn_sched_barrier(0);
            { const lds_cptr kp = kp0 + slot;
              bf16x8 ka[4], kb[4];
#pragma unroll
              for (int j = 0; j < 4; ++j) { ka[j] = *(const LAS bf16x8*)(kp + j * 2048); kb[j] = *(const LAS bf16x8*)(kp + j * 2048 + 512); }
              p0 = __builtin_amdgcn_mfma_f32_32x32x16_bf16(ka[0], qr[g][0], p0, 0, 0, 0);
              p1 = __builtin_amdgcn_mfma_f32_32x32x16_bf16(kb[0], qr[g][0], p1, 0, 0, 0);
#pragma unroll
              for (int d0 = 1; d0 < 4; ++d0) { p0 = __builtin_amdgcn_mfma_f32_32x32x16_bf16(ka[d0], qr[g][d0], p0, 0, 0, 0); p1 = __builtin_amdgcn_mfma_f32_32x32x16_bf16(kb[d0], qr[g][d0], p1, 0, 0, 0); } }
            __builtin_amdgcn_sched_group_barrier(0x100, 4, 0);
#pragma unroll
            for (int i = 0; i < 4; ++i) { __builtin_amdgcn_sched_group_barrier(0x008, 1, 0); __builtin_amdgcn_sched_group_barrier(0x100, 1, 0); }
            __builtin_amdgcn_sched_group_barrier(0x008, 4, 0);
            __builtin_amdgcn_sched_barrier(0);
            s16x4 vl0[4], vh0[4];
            { const lds_cptr vp = vp0 + slot;
#pragma unroll
              for (int ks = 0; ks < 4; ++ks) { vl0[ks] = vtr(vp + ks * 1024); vh0[ks] = vtr(vp + ks * 1024 + 512); } }
            __builtin_amdgcn_sched_barrier(0);
            if (shifted[g]) {
#pragma unroll
                for (int r = 0; r < 16; ++r) { p0[r] -= m_run[g]; p1[r] -= m_run[g]; } }
            if (MODE == 0) {
                if ((row0 >> 8) == 2 * blk + g) { if (row0 + 63 > qw0[g]) { const int kb_ = row0 + 4 * hi;
#pragma unroll
                    for (int r = 0; r < 16; ++r) { const int kv = kb_ + (r & 3) + 8 * (r >> 2); if (kv > qpos[g]) p0[r] = NEG; if (kv + 32 > qpos[g]) p1[r] = NEG; } } }
                else { if (!((sel[g] >> (row0 >> 8)) & 1u)) { float ng = NEG; asm volatile("" : "+v"(ng));
#pragma unroll
                    for (int r = 0; r < 16; ++r) { p0[r] = ng; p1[r] = ng; } } }
            }
            asm volatile("s_nop 11" : "+v"(p0), "+v"(p1));
            float ma = fmax3_s(p0[0], p0[1], p1[0]), mb = fmax3_s(p0[2], p0[3], p1[1]);
            ma = fmax3_s(ma, p1[2], p1[3]);
#pragma unroll
            for (int r = 4; r < 16; r += 4) { ma = fmax3_s(ma, p0[r], p0[r + 1]); mb = fmax3_s(mb, p0[r + 2], p0[r + 3]);
                ma = fmax3_s(ma, p1[r], p1[r + 1]); mb = fmax3_s(mb, p1[r + 2], p1[r + 3]); }
            const float rm = swap_max(__builtin_fmaxf(ma, mb));
            const bool up = rm > SHIFT_THR, down = (mx_run[g] == NEG) && (rm < -SHIFT_THR) && (rm != NEG);
            if (__any(up || down)) {
                const float dl = (up || down) ? rm : 0.f; m_run[g] += dl; shifted[g] = true;
                const float f = __builtin_amdgcn_exp2f(-dl); l_run[g] *= f;
#pragma unroll
                for (int r = 0; r < 16; ++r) { p0[r] -= dl; p1[r] -= dl; o0[g][r] *= f; o1[g][r] *= f; }
                mx_run[g] = __builtin_fmaxf(mx_run[g], rm);
            } else mx_run[g] = __builtin_fmaxf(mx_run[g], rm);
            float ls0 = 0.f, ls1 = 0.f;
#pragma unroll
            for (int r = 0; r < 16; ++r) { p0[r] = __builtin_amdgcn_exp2f(p0[r]); p1[r] = __builtin_amdgcn_exp2f(p1[r]); }
            asm volatile("" : "+v"(p0), "+v"(p1));
#pragma unroll
            for (int r = 0; r < 16; ++r) { ls0 = fadd_s(ls0, p0[r]); ls1 = fadd_s(ls1, p1[r]); }
            l_run[g] = fadd_s(l_run[g], fadd_s(ls0, ls1));
            u32x4 pw[4];
            pw[0] = (u32x4){cvtpk(p0[0], p0[1]), cvtpk(p0[2], p0[3]), cvtpk(p0[4], p0[5]), cvtpk(p0[6], p0[7])};
            pw[1] = (u32x4){cvtpk(p0[8], p0[9]), cvtpk(p0[10], p0[11]), cvtpk(p0[12], p0[13]), cvtpk(p0[14], p0[15])};
            pw[2] = (u32x4){cvtpk(p1[0], p1[1]), cvtpk(p1[2], p1[3]), cvtpk(p1[4], p1[5]), cvtpk(p1[6], p1[7])};
            pw[3] = (u32x4){cvtpk(p1[8], p1[9]), cvtpk(p1[10], p1[11]), cvtpk(p1[12], p1[13]), cvtpk(p1[14], p1[15])};
            __builtin_amdgcn_sched_barrier(0);
            { const lds_cptr vp = vp0 + slot + 4096;
              s16x4 vl1[4], vh1[4];
#pragma unroll
              for (int ks = 0; ks < 4; ++ks) { vl1[ks] = vtr(vp + ks * 1024); vh1[ks] = vtr(vp + ks * 1024 + 512); }
#pragma unroll
              for (int ks = 0; ks < 4; ++ks) { const bf16x8 vf = (bf16x8){vl0[ks][0], vl0[ks][1], vl0[ks][2], vl0[ks][3], vh0[ks][0], vh0[ks][1], vh0[ks][2], vh0[ks][3]};
                  o0[g] = __builtin_amdgcn_mfma_f32_32x32x16_bf16(vf, __builtin_bit_cast(bf16x8, pw[ks]), o0[g], 0, 0, 0); }
#pragma unroll
              for (int ks = 0; ks < 4; ++ks) { const bf16x8 vf = (bf16x8){vl1[ks][0], vl1[ks][1], vl1[ks][2], vl1[ks][3], vh1[ks][0], vh1[ks][1], vh1[ks][2], vh1[ks][3]};
                  o1[g] = __builtin_amdgcn_mfma_f32_32x32x16_bf16(vf, __builtin_bit_cast(bf16x8, pw[ks]), o1[g], 0, 0, 0); } }
#pragma unroll
            for (int i = 0; i < 4; ++i) { __builtin_amdgcn_sched_group_barrier(0x100, 2, 0); __builtin_amdgcn_sched_group_barrier(0x008, 1, 0); }
            __builtin_amdgcn_sched_group_barrier(0x008, 4, 0);
            __builtin_amdgcn_sched_barrier(0);
          }
          __builtin_amdgcn_sched_barrier(0);
        }
        const int ahead = NT - 2 - t;
        if (MODE == 1) { if (ahead >= 2) WAITBAR(6); else if (ahead == 1) WAITBAR(3); else WAITBAR(0); }
        else           { if (ahead >= 2) WAITBAR(4); else if (ahead == 1) WAITBAR(2); else WAITBAR(0); }
    }
    __builtin_amdgcn_s_setprio(0);
#pragma unroll
    for (int g = 0; g < 2; ++g) {
        const int head = (MODE == 0) ? hsel : 2 * hsel + g;
        const float inv = 1.f / swap_add(l_run[g]);
        const bf16_t* grow = P + p_off(rowbase + qpos[g], C_GA + ((MODE == 0) ? 0 : 384) + 64 * head);
        const int yr_ = rowbase + qpos[g], yc_ = ((MODE == 0) ? 0 : 512) + 64 * head;
#pragma unroll
        for (int d0 = 0; d0 < 2; ++d0)
#pragma unroll
            for (int g4 = 0; g4 < 4; ++g4) {
                const int dim = 32 * d0 + 8 * g4 + 4 * hi;
                const s16x4 gt = *(const s16x4*)(grow + p_col(dim));
                float v[4];
#pragma unroll
                for (int e = 0; e < 4; ++e) v[e] = (d0 == 0 ? o0[g][4 * g4 + e] : o1[g][4 * g4 + e]) * inv * bf2f(gt[e]);
                *(unsigned*)((unsigned char*)Y + g_off(yr_, yc_ + dim, YP)) = pk4_fp8(v[0] * F8_SY, v[1] * F8_SY, v[2] * F8_SY, v[3] * F8_SY);
            }
        if (head == 5) {
#pragma unroll
            for (int j = 0; j < 4; ++j) *(u32x4*)((unsigned char*)Y + g_off(yr_, yc_ + 64 + 64 * hi + 16 * j, YP)) = (u32x4){0u, 0u, 0u, 0u};
        }
    }
#undef T2_ROW0
#undef ISSUE2
}

__device__ __forceinline__ unsigned f2key(float f) { unsigned u = __float_as_uint(f); if (u == 0x80000000u) u = 0u; return (u & 0x80000000u) ? ~u : (u | 0x80000000u); }
__device__ __forceinline__ float key2f(unsigned k) { const unsigned u = (k & 0x80000000u) ? (k & 0x7fffffffu) : ~k; return __uint_as_float(u); }
__device__ __forceinline__ unsigned wave_sum_dpp(unsigned x) {
    x += (unsigned)__builtin_amdgcn_update_dpp(0, (int)x, 0xB1, 0xf, 0xf, false);
    x += (unsigned)__builtin_amdgcn_update_dpp(0, (int)x, 0x4E, 0xf, 0xf, false);
    x += (unsigned)__builtin_amdgcn_update_dpp(0, (int)x, 0x141, 0xf, 0xf, false);
    x += (unsigned)__builtin_amdgcn_update_dpp(0, (int)x, 0x140, 0xf, 0xf, false);
    x += (unsigned)__builtin_amdgcn_update_dpp(0, (int)x, 0x142, 0xa, 0xf, false);
    x += (unsigned)__builtin_amdgcn_update_dpp(0, (int)x, 0x143, 0xc, 0xf, false);
    return (unsigned)__builtin_amdgcn_readlane((int)x, 63);
}
__device__ __forceinline__ void cnt4(unsigned& na, unsigned& nb, unsigned ka0, unsigned ka1, unsigned kb0, unsigned kb1, unsigned ca, unsigned cb) {
    u64 t1, t2, t3;
    asm("v_cmp_ge_u32_e64 vcc, %[ka0], %[ca]\n\t"
        "v_cmp_ge_u32_e64 %[t1], %[kb0], %[cb]\n\t"
        "v_cmp_ge_u32_e64 %[t2], %[ka1], %[ca]\n\t"
        "v_cmp_ge_u32_e64 %[t3], %[kb1], %[cb]\n\t"
        "v_addc_co_u32_e64 %[na], vcc, 0, %[na], vcc\n\t"
        "v_addc_co_u32_e64 %[nb], %[t1], 0, %[nb], %[t1]\n\t"
        "v_addc_co_u32_e64 %[na], %[t2], 0, %[na], %[t2]\n\t"
        "v_addc_co_u32_e64 %[nb], %[t3], 0, %[nb], %[t3]"
        : [na] "+v"(na), [nb] "+v"(nb), [t1] "=&s"(t1), [t2] "=&s"(t2), [t3] "=&s"(t3)
        : [ka0] "v"(ka0), [ka1] "v"(ka1), [kb0] "v"(kb0), [kb1] "v"(kb1), [ca] "v"(ca), [cb] "v"(cb)
        : "vcc");
}
template <int NREG> __device__ __forceinline__ int count_ge(const unsigned (&key)[32], unsigned cand) {
    unsigned cnt = 0u;
#pragma unroll
    for (int i = 0; i < NREG; ++i) cnt += (key[i] >= cand) ? 1u : 0u;
    int tot = 0;
#pragma unroll
    for (int b = 0; b < 6; ++b) tot += __popcll(__ballot((cnt >> b) & 1u)) << b;
    return tot;
}
template <int NREG> __device__ __forceinline__ void select_unit(LAS unsigned char* lds, const bf16_t* __restrict__ P, const float* __restrict__ IW, u64* __restrict__ bits, int rowbase, int q16, int wave) {
    wave = opaque_wave(wave);
    const int tid = opaque_tid(wave), lane = tid & 63; const int wid = wave;
    const int t0 = 16 * q16, ngroups = q16 + 1;
    const int qi = lane & 15, kq = lane >> 4;
    LAS float* sc = (LAS float*)lds;
    const bool triv = (NREG == 8) && (t0 + 16 <= 256);
    if (!triv) {
        bf16x8 bq[4][2]; float w[4];
        const bf16_t* qp = P + p_off(rowbase + t0 + qi, C_IQ + 8 * kq);
#pragma unroll
        for (int h = 0; h < 4; ++h) { bq[h][0] = *(const bf16x8*)(qp + p_col(64 * h)); bq[h][1] = *(const bf16x8*)(qp + p_col(64 * h + 32)); }
        { const f32x4 wv = *(const f32x4*)(IW + (size_t)(rowbase + t0 + qi) * 4); w[0] = wv[0]; w[1] = wv[1]; w[2] = wv[2]; w[3] = wv[3]; }
        const bf16_t* kbase = (const bf16_t*)((const char*)P - (WS_P - WS_IKC)) + (size_t)(rowbase + qi) * 32 + 8 * kq;
        constexpr int NG = NREG / 2;
        bf16x8 a[NG][2];
#pragma unroll
        for (int u = 0; u < NG; ++u) { int g = wid + 8 * u; g = g < ngroups ? g : ngroups - 1; const bf16_t* kp = kbase + (size_t)(16 * g) * 32; a[u][0] = *(const bf16x8*)kp; a[u][1] = *(const bf16x8*)(kp + (size_t)MC * 32); }
#pragma unroll
        for (int u = 0; u < NG; ++u) {
            const int g = wid + 8 * u;
            f32x4 s = {0.f, 0.f, 0.f, 0.f};
            f32x4 d[4];
#pragma unroll
            for (int h = 0; h < 4; ++h) {
                d[h] = (f32x4){0.f, 0.f, 0.f, 0.f};
                d[h] = __builtin_amdgcn_mfma_f32_16x16x32_bf16(a[u][0], bq[h][0], d[h], 0, 0, 0);
                d[h] = __builtin_amdgcn_mfma_f32_16x16x32_bf16(a[u][1], bq[h][1], d[h], 0, 0, 0);
            }
            asm volatile("s_nop 11" : "+v"(d[0]), "+v"(d[1]), "+v"(d[2]), "+v"(d[3]));
#pragma unroll
            for (int h = 0; h < 4; ++h)
#pragma unroll
                for (int e = 0; e < 4; ++e) { float r_; asm("v_max_f32_e32 %0, 0, %1" : "=v"(r_) : "v"(d[h][e])); float se = s[e]; asm("v_fmac_f32_e32 %0, %1, %2" : "+v"(se) : "v"(r_), "v"(w[h])); s[e] = se; }
            if (g < ngroups) *(LAS f32x4*)(sc + qi * SCORE_PITCH + 16 * g + 4 * kq) = s;
        }
    }
    __syncthreads();
    {
        const int qA = 2 * wid, tA = t0 + qA, tB = tA + 1;
        unsigned kA[32], kB[32];
#pragma unroll
        for (int i = 0; i < NREG; ++i) {
            const int idx = lane + 64 * i;
            const float va = sc[qA * SCORE_PITCH + idx], vb = sc[(qA + 1) * SCORE_PITCH + idx];
            const unsigned ka = triv ? 2u : f2key(va), kb = triv ? 2u : f2key(vb);
            kA[i] = (idx <= tA) ? ka : 0u; kB[i] = (idx <= tB) ? kb : 0u;
        }
        unsigned TA = 1u, TB = 1u; bool dA = (tA + 1 <= 256), dB = (tB + 1 <= 256);
        if (!dB) {
            TA = dA ? 1u : 0u; TB = 0u;
            for (int bit = 31; bit >= 0; --bit) {
                if (dA && dB) break;
                const unsigned cA = TA | (1u << bit), cB = TB | (1u << bit);
                unsigned ca = 0u, cb = 0u;
#pragma unroll
                for (int i = 0; i < NREG; i += 2) cnt4(ca, cb, kA[i], kA[i + 1], kB[i], kB[i + 1], cA, cB);
                const unsigned tot = wave_sum_dpp(ca | (cb << 16));
                const int nA = (int)(tot & 0xffffu), nB = (int)(tot >> 16);
                if (!dA) { if (nA >= 256) TA = cA; if (nA == 256) dA = true; }
                if (!dB) { if (nB >= 256) TB = cB; if (nB == 256) dB = true; }
            }
        }
        const u64 lt_mask = (lane == 0) ? 0ull : (~0ull >> (64 - lane));
#pragma unroll 1
        for (int rr = 0; rr < 2; ++rr) {
            const unsigned T = rr ? TB : TA; const int t = tA + rr;
            unsigned cge = 0u;
#pragma unroll
            for (int i = 0; i < NREG; ++i) { const unsigned kk_ = rr ? kB[i] : kA[i]; cge += (kk_ > T) ? 1u : 0u; cge += (kk_ == T) ? 0x10000u : 0u; }
            const unsigned tote = wave_sum_dpp(cge);
            const int cgt = (int)(tote & 0xffffu), ceq = (int)(tote >> 16);
            const int need = 256 - cgt;
            unsigned mine_lo = 0u, mine_hi = 0u;
            if (need <= 0 || need >= ceq) {
                const unsigned Tc = (need <= 0) ? T + 1u : T;
#define SEL_FAST(i) do { if ((i) < NREG) { const unsigned kk_ = rr ? kB[i] : kA[i]; const u64 wsel = __ballot(kk_ >= Tc); \
            const unsigned wl_ = (unsigned)wsel, wh_ = (unsigned)(wsel >> 32); \
            asm volatile("s_nop 1\n\tv_writelane_b32 %0, %2, " #i "\n\tv_writelane_b32 %1, %3, " #i : "+v"(mine_lo), "+v"(mine_hi) : "s"(wl_), "s"(wh_)); if (((i) & 3) == 3) __builtin_amdgcn_sched_barrier(0); } } while (0)
                SEL_FAST(0); SEL_FAST(1); SEL_FAST(2); SEL_FAST(3); SEL_FAST(4); SEL_FAST(5); SEL_FAST(6); SEL_FAST(7);
                SEL_FAST(8); SEL_FAST(9); SEL_FAST(10); SEL_FAST(11); SEL_FAST(12); SEL_FAST(13); SEL_FAST(14); SEL_FAST(15);
                SEL_FAST(16); SEL_FAST(17); SEL_FAST(18); SEL_FAST(19); SEL_FAST(20); SEL_FAST(21); SEL_FAST(22); SEL_FAST(23);
                SEL_FAST(24); SEL_FAST(25); SEL_FAST(26); SEL_FAST(27); SEL_FAST(28); SEL_FAST(29); SEL_FAST(30); SEL_FAST(31);
#undef SEL_FAST
            } else {
                int run = 0;
#define SEL_EMIT(i) do { if ((i) < NREG) { const unsigned kk_ = rr ? kB[i] : kA[i]; const bool eq = (kk_ == T) && (kk_ != 0u); const u64 beq = __ballot(eq); const int rank = run + __popcll(beq & lt_mask); \
            const bool s_ = (kk_ > T) || (eq && rank < need); const u64 wsel = __ballot(s_); run += __popcll(beq); \
            const unsigned wl_ = (unsigned)wsel, wh_ = (unsigned)(wsel >> 32); \
            asm volatile("s_nop 1\n\tv_writelane_b32 %0, %2, " #i "\n\tv_writelane_b32 %1, %3, " #i : "+v"(mine_lo), "+v"(mine_hi) : "s"(wl_), "s"(wh_)); if (((i) & 3) == 3) __builtin_amdgcn_sched_barrier(0); } } while (0)
                SEL_EMIT(0); SEL_EMIT(1); SEL_EMIT(2); SEL_EMIT(3); SEL_EMIT(4); SEL_EMIT(5); SEL_EMIT(6); SEL_EMIT(7);
                SEL_EMIT(8); SEL_EMIT(9); SEL_EMIT(10); SEL_EMIT(11); SEL_EMIT(12); SEL_EMIT(13); SEL_EMIT(14); SEL_EMIT(15);
                SEL_EMIT(16); SEL_EMIT(17); SEL_EMIT(18); SEL_EMIT(19); SEL_EMIT(20); SEL_EMIT(21); SEL_EMIT(22); SEL_EMIT(23);
                SEL_EMIT(24); SEL_EMIT(25); SEL_EMIT(26); SEL_EMIT(27); SEL_EMIT(28); SEL_EMIT(29); SEL_EMIT(30); SEL_EMIT(31);
#undef SEL_EMIT
            }
            if (lane < 32) bits[((size_t)((rowbase + t) >> 5) * 32 + lane) * 32 + ((rowbase + t) & 31)] = ((u64)mine_hi << 32) | (u64)mine_lo;
        }
    }
    __syncthreads();
}
}

struct Args { const float* x; const float* norm_g; const float* w_in; const float* w_br_a; const float* w_br_b; const float* w_br_c; const float* w_out; const float* final_g;
              float* out; unsigned char* ws; int ph_lo, ph_hi; };

constexpr int WI_IN = (DM / 64) * (C_F8 / 32), WI_IN8 = (DM / 64) * ((NW - C_F8) / 32), WI_BA = (384 / 64) * (DM / 32), WI_BC = (256 / 64) * (DM / 32), WI_O = (DM / 64) * (DM / 32);
constexpr int WPER_L = WI_IN + WI_IN8 + 2 * WI_BA + WI_BC + WI_O;
__device__ __forceinline__ void weight_item(const Args& args, bf16_t* WIN, bf16_t* WBR, bf16_t* WOUT, int l, int r, LAS float* scr, int lane_) {
    if (r < WI_IN) { transpose_item<true>(args.w_in + (size_t)l * DM * INW, INW, C_F8 / 32, WIN + (size_t)l * NW * DM, DM, 0, scr, r, lane_); return; } r -= WI_IN;
    if (r < WI_IN8) { transpose_item<true, true>(args.w_in + (size_t)l * DM * INW, INW, (NW - C_F8) / 32, WIN + (size_t)l * NW * DM + (size_t)C_F8 * DM, DM, 0, scr, r, lane_, C_F8, C_F8); return; } r -= WI_IN8;
    if (r < WI_BA) { transpose_item<false, true>(args.w_br_a + (size_t)l * 384 * DM, DM, DM / 32, WBR + (size_t)l * DM * DM, YP, 0, scr, r, lane_); return; } r -= WI_BA;
    if (r < WI_BA) { transpose_item<false, true>(args.w_br_b + (size_t)l * 384 * DM, DM, DM / 32, WBR + (size_t)l * DM * DM, YP, 512, scr, r, lane_); return; } r -= WI_BA;
    if (r < WI_BC) { transpose_item<false, true>(args.w_br_c + (size_t)l * 256 * DM, DM, DM / 32, WBR + (size_t)l * DM * DM, YP, 1024, scr, r, lane_); return; } r -= WI_BC;
    transpose_item<false, true>(args.w_out + (size_t)l * DM * DM, DM, DM / 32, WOUT + (size_t)l * DM * DM, DM, 0, scr, r, lane_);
}

__device__ __forceinline__ bool attn_work(int idx, int& mode, int& level, int& sub) {
    int r = idx;
#define AW(m_, l_) do { const int cnt = ((m_) == 2) ? 32 : ((m_) == 1) ? 24 : 48; if (r < cnt) { mode = (m_); level = (l_); sub = r; return true; } r -= cnt; } while (0)
    AW(1, 7); AW(0, 3); AW(1, 6); AW(1, 5); AW(0, 2); AW(1, 4); AW(1, 3); AW(0, 1); AW(1, 2); AW(1, 1); AW(0, 0); AW(1, 0);
    AW(2, 7); AW(2, 6); AW(2, 5); AW(2, 4); AW(2, 3); AW(2, 2); AW(2, 1); AW(2, 0);
#undef AW
    return false;
}

__global__ void __launch_bounds__(NWAVES * 64, 2) mega_fwd(Args args) {
    extern __shared__ __attribute__((aligned(16))) unsigned char lds_raw[];
    Frame F;
    F.lds = (LAS unsigned char*)lds_raw;
    F.MISC = (volatile LAS unsigned*)(F.lds + MISC_OFF);
    F.tid = threadIdx.x; F.lane = F.tid & 63; F.wave = __builtin_amdgcn_readfirstlane(F.tid >> 6);
    F.G = gridDim.x;
    unsigned char* ws = args.ws;
    F.ctl = (gu32*)(ws + WS_CTL);
    for (int u = F.tid; u < (LDS_BYTES - LDSCTL_OFF) / 4; u += NWAVES * 64) ((LAS unsigned*)(F.lds + LDSCTL_OFF))[u] = 0u;
    __syncthreads();
    XcdBarrier bar; bar.bar = (unsigned*)(F.ctl + CW_BAR); bar.x = 0; bar.st = nullptr;
    if (MK_N_LAUNCHES == 1) bar = xcd_barrier_post((unsigned*)(F.ctl + CW_BAR), F.MISC + 8);
#define GRID_BAR() do { if (MK_N_LAUNCHES == 1) xcd_barrier<false>(bar, F.wave); } while (0)
#define GRID_BAR_FIRST() do { if (MK_N_LAUNCHES == 1) xcd_barrier<true>(bar, F.wave); } while (0)
    const int lo = args.ph_lo, hi = args.ph_hi;
#define IN(k) (lo <= (k) && (k) < hi)
#define BOTH(k) (IN(k) && IN((k) + 1))

#define WSPTRS() unsigned char* wsl = launder(args.ws); float* cosT = (float*)(wsl + WS_ROPE); float* sinT = cosT + SEQ * 32; float* IWb = (float*)(wsl + WS_IW); unsigned char* H8b = wsl + WS_H8; \
    bf16_t* WIN = (bf16_t*)(wsl + WS_WIN); bf16_t* WBR = (bf16_t*)(wsl + WS_WBR); bf16_t* WOUT = (bf16_t*)(wsl + WS_WOUT); u64* BITS = (u64*)(wsl + WS_BITS); \
    bf16_t* Hb = (bf16_t*)(wsl + WS_H); bf16_t* Hb1 = (bf16_t*)(wsl + WS_H1); float* POb = (float*)(wsl + WS_PO); float* PMLb = (float*)(wsl + WS_PML); bf16_t* Yb = (bf16_t*)(wsl + WS_Y); bf16_t* MGb = (bf16_t*)(wsl + WS_MERGED); bf16_t* Pb = (bf16_t*)(wsl + WS_P); unsigned char* MG8b = wsl + WS_MG8; \
    gu32* ctl = (gu32*)(wsl + WS_CTL); \
    (void)cosT; (void)sinT; (void)IWb; (void)H8b; (void)WIN; (void)WBR; (void)WOUT; (void)BITS; (void)Hb; (void)Hb1; (void)POb; (void)PMLb; (void)Yb; (void)MGb; (void)Pb; (void)MG8b; (void)ctl
    const int NGW = F.G * NWAVES;
    const bool fuse_fin = (MK_N_LAUNCHES == 1) && (EN_MASK == 0xFF) && F.G == (MC / 256) * (DM / 256);
#define PHASE_IDS() const int wave_ = opaque_wave(F.wave); const int tid_ = opaque_tid(wave_); const int lane_ = tid_ & 63; const int gw = blockIdx.x * NWAVES + wave_; (void)lane_; (void)gw

    if (EN(0)) {
        WSPTRS(); PHASE_IDS();
        LAS float* scr = (LAS float*)(F.lds + wave_ * 16384);
        for (int it = gw; it < WPER_L; it += NGW) weight_item(args, WIN, WBR, WOUT, 0, it, scr, lane_);
        for (int e = blockIdx.x * (NWAVES * 64) + tid_; e < DEPTH * DM * 16; e += F.G * NWAVES * 64) {
            const int l = e / (DM * 16), n = (e / 16) % DM, j = e % 16;
            *(u32x4*)((unsigned char*)(WBR + (size_t)l * DM * DM) + (size_t)n * YP + (j < 8 ? 384 : 896 - 128) + 16 * j) = (u32x4){0u, 0u, 0u, 0u};
        }
        for (int e = blockIdx.x * (NWAVES * 64) + tid_; e < SEQ * 32; e += F.G * NWAVES * 64) {
            const int t = e >> 5, f = e & 31;
            const float inv_freq = 1.0f / powf(10000.0f, (float)(2 * f) / 64.0f);
            const float ang = (float)t * inv_freq;
            const double rev = (double)ang * 0.15915494309189535;
            const float fr = (float)(rev - __builtin_rint(rev));
            cosT[e] = __builtin_amdgcn_cosf(fr); sinT[e] = __builtin_amdgcn_sinf(fr);
        }
        for (int m = 4 * gw; m < BATCH * SEQ; m += 4 * NGW) rms_rows<true, 4>(args.x + (size_t)m * DM, args.norm_g, (m < MC ? Hb + (size_t)m * DM : Hb1 + (size_t)(m - MC) * DM), H8b + (size_t)m * DM, IWb + (size_t)m * 4, args.w_in + 2752, lane_);
    }
    GRID_BAR_FIRST();

#pragma nounroll
    for (int lcx = -1; lcx < DEPTH * NCH; ++lcx) {
        if (lcx >= 0) {
            const int lc = lcx;
            const int l = lc / NCH, c = lc % NCH;
            const float* xin = ((l == 0) ? args.x : (const float*)args.out) + (size_t)c * MC * DM;
            float* xout = args.out + (size_t)c * MC * DM;
            if (EN(3)) for (int rep = 0; rep < NREP(3); ++rep) {
                WSPTRS();
                gu32* qc = ctl + CW_Q + 64 * (((l * NCH + c) * 2 + 0) * 4 + rep);
                for (int nq = 0;; ++nq) {
                    __syncthreads();
                    if (opaque_tid(F.wave) == 0) F.MISC[0] = (nq == 0) ? (unsigned)blockIdx.x : (unsigned)F.G + __hip_atomic_fetch_add(qc, 1u, RLX_AGENT);
                    __syncthreads();
                    const int idx = (int)F.MISC[0];
                    constexpr int NSEL = BPC * 128, NG2 = 2 * BPC * 4 * 8;
                    if (idx >= NSEL + NG2) break;
                    if (idx >= NSEL && idx < NSEL + NG2) { const int j = idx - NSEL;
                        if (j < NG2 / 2) att::attn_unit<4>(F.lds, Pb, Yb, BITS, POb, PMLb, ((j >> 5) & 7) * SEQ, (j >> 3) & 3, 7 - (j & 7), F.wave);
                        else att::attn_unit<3>(F.lds, Pb, Yb, BITS, POb, PMLb, ((j >> 5) & 7) * SEQ, (j >> 3) & 3, j & 7, F.wave);
                        continue; }
                    const int q16 = 127 - (idx >> 3), b = idx & 7;
                    if (q16 < 32) att::select_unit<8>(F.lds, Pb, IWb + (size_t)c * MC * 4, BITS, b * SEQ, q16, F.wave);
                    else if (q16 < 48) att::select_unit<12>(F.lds, Pb, IWb + (size_t)c * MC * 4, BITS, b * SEQ, q16, F.wave);
                    else if (q16 < 64) att::select_unit<16>(F.lds, Pb, IWb + (size_t)c * MC * 4, BITS, b * SEQ, q16, F.wave);
                    else if (q16 < 80) att::select_unit<20>(F.lds, Pb, IWb + (size_t)c * MC * 4, BITS, b * SEQ, q16, F.wave);
                    else if (q16 < 96) att::select_unit<24>(F.lds, Pb, IWb + (size_t)c * MC * 4, BITS, b * SEQ, q16, F.wave);
                    else if (q16 < 112) att::select_unit<28>(F.lds, Pb, IWb + (size_t)c * MC * 4, BITS, b * SEQ, q16, F.wave);
                    else att::select_unit<32>(F.lds, Pb, IWb + (size_t)c * MC * 4, BITS, b * SEQ, q16, F.wave);
                }
                GRID_BAR();
            }
            if (EN(4)) for (int rep = 0; rep < NREP(4); ++rep) {
                WSPTRS();
                gu32* qc = ctl + CW_Q + 64 * (((l * NCH + c) * 2 + 1) * 4 + rep);
                {
                    pg8::Gemm g{(const bf16_t*)(H8b + (size_t)c * MC * DM), WIN + (size_t)l * NW * DM + (size_t)C_F8 * DM}; pg8::TailOrder S; S.init(DM, F.G, (int)blockIdx.x); S.nt = DM / 128;
                    pg8::EpiProj E{Pb, MG8b, cosT, sinT, C_F8, 1.f / (F8_SA * F8_SB)};
                    pg8::gemm_phase<pg8::EpiProj, pg8::TailOrder, true>(F.lds, g, S, E, F.wave);
                }
                for (int nq = 0;; ++nq) {
                    __syncthreads();
                    if (opaque_tid(F.wave) == 0) F.MISC[0] = (nq == 0) ? (unsigned)((blockIdx.x + F.G - 64) % F.G) : (unsigned)F.G + __hip_atomic_fetch_add(qc, 1u, RLX_AGENT);
                    __syncthreads();
                    const int idx = (int)F.MISC[0];
                    int mode, level, sub;
                    if (!attn_work(idx, mode, level, sub)) {
                        constexpr int NATT = 8 * 24 + 4 * 48 + 8 * 32;
                        const int fidx = idx - NATT;
                        if (fidx >= ((rep == 0) ? (lc > 0 ? MC / 64 : WPER_L / 8) : 0)) break;
                        PHASE_IDS();
                        if (lc == 0) { weight_item(args, WIN, WBR, WOUT, 1, fidx * 8 + wave_, (LAS float*)(F.lds + wave_ * 16384), lane_); continue; }
                        const int r0 = fidx * 64 + wave_ * 8;
                        if (lc == 3) { for (int j = 0; j < 8; j += 4) rms_rows<false, 4>(args.out + (size_t)(r0 + j) * DM, args.final_g, args.out + (size_t)(r0 + j) * DM, nullptr, nullptr, nullptr, lane_); }
                        else { const float* src = args.out + (size_t)(lc - 1) * MC * DM; bf16_t* dst = (lc == 1) ? Hb : Hb1;
                            for (int j = 0; j < 8; j += 4) rms_rows<true, 4>(src + (size_t)(r0 + j) * DM, args.norm_g + DM, dst + (size_t)(r0 + j) * DM, H8b + ((size_t)(lc - 1) * MC + r0 + j) * DM, IWb + ((size_t)(lc - 1) * MC + r0 + j) * 4, args.w_in + (size_t)DM * INW + 2752, lane_); }
                        continue;
                    }
                    if (mode == 0) att::attn_unit2<0>(F.lds, Pb, Yb, BITS, (sub / 6) * SEQ, sub % 6, level, F.wave);
                    else if (mode == 1) att::attn_unit2<1>(F.lds, Pb, Yb, BITS, (sub / 3) * SEQ, sub % 3, level, F.wave);
                    else att::attn_unit<2>(F.lds, Pb, Yb, BITS, POb, PMLb, (sub >> 2) * SEQ, sub & 3, level, F.wave);
                }
                GRID_BAR();
            }
            if (EN(5)) for (int rep = 0; rep < NREP(5); ++rep) {
                WSPTRS();
                pg8::Gemm g{Yb, WBR + (size_t)l * DM * DM}; pg8::BranchOrder S; S.so.init(MC, DM, DM, F.G, (int)blockIdx.x);
                pg8::EpiMerge E{MG8b, MGb, 1.f / (F8_SY * F8_SB)};
                pg8::gemm_phase<pg8::EpiMerge, pg8::BranchOrder, true, YP, true>(F.lds, g, S, E, F.wave);
                GRID_BAR();
            }
            if (EN(6)) {
                WSPTRS();
                pg8::Gemm g{MGb, WOUT + (size_t)l * DM * DM}; pg8::StaticOrder S; S.init(MC, DM, DM, F.G, (int)blockIdx.x); S.nt = DM / 128;
                if (lc == DEPTH * NCH - 1 && fuse_fin) {
                    pg8::EpiResidNorm E{xout, args.final_g, wsl};
                    pg8::gemm_phase<pg8::EpiResidNorm, pg8::StaticOrder, true, pg8::LD, true>(F.lds, g, S, E, F.wave);
                } else {
                pg8::EpiResid E{xin, xout, 1.f / (F8_SM * F8_SB)};
                pg8::gemm_phase<pg8::EpiResid, pg8::StaticOrder, true, pg8::LD, true>(F.lds, g, S, E, F.wave);
                }
            }
        }
        if (lcx + 1 < DEPTH * NCH) {
            const int lc = lcx + 1;
            const int l = lc / NCH, c = lc % NCH;
            if (EN(2)) for (int rep = 0; rep < NREP(2); ++rep) {
                WSPTRS();
                const bool fp8_first = (blockIdx.x & 1) != 0;
#pragma nounroll
                for (int part = 0; part < 2; ++part)
                if ((part == 0) != fp8_first) {
                    pg8::Gemm g{c ? Hb1 : Hb, WIN + (size_t)l * NW * DM}; pg8::StaticOrder S; S.init(MC, C_F8, DM, F.G, (int)blockIdx.x);
                    pg8::EpiProj E{Pb, MG8b, cosT, sinT, 0, 1.f};
                    pg8::gemm_phase<pg8::EpiProj, pg8::StaticOrder, false>(F.lds, g, S, E, F.wave);
                }
                else {
                    pg8::Gemm g{(const bf16_t*)(H8b + (size_t)c * MC * DM), WIN + (size_t)l * NW * DM + (size_t)C_F8 * DM}; pg8::StaticOrder S; S.init(MC, NW_MAIN - C_F8, DM, F.G, (int)blockIdx.x); S.nt = DM / 128;
                    pg8::EpiProj E{Pb, MG8b, cosT, sinT, C_F8, 1.f / (F8_SA * F8_SB)};
                    pg8::gemm_phase<pg8::EpiProj, pg8::StaticOrder, true>(F.lds, g, S, E, F.wave);
                }
            }
        }
        if (!(lcx == DEPTH * NCH - 1 && fuse_fin)) GRID_BAR();
    }
    if (EN(7) && !fuse_fin) {
        PHASE_IDS();
        for (int m = MC + 4 * gw; m < BATCH * SEQ; m += 4 * NGW) rms_rows<false, 4>(args.out + (size_t)m * DM, args.final_g, args.out + (size_t)m * DM, nullptr, nullptr, nullptr, lane_);
    }
#undef IN
#undef BOTH
#undef GRID_BAR
}

extern "C" void kernel_launch(void* const* d_in, const int* in_sizes, int n_in, void* d_out, int out_size, void* d_ws, size_t ws_size, hipStream_t stream) {
    static int grid = 0;
    if (grid == 0) {
        if (n_in != 8 || in_sizes[0] != BATCH * SEQ * DM || out_size != BATCH * SEQ * DM || ws_size < WS_END) {
            fprintf(stderr, "kernel_launch: unexpected shapes / workspace (n_in %d, in0 %d, out %d, ws %zu, need %zu); nothing launched\n", n_in, n_in > 0 ? in_sizes[0] : -1, out_size, ws_size, (size_t)WS_END);
            grid = -1; return; }
        int dev = 0, cus = 0, per_cu = 0;
        if (hipGetDevice(&dev) != hipSuccess || hipDeviceGetAttribute(&cus, hipDeviceAttributeMultiprocessorCount, dev) != hipSuccess) { grid = -1; return; }
        if (hipFuncSetAttribute((const void*)mega_fwd, hipFuncAttributeMaxDynamicSharedMemorySize, LDS_BYTES) != hipSuccess) { fprintf(stderr, "kernel_launch: hipFuncSetAttribute failed\n"); grid = -1; return; }
        if (hipOccupancyMaxActiveBlocksPerMultiprocessor(&per_cu, (const void*)mega_fwd, NWAVES * 64, LDS_BYTES) != hipSuccess || per_cu < 1)
            fprintf(stderr, "kernel_launch: note: occupancy query reports %d workgroups per CU\n", per_cu);
        (void)hipGetLastError();
        grid = cus;
    }
    if (grid < 0) return;
    if (hipMemsetAsync((char*)d_ws + WS_CTL, 0, CTL_ZERO_BYTES, stream) != hipSuccess) return;
    Args a{};
    a.x = (const float*)d_in[0]; a.norm_g = (const float*)d_in[1]; a.w_in = (const float*)d_in[2]; a.w_br_a = (const float*)d_in[3];
    a.w_br_b = (const float*)d_in[4]; a.w_br_c = (const float*)d_in[5]; a.w_out = (const float*)d_in[6]; a.final_g = (const float*)d_in[7];
    a.out = (float*)d_out; a.ws = (unsigned char*)d_ws;
    if (MK_N_LAUNCHES == 1) {
        a.ph_lo = 0; a.ph_hi = NPHASES;
        hipLaunchKernelGGL(mega_fwd, dim3(grid), dim3(NWAVES * 64), LDS_BYTES, stream, a);
    } else {
        for (int p = 0; p < NPHASES; ++p) { a.ph_lo = p; a.ph_hi = p + 1; hipLaunchKernelGGL(mega_fwd, dim3(grid), dim3(NWAVES * 64), LDS_BYTES, stream, a); }
    }
}
```
